# Optimizing an MI355X kernel written in HIP

```python
import jax, jax.numpy as jnp
from jax import lax
import numpy as np

D_MODEL = 1024
BATCH = 32
SEQ = 2048
DEPTH = 2

MLA_HEADS = 8
MLA_NOPE = 64
MLA_ROPE = 32
MLA_V = 64
MLA_Q_RANK = 768
MLA_KV_RANK = 256
DSA_HEADS = 4
DSA_DIM = 64
IDX_HEADS = 8
IDX_DIM = 32
DSA_TOPK_MAX = 256
RET_HEADS = 4
RET_DK = 64
RET_DV = 64
RET_CHUNK = 128
D_FF = 4 * D_MODEL
ROPE_THETA = 10000.0
EPS = 1e-6
Q_BLOCK = 128

MIX_WIDTH = MLA_HEADS * MLA_V + DSA_HEADS * DSA_DIM + RET_HEADS * RET_DV
MLA_COLS = (MLA_Q_RANK, MLA_KV_RANK, MLA_ROPE)
DSA_COLS = (DSA_HEADS * DSA_DIM, DSA_DIM, DSA_DIM, IDX_HEADS * IDX_DIM, IDX_DIM, IDX_HEADS)
RET_COLS = (RET_HEADS * RET_DK, RET_HEADS * RET_DK, RET_HEADS * RET_DV, RET_HEADS * RET_DV)
SPLITS = MLA_COLS + DSA_COLS + RET_COLS
IN_WIDTH = sum(SPLITS)

kernel_name = 'hymba_mla_dsa_retention_block'


def rmsnorm(x, g):
    xf = x.astype(jnp.float32)
    y = xf * lax.rsqrt(jnp.mean(xf * xf, axis=-1, keepdims=True) + EPS)
    return (y * g.astype(jnp.float32)).astype(x.dtype)


def rope_tables(seq, dim):
    pos = jnp.arange(seq, dtype=jnp.float32)
    inv = ROPE_THETA ** (-jnp.arange(0, dim, 2, dtype=jnp.float32) / dim)
    ang = pos[:, None] * inv[None, :]
    return jnp.cos(ang), jnp.sin(ang)


def apply_rope(x, cos, sin):
    d2 = x.shape[-1] // 2
    x1, x2 = x[..., :d2], x[..., d2:]
    c = cos[:, None, :].astype(x.dtype)
    s = sin[:, None, :].astype(x.dtype)
    return jnp.concatenate([x1 * c - x2 * s, x1 * s + x2 * c], axis=-1)


def to_blocks(t):
    b, s = t.shape[0], t.shape[1]
    return t.reshape((b, s // Q_BLOCK, Q_BLOCK) + t.shape[2:]).swapaxes(0, 1)


def from_blocks(t):
    t = t.swapaxes(0, 1)
    return t.reshape(t.shape[0], t.shape[1] * t.shape[2], -1)


def mla_attention(q_nope, q_rope, k_nope, k_rope, v):
    S = q_nope.shape[1]
    nb = S // Q_BLOCK
    scale = (MLA_NOPE + MLA_ROPE) ** -0.5
    key_pos = jnp.arange(S)
    neg = jnp.finfo(jnp.float32).min

    def block(args):
        qn, qr, start = args
        s = jnp.einsum('bqhd,bkhd->bhqk', qn, k_nope) + jnp.einsum('bqhd,bkd->bhqk', qr, k_rope)
        s = s.astype(jnp.float32) * scale
        qpos = start + jnp.arange(Q_BLOCK)
        causal = key_pos[None, :] <= qpos[:, None]
        p = jax.nn.softmax(jnp.where(causal, s, neg), axis=-1).astype(v.dtype)
        return jnp.einsum('bhqk,bkhd->bqhd', p, v)

    starts = jnp.arange(nb, dtype=jnp.int32) * Q_BLOCK
    out = lax.map(block, (to_blocks(q_nope), to_blocks(q_rope), starts))
    return from_blocks(out)


def dsa_attention(q, k, v, q_idx, k_idx, w_idx, topk):
    S = q.shape[1]
    nb = S // Q_BLOCK
    scale = DSA_DIM ** -0.5
    key_pos = jnp.arange(S)
    neg = jnp.finfo(jnp.float32).min
    gather = jax.vmap(lambda table, idx: table[idx])

    def block(args):
        qb, qib, wb, start = args
        qpos = start + jnp.arange(Q_BLOCK)
        causal = key_pos[None, :] <= qpos[:, None]
        rel = jax.nn.relu(jnp.einsum('bqhd,bkd->bqhk', qib, k_idx))
        score = jnp.einsum('bqh,bqhk->bqk', wb, rel).astype(jnp.float32)
        score = jnp.where(causal[None], score, -jnp.inf)
        _, sel = lax.top_k(score, topk)
        valid = sel <= qpos[None, :, None]
        k_sel = gather(k, sel)
        v_sel = gather(v, sel)
        s = jnp.einsum('bqhd,bqjd->bhqj', qb, k_sel).astype(jnp.float32) * scale
        p = jax.nn.softmax(jnp.where(valid[:, None], s, neg), axis=-1).astype(v.dtype)
        return jnp.einsum('bhqj,bqjd->bqhd', p, v_sel)

    starts = jnp.arange(nb, dtype=jnp.int32) * Q_BLOCK
    out = lax.map(block, (to_blocks(q), to_blocks(q_idx), to_blocks(w_idx), starts))
    return from_blocks(out)


def retention(q, k, v, log_gamma):
    B, S, H, dk = q.shape
    dv = v.shape[-1]
    C = RET_CHUNK
    n = S // C
    qc = q.astype(jnp.float32).reshape(B, n, C, H, dk)
    kc = k.astype(jnp.float32).reshape(B, n, C, H, dk)
    vc = v.astype(jnp.float32).reshape(B, n, C, H, dv)
    pos = jnp.arange(C, dtype=jnp.float32)
    rel = pos[:, None] - pos[None, :]
    decay = jnp.where(rel[None] >= 0, jnp.exp(jnp.maximum(rel, 0.0)[None] * log_gamma[:, None, None]), 0.0)
    inner = jnp.einsum('bnqhd,bnchd->bnhqc', qc, kc) * decay[None, None]
    inner_out = jnp.einsum('bnhqc,bnche->bnqhe', inner, vc)
    zeta = jnp.exp((C - 1.0 - pos)[None, :] * log_gamma[:, None])
    chunk_state = jnp.einsum('bnchd,hc,bnche->bnhde', kc, zeta, vc)
    chunk_decay = jnp.exp(C * log_gamma)[None, :, None, None]

    def step(R, s_i):
        return R * chunk_decay + s_i, R

    R0 = jnp.zeros((B, H, dk, dv), jnp.float32)
    _, R_prev = lax.scan(step, R0, chunk_state.swapaxes(0, 1))
    R_prev = R_prev.swapaxes(0, 1)
    xi = jnp.exp((pos + 1.0)[None, :] * log_gamma[:, None])
    cross = jnp.einsum('bnqhd,bnhde,hq->bnqhe', qc, R_prev, xi)
    return (inner_out + cross).reshape(B, S, H, dv)


def head_groupnorm(x, g):
    mu = jnp.mean(x, axis=-1, keepdims=True)
    xc = x - mu
    var = jnp.mean(xc * xc, axis=-1, keepdims=True)
    return xc * lax.rsqrt(var + EPS) * g


def setup_inputs(seed: int = 0) -> dict:
    key = jax.random.key(seed)
    ks = jax.random.split(key, 16)

    def nrm(k, shape, scale):
        return jax.random.normal(k, shape, jnp.float32) * scale

    def gain(k, shape):
        return 1.0 + 0.05 * jax.random.normal(k, shape, jnp.float32)

    return {
        'x': nrm(ks[0], (BATCH, SEQ, D_MODEL), 1.0),
        'g_mix': gain(ks[1], (DEPTH, D_MODEL)),
        'w_in': nrm(ks[2], (DEPTH, D_MODEL, IN_WIDTH), D_MODEL ** -0.5),
        'g_q': gain(ks[3], (DEPTH, MLA_Q_RANK)),
        'w_uq': nrm(ks[4], (DEPTH, MLA_Q_RANK, MLA_HEADS * (MLA_NOPE + MLA_ROPE)), MLA_Q_RANK ** -0.5),
        'g_kv': gain(ks[5], (DEPTH, MLA_KV_RANK)),
        'w_ukv': nrm(ks[6], (DEPTH, MLA_KV_RANK, MLA_HEADS * (MLA_NOPE + MLA_V)), MLA_KV_RANK ** -0.5),
        'g_ret': gain(ks[7], (DEPTH, RET_HEADS * RET_DV)),
        'w_out': nrm(ks[8], (DEPTH, MIX_WIDTH, D_MODEL), MIX_WIDTH ** -0.5),
        'g_mlp': gain(ks[9], (DEPTH, D_MODEL)),
        'w_ff1': nrm(ks[10], (DEPTH, D_MODEL, D_FF), D_MODEL ** -0.5),
        'w_ff2': nrm(ks[11], (DEPTH, D_FF, D_MODEL), D_FF ** -0.5),
        'g_final': gain(ks[12], (D_MODEL,)),
    }


def reference(x, g_mix, w_in, g_q, w_uq, g_kv, w_ukv, g_ret, w_out, g_mlp, w_ff1, w_ff2, g_final):
    B, S, _ = x.shape
    topk = min(DSA_TOPK_MAX, S // 4)
    cos_r, sin_r = rope_tables(S, MLA_ROPE)
    cos_a, sin_a = rope_tables(S, DSA_DIM)
    cos_i, sin_i = rope_tables(S, IDX_DIM)
    cos_t, sin_t = rope_tables(S, RET_DK)
    log_gamma = jnp.log1p(-jnp.exp2(-5.0 - jnp.arange(RET_HEADS, dtype=jnp.float32)))
    split_at = np.cumsum(SPLITS)[:-1].tolist()
    idx_scale = (IDX_HEADS ** -0.5) * (IDX_DIM ** -0.5)

    for l in range(DEPTH):
        h = rmsnorm(x, g_mix[l])
        (cq, ckv, kr, aq, ak, av, qi, ki, wi, rq, rk, rv, rg) = jnp.split(h @ w_in[l], split_at, axis=-1)

        q = (rmsnorm(cq, g_q[l]) @ w_uq[l]).reshape(B, S, MLA_HEADS, MLA_NOPE + MLA_ROPE)
        q_nope = q[..., :MLA_NOPE]
        q_rope = apply_rope(q[..., MLA_NOPE:], cos_r, sin_r)
        kv = (rmsnorm(ckv, g_kv[l]) @ w_ukv[l]).reshape(B, S, MLA_HEADS, MLA_NOPE + MLA_V)
        k_nope, v_mla = kv[..., :MLA_NOPE], kv[..., MLA_NOPE:]
        k_rope = apply_rope(kr[:, :, None, :], cos_r, sin_r)[:, :, 0]
        o_a = mla_attention(q_nope, q_rope, k_nope, k_rope, v_mla)

        q_b = apply_rope(aq.reshape(B, S, DSA_HEADS, DSA_DIM), cos_a, sin_a)
        k_b = apply_rope(ak[:, :, None, :], cos_a, sin_a)[:, :, 0]
        q_i = apply_rope(qi.reshape(B, S, IDX_HEADS, IDX_DIM), cos_i, sin_i)
        k_i = apply_rope(ki[:, :, None, :], cos_i, sin_i)[:, :, 0]
        o_b = dsa_attention(q_b, k_b, av, q_i, k_i, wi * idx_scale, topk)

        q_c = apply_rope(rq.reshape(B, S, RET_HEADS, RET_DK), cos_t, sin_t)
        k_c = apply_rope(rk.reshape(B, S, RET_HEADS, RET_DK), cos_t, sin_t) * (RET_DK ** -0.5)
        ret = retention(q_c, k_c, rv.reshape(B, S, RET_HEADS, RET_DV), log_gamma)
        ret = head_groupnorm(ret, g_ret[l].reshape(RET_HEADS, RET_DV).astype(jnp.float32))
        o_c = (jax.nn.silu(rg.astype(jnp.float32)) * ret.reshape(B, S, RET_HEADS * RET_DV)).astype(x.dtype)

        x = x + jnp.concatenate([o_a, o_b, o_c], axis=-1) @ w_out[l]

        hf = rmsnorm(x, g_mlp[l])
        x = x + jnp.square(jax.nn.relu(hf @ w_ff1[l])) @ w_ff2[l]

    return rmsnorm(x, g_final)
```

```cpp
#include <hip/hip_runtime.h>
#include <cstdio>
#include <cstdint>
namespace pg8 {
#define PG8_LAS __attribute__((address_space(3)))
typedef unsigned short bf16_t;
typedef short bf16x8 __attribute__((ext_vector_type(8)));
typedef float f32x4 __attribute__((ext_vector_type(4)));
typedef unsigned u32x4 __attribute__((ext_vector_type(4)));
constexpr int BM = 256, BK = 64, HALF = 128, HTB = HALF * BK * 2  , STAGE_BYTES = 8 * HTB, NXCD = 8, WGM = 8;

__host__ __device__ __forceinline__ int lds_byte(int r, int c) { const int st = (r >> 4) * 2 + (c >> 5), rr = r & 15, cc = c & 31, ob = rr * 64 + cc * 2; return st * 1024 + (ob ^ (((ob >> 9) & 1) << 5)); }
__host__ __device__ __forceinline__ void stage_rc(int b, int& R, int& C) { const int st = b / 1024, sb = b % 1024, swz = sb ^ (((sb >> 9) & 1) << 5); R = (st >> 1) * 16 + swz / 64; C = (st & 1) * 32 + (swz % 64) / 2; }
__host__ __device__ __forceinline__ int perm32(int rho) { const int n = rho >> 4, i = rho & 15; return 8 * (i >> 2) + 4 * n + (i & 3); }

struct Unit { int pm, pn; };
struct Gemm { const bf16_t* A; const bf16_t* Bt; int M, N, K; };

struct StaticOrder {
    int nM, nN, nwg, G, c;
    __host__ __device__ void init(int M, int N, int G_, int c_) { nM = M / BM; nN = N / BM; nwg = nM * nN; G = G_; c = c_; }
    __host__ __device__ bool next(int i, Unit& u) const {
        const long L = (long)i * G + c; if (L >= nwg) return false;
        int wgid = (int)L; { const int q = nwg / NXCD, r = nwg % NXCD, xcd = wgid % NXCD, off = wgid / NXCD; wgid = (xcd < r ? xcd * (q + 1) : r * (q + 1) + (xcd - r) * q) + off; }
        const int nig = WGM * nN, gid = wgid / nig, fm = gid * WGM, gsz = (nM - fm) < WGM ? (nM - fm) : WGM;
        u.pm = fm + ((wgid % nig) % gsz); u.pn = (wgid % nig) / gsz; return true;
    }
    __device__ __forceinline__ void a_ready(const Unit&) const {}
    __device__ __forceinline__ void done(const Unit&) const {}
};

__device__ __forceinline__ unsigned cvt_pk_bf16(float lo, float hi) { unsigned r; asm volatile("v_cvt_pk_bf16_f32 %0, %1, %2" : "=v"(r) : "v"(lo), "v"(hi)); return r; }
typedef float f32x2 __attribute__((ext_vector_type(2)));

template <class Epi, class Sched, bool ALIGN_EPI = false, bool SP2 = false>
__device__ __forceinline__ void gemm_phase(PG8_LAS unsigned char* lds, const Gemm g, const Sched& S, const Epi& E, const int wid_in) {
    int lane_l; asm volatile("v_mbcnt_lo_u32_b32 %0, -1, 0\n\tv_mbcnt_hi_u32_b32 %0, -1, %0" : "=v"(lane_l));
    int wid_l = wid_in; asm volatile("" : "+s"(wid_l));
    const int wid = wid_l, lane = lane_l, tid = wid * 64 + lane, wr = wid >> 2, wc = wid & 3, fr = lane & 15, fq = lane >> 4;
    const int K = g.K, nt = K / BK;
    unsigned voffA[2], voffB[2];
#pragma unroll
    for (int i = 0; i < 2; ++i) { int R, C; stage_rc(tid * 16 + i * 8192, R, C); const int Rb = Epi::PERM ? ((R & ~31) + perm32(R & 31)) : R;
        voffA[i] = (unsigned)(R * K + C) * 2u; voffB[i] = (unsigned)(Rb * K + C) * 2u; }
    const size_t kstep = (size_t)(BK * 2);
    const size_t hstep = (size_t)HALF * K * 2;
    const size_t tstep = 2 * hstep;
    const unsigned ldsw = (unsigned)wid * 1024u;
    const int aoff = lds_byte(wr * 64 + fr, fq * 8), boff = lds_byte(wc * 32 + fr, fq * 8);
#define PG8_SA(b, h) (((b) * 2 + (h)) * HTB)
#define PG8_SB(b, h) ((4 + (b) * 2 + (h)) * HTB)
#define PG8_STAGE(bufoff, gbase, voff) do { _Pragma("unroll") for (int _i = 0; _i < 2; ++_i) \
        __builtin_amdgcn_global_load_lds((const unsigned*)((const char*)(gbase) + (voff)[_i]), (PG8_LAS unsigned*)(lds + (bufoff) + ldsw + _i * 8192), 16, 0, 0); } while (0)
#define PG8_LDA(dst, b, h) do { _Pragma("unroll") for (int m = 0; m < 4; ++m) _Pragma("unroll") for (int k = 0; k < 2; ++k) dst[m][k] = *(const PG8_LAS bf16x8*)(lds + PG8_SA(b, h) + aoff + m * 2048 + k * 1024); } while (0)
#define PG8_LDB(dst, b, h) do { _Pragma("unroll") for (int n = 0; n < 2; ++n) _Pragma("unroll") for (int k = 0; k < 2; ++k) dst[n][k] = *(const PG8_LAS bf16x8*)(lds + PG8_SB(b, h) + boff + n * 2048 + k * 1024); } while (0)
#define PG8_MMA(ai, bj, At, Bt) do { __builtin_amdgcn_s_setprio(1); _Pragma("unroll") for (int m = 0; m < 4; ++m) _Pragma("unroll") for (int n = 0; n < 2; ++n) _Pragma("unroll") for (int k = 0; k < 2; ++k) \
        acc[ai][bj][m][n] = __builtin_amdgcn_mfma_f32_16x16x32_bf16(Bt[n][k], At[m][k], acc[ai][bj][m][n], 0, 0, 0); __builtin_amdgcn_s_setprio(0); } while (0)
#define PG8_WAIT_V(n) asm volatile("s_waitcnt vmcnt(" #n ")" ::: "memory")
#define PG8_WAIT_L(n) asm volatile("s_waitcnt lgkmcnt(" #n ")" ::: "memory")
#define PG8_BAR __builtin_amdgcn_s_barrier()
#define PG8_SCHED __builtin_amdgcn_sched_barrier(0)
    Unit cur, nxt; int ui = 0;
    if (!S.next(0, cur)) return;
    f32x4 acc[2][2][4][2];
#pragma unroll
    for (int a = 0; a < 2; ++a)
#pragma unroll
        for (int b = 0; b < 2; ++b)
#pragma unroll
            for (int m = 0; m < 4; ++m)
#pragma unroll
                for (int n = 0; n < 2; ++n) acc[a][b][m][n] = (f32x4){0.f, 0.f, 0.f, 0.f};
    bf16x8 At[4][2], B0[2][2], B1[2][2];
    const char* cA = (const char*)g.A + (size_t)cur.pm * tstep; const char* cB = (const char*)g.Bt + (size_t)cur.pn * tstep;
    S.a_ready(cur);
    if constexpr (SP2) {
        PG8_STAGE(PG8_SB(0, 0), cB, voffB); PG8_STAGE(PG8_SB(0, 1), cB + hstep, voffB); PG8_STAGE(PG8_SA(0, 0), cA, voffA); PG8_STAGE(PG8_SA(0, 1), cA + hstep, voffA);
        if (wr == 1) PG8_BAR;
        PG8_WAIT_V(2); PG8_BAR;
        PG8_STAGE(PG8_SB(1, 0), cB + kstep, voffB); PG8_STAGE(PG8_SA(1, 0), cA + kstep, voffA); PG8_STAGE(PG8_SB(1, 1), cB + hstep + kstep, voffB);
        PG8_WAIT_V(6); PG8_BAR;
    } else {
        PG8_STAGE(PG8_SB(0, 0), cB, voffB); PG8_STAGE(PG8_SA(0, 0), cA, voffA); PG8_STAGE(PG8_SB(0, 1), cB + hstep, voffB); PG8_STAGE(PG8_SA(0, 1), cA + hstep, voffA);
        if (wr == 1) PG8_BAR;
        PG8_WAIT_V(4); PG8_BAR;
        PG8_STAGE(PG8_SB(1, 0), cB + kstep, voffB); PG8_STAGE(PG8_SA(1, 0), cA + kstep, voffA); PG8_STAGE(PG8_SB(1, 1), cB + hstep + kstep, voffB);
        PG8_WAIT_V(6); PG8_BAR;
    }
    for (;;) {
        const bool has_next = S.next(ui + 1, nxt);
        const char* nA = has_next ? (const char*)g.A + (size_t)nxt.pm * tstep : cA; const char* nB = has_next ? (const char*)g.Bt + (size_t)nxt.pn * tstep : cB;
        for (int t = 0; t < nt; t += 2) {
            const bool last = (t == nt - 2);
            const char* a1 = cA + (size_t)(t + 1) * kstep;
            const char* a2 = last ? nA : cA + (size_t)(t + 2) * kstep; const char* b2 = last ? nB : cB + (size_t)(t + 2) * kstep;
            const char* a3 = a2 + kstep; const char* b3 = b2 + kstep;
            if (last && has_next) S.a_ready(nxt);
            if constexpr (SP2) {
            PG8_LDB(B0, 0, 0); PG8_LDB(B1, 0, 1); PG8_SCHED; PG8_LDA(At, 0, 0); PG8_STAGE(PG8_SA(1, 1), a1 + hstep, voffA);
            PG8_WAIT_V(8); PG8_WAIT_L(0); PG8_BAR; PG8_MMA(0, 0, At, B0); PG8_MMA(0, 1, At, B1); PG8_BAR; PG8_SCHED;
            PG8_LDA(At, 0, 1); PG8_STAGE(PG8_SB(0, 0), b2, voffB); PG8_STAGE(PG8_SB(0, 1), b2 + hstep, voffB); PG8_STAGE(PG8_SA(0, 0), a2, voffA);
            PG8_WAIT_V(8); PG8_WAIT_L(0); PG8_BAR; PG8_MMA(1, 0, At, B0); PG8_MMA(1, 1, At, B1); PG8_BAR; PG8_SCHED;
            PG8_LDB(B0, 1, 0); PG8_LDB(B1, 1, 1); PG8_SCHED; PG8_LDA(At, 1, 0); PG8_STAGE(PG8_SA(0, 1), a2 + hstep, voffA);
            PG8_WAIT_V(8); PG8_WAIT_L(0); PG8_BAR; PG8_MMA(0, 0, At, B0); PG8_MMA(0, 1, At, B1); PG8_BAR; PG8_SCHED;
            PG8_LDA(At, 1, 1); PG8_STAGE(PG8_SB(1, 0), b3, voffB); PG8_STAGE(PG8_SB(1, 1), b3 + hstep, voffB); PG8_STAGE(PG8_SA(1, 0), a3, voffA);
            PG8_WAIT_V(8); PG8_WAIT_L(0); PG8_BAR; PG8_MMA(1, 0, At, B0); PG8_MMA(1, 1, At, B1); PG8_BAR; PG8_SCHED;
            } else {
            PG8_LDB(B0, 0, 0); PG8_SCHED; PG8_LDA(At, 0, 0); PG8_STAGE(PG8_SA(1, 1), a1 + hstep, voffA);
            PG8_WAIT_L(8); PG8_BAR; PG8_WAIT_L(0); PG8_MMA(0, 0, At, B0); PG8_BAR; PG8_SCHED;
            PG8_LDB(B1, 0, 1); PG8_STAGE(PG8_SB(0, 0), b2, voffB);
            PG8_BAR; PG8_WAIT_L(0); PG8_MMA(0, 1, At, B1); PG8_BAR;
            PG8_LDA(At, 0, 1); PG8_STAGE(PG8_SA(0, 0), a2, voffA);
            PG8_BAR; PG8_WAIT_L(0); PG8_MMA(1, 0, At, B0); PG8_BAR; PG8_SCHED;
            PG8_STAGE(PG8_SB(0, 1), b2 + hstep, voffB);
            PG8_WAIT_V(6); PG8_BAR; PG8_MMA(1, 1, At, B1); PG8_BAR;
            PG8_LDB(B0, 1, 0); PG8_SCHED; PG8_LDA(At, 1, 0); PG8_STAGE(PG8_SA(0, 1), a2 + hstep, voffA);
            PG8_WAIT_L(8); PG8_BAR; PG8_WAIT_L(0); PG8_MMA(0, 0, At, B0); PG8_BAR; PG8_SCHED;
            PG8_LDB(B1, 1, 1); PG8_STAGE(PG8_SB(1, 0), b3, voffB);
            PG8_BAR; PG8_WAIT_L(0); PG8_MMA(0, 1, At, B1); PG8_BAR;
            PG8_LDA(At, 1, 1); PG8_STAGE(PG8_SA(1, 0), a3, voffA);
            PG8_BAR; PG8_WAIT_L(0); PG8_MMA(1, 0, At, B0); PG8_BAR; PG8_SCHED;
            PG8_STAGE(PG8_SB(1, 1), b3 + hstep, voffB);
            PG8_WAIT_V(6); PG8_BAR; PG8_MMA(1, 1, At, B1); PG8_BAR;
            }
        }
        if constexpr (ALIGN_EPI) { if (wr == 0) PG8_BAR; }
        if constexpr (!Epi::AFTER_DRAIN) { E(acc, cur, wr, wc, fr, fq); S.done(cur); }
        if (!has_next) break;
#pragma unroll
        for (int a = 0; a < 2; ++a)
#pragma unroll
            for (int b = 0; b < 2; ++b)
#pragma unroll
                for (int m = 0; m < 4; ++m)
#pragma unroll
                    for (int n = 0; n < 2; ++n) acc[a][b][m][n] = (f32x4){0.f, 0.f, 0.f, 0.f};
        cur = nxt; cA = nA; cB = nB; ++ui;
        if constexpr (ALIGN_EPI) { if (wr == 1) PG8_BAR; }
    }
    PG8_WAIT_V(0);
    if constexpr (!ALIGN_EPI) { if (wr == 0) PG8_BAR; }
    PG8_BAR;
    if constexpr (Epi::AFTER_DRAIN) { E.fused(acc, cur, wr, wc, fr, fq, lds, wid, lane); S.done(cur); }
#undef PG8_SA
#undef PG8_SB
#undef PG8_STAGE
#undef PG8_LDA
#undef PG8_LDB
#undef PG8_MMA
#undef PG8_WAIT_V
#undef PG8_WAIT_L
#undef PG8_BAR
#undef PG8_SCHED
}
}

#ifndef MK_N_LAUNCHES
#define MK_N_LAUNCHES 1
#endif
#ifndef PROBE_REP
#define PROBE_REP 0
#endif
#define REP(bit) for (int rep_ = 0; rep_ < ((PROBE_REP >> (bit)) & 1) + 1; ++rep_)
#ifndef PROBE_KL
#define PROBE_KL 0
#endif
#ifndef SEL_NB
#define SEL_NB 13
#endif
#ifndef ATT_FUSE_SM
#define ATT_FUSE_SM 2
#endif
#ifndef ATT_SPLIT
#define ATT_SPLIT 1
#endif
#ifndef ATT_NQR
#define ATT_NQR 2
#endif
#ifndef RES_BATCH
#define RES_BATCH 4
#endif
#ifndef MK_NAIVE_GEMM
#define MK_NAIVE_GEMM 0
#endif

namespace mk {
#define GAS __attribute__((address_space(1)))
#define LAS __attribute__((address_space(3)))
typedef unsigned short bf16;
typedef float f32x4 __attribute__((ext_vector_type(4)));
typedef float f32x2 __attribute__((ext_vector_type(2)));
typedef unsigned u32x4 __attribute__((ext_vector_type(4)));
typedef unsigned u32x2 __attribute__((ext_vector_type(2)));
typedef __bf16 bf16x2_t __attribute__((ext_vector_type(2)));
typedef unsigned long long u64;

constexpr int BATCH = 32, SEQ = 2048, DM = 1024, DEPTH = 2, M = BATCH * SEQ, FF = 4096;
constexpr int NIN = 2816;
constexpr int IN_W = 2760;
constexpr float EPS = 1e-6f;
constexpr float LOG2E = 1.4426950408889634f;
constexpr int NWAVES = 8, NTHREADS = 512;

constexpr size_t MiB = 1u << 20;
constexpr size_t WS_CTL = 0, CTL_ZERO_BYTES = 1 * MiB;
constexpr size_t W_IN_B = (size_t)NIN * DM * 2, W_UQ_B = 768 * 768 * 2, W_UKV_B = 1024 * 256 * 2, W_OUT_B = 1024 * 1024 * 2, W_F1_B = (size_t)FF * DM * 2, W_F2_B = (size_t)DM * FF * 2;
constexpr size_t WL_IN = 0, WL_UQ = WL_IN + W_IN_B, WL_UKV = WL_UQ + W_UQ_B, WL_OUT = WL_UKV + W_UKV_B, WL_F1 = WL_OUT + W_OUT_B, WL_F2 = WL_F1 + W_F1_B, WL_BYTES = WL_F2 + W_F2_B;
constexpr size_t WS_W = 1 * MiB;
constexpr size_t WS_SSQX = 55 * MiB, WS_SSQL = 59 * MiB;
constexpr size_t WS_WI = 63 * MiB;
constexpr size_t WS_SSQ2 = 66 * MiB;
constexpr size_t WS_XB = 70 * MiB;
constexpr size_t WS_BIG = 198 * MiB;
constexpr size_t WS_CQ = WS_BIG, WS_CKV = WS_CQ + 96 * MiB, WS_AQ = WS_CKV + 32 * MiB, WS_RQ = WS_AQ + 32 * MiB, WS_RK = WS_RQ + 32 * MiB, WS_QI = WS_RK + 32 * MiB,
                 WS_MS = WS_QI + 32 * MiB, WS_RV = WS_MS + 32 * MiB, WS_RG = WS_RV + 32 * MiB, WS_Q = WS_RG + 32 * MiB, WS_KN = WS_Q + 96 * MiB, WS_V = WS_KN + 64 * MiB,
                 WS_BM = WS_V + 64 * MiB, WS_O = WS_BM + 16 * MiB, WS_END = WS_O + 128 * MiB;
constexpr size_t WS_H = WS_BIG;
static_assert(WS_W + 2 * WL_BYTES <= WS_SSQX && WS_END <= 1024 * MiB && WS_H + 512 * MiB <= 1024 * MiB, "d_ws map");
constexpr int CW_BAR = 4096;

constexpr int RING_BYTES = 131072, MISC_OFF = RING_BYTES + 320, LDS_BYTES = 147456;

__device__ __forceinline__ unsigned cvtpk(float lo, float hi) { f32x2 v = {lo, hi}; bf16x2_t b = __builtin_convertvector(v, bf16x2_t); return __builtin_bit_cast(unsigned, b); }
__device__ __forceinline__ float bf_lo(unsigned u) { return __uint_as_float(u << 16); }
__device__ __forceinline__ float bf_hi(unsigned u) { return __uint_as_float(u & 0xffff0000u); }
__device__ __forceinline__ void unpack8(const u32x4 r, float* f) { f[0] = bf_lo(r.x); f[1] = bf_hi(r.x); f[2] = bf_lo(r.y); f[3] = bf_hi(r.y); f[4] = bf_lo(r.z); f[5] = bf_hi(r.z); f[6] = bf_lo(r.w); f[7] = bf_hi(r.w); }
__device__ __forceinline__ void st8(bf16* dst, const float* v) { u32x4 w; w.x = cvtpk(v[0], v[1]); w.y = cvtpk(v[2], v[3]); w.z = cvtpk(v[4], v[5]); w.w = cvtpk(v[6], v[7]); *(u32x4*)dst = w; }
__device__ __forceinline__ void st8nt(bf16* dst, const float* v) { u32x4 w; w.x = cvtpk(v[0], v[1]); w.y = cvtpk(v[2], v[3]); w.z = cvtpk(v[4], v[5]); w.w = cvtpk(v[6], v[7]); __builtin_nontemporal_store(w, (u32x4*)dst); }
__device__ __forceinline__ void st8f(float* dst, const float* v) { *(f32x4*)dst = (f32x4){v[0], v[1], v[2], v[3]}; *(f32x4*)(dst + 4) = (f32x4){v[4], v[5], v[6], v[7]}; }
__device__ __forceinline__ float sum16(const float* p) { const f32x4 a = *(const f32x4*)p, b = *(const f32x4*)(p + 4), c = *(const f32x4*)(p + 8), d = *(const f32x4*)(p + 12);
    return (((a.x + a.y) + (a.z + a.w)) + ((b.x + b.y) + (b.z + b.w))) + (((c.x + c.y) + (c.z + c.w)) + ((d.x + d.y) + (d.z + d.w))); }
__device__ __forceinline__ float wave_sum(float v) {
#pragma unroll
    for (int o = 1; o < 64; o <<= 1) v += __shfl_xor(v, o);
    return v; }
__device__ __forceinline__ float wave_max(float v) {
#pragma unroll
    for (int o = 1; o < 64; o <<= 1) v = fmaxf(v, __shfl_xor(v, o));
    return v; }
__device__ __forceinline__ float wave_min(float v) {
#pragma unroll
    for (int o = 1; o < 64; o <<= 1) v = fminf(v, __shfl_xor(v, o));
    return v; }

__device__ __forceinline__ float xhalf_sum(float a) { const auto rr = __builtin_amdgcn_permlane32_swap(__float_as_uint(a), __float_as_uint(a), false, false); return __uint_as_float(rr[0]) + __uint_as_float(rr[1]); }
__device__ __forceinline__ float xrow16_sum(float x) { const auto s_ = __builtin_amdgcn_permlane16_swap(__float_as_uint(x), __float_as_uint(x), false, false); x = __uint_as_float(s_[0]) + __uint_as_float(s_[1]);
    const auto t_ = __builtin_amdgcn_permlane32_swap(__float_as_uint(x), __float_as_uint(x), false, false); return __uint_as_float(t_[0]) + __uint_as_float(t_[1]); }
__device__ __forceinline__ float xhalf_max(float a) { const auto rr = __builtin_amdgcn_permlane32_swap(__float_as_uint(a), __float_as_uint(a), false, false); return fmaxf(__uint_as_float(rr[0]), __uint_as_float(rr[1])); }
#define DPP_I(x, ctrl) __builtin_amdgcn_update_dpp(0, (x), (ctrl), 0xf, 0xf, false)
__device__ __forceinline__ int wave_sum_i(int x) {
    x += DPP_I(x, 0xB1); x += DPP_I(x, 0x4E); x += DPP_I(x, 0x141); x += DPP_I(x, 0x140);
    return __builtin_amdgcn_readlane(x, 0) + __builtin_amdgcn_readlane(x, 16) + __builtin_amdgcn_readlane(x, 32) + __builtin_amdgcn_readlane(x, 48); }
__device__ __forceinline__ float wave_max_f(float x) {
    x = fmaxf(x, __int_as_float(DPP_I(__float_as_int(x), 0xB1))); x = fmaxf(x, __int_as_float(DPP_I(__float_as_int(x), 0x4E))); x = fmaxf(x, __int_as_float(DPP_I(__float_as_int(x), 0x141))); x = fmaxf(x, __int_as_float(DPP_I(__float_as_int(x), 0x140)));
    const int xi = __float_as_int(x);
    return fmaxf(fmaxf(__int_as_float(__builtin_amdgcn_readlane(xi, 0)), __int_as_float(__builtin_amdgcn_readlane(xi, 16))), fmaxf(__int_as_float(__builtin_amdgcn_readlane(xi, 32)), __int_as_float(__builtin_amdgcn_readlane(xi, 48)))); }
__device__ __forceinline__ float wave_min_f(float x) { return -wave_max_f(-x); }
#define LDS_WAIT() asm volatile("s_waitcnt lgkmcnt(0)" ::: "memory")
__device__ __forceinline__ int lane_here() { int t; asm volatile("v_mbcnt_lo_u32_b32 %0, -1, 0\n\tv_mbcnt_hi_u32_b32 %0, -1, %0" : "=v"(t)); return t; }
#define tid_here() (wave_id * 64 + lane_here())

#define XB_TMO      128
#define XB_XCNT(j)  (256  + 64 * (j))
#define XB_XSUB(j)  (1280 + 64 * (j))
#define XB_XGEN(j)  (2304 + 64 * (j))
#define XB_TOP      3328
#define XB_TOPGEN   3392
#define XCD_BAR_WORDS 3456
#define XB_SPIN_CAP (1u << 24)
__device__ __forceinline__ unsigned xb_ld(unsigned* p)              { return __hip_atomic_load(p, __ATOMIC_RELAXED, __HIP_MEMORY_SCOPE_AGENT); }
__device__ __forceinline__ unsigned xb_add(unsigned* p, unsigned v) { return __hip_atomic_fetch_add(p, v, __ATOMIC_RELAXED, __HIP_MEMORY_SCOPE_AGENT); }
__device__ __forceinline__ unsigned xb_xcc_id() { return (unsigned)__builtin_amdgcn_s_getreg((3 << 11) | 20) & 0xFu; }
#define XB_SPIN(cond, bar) do { unsigned _sp = 0; while (cond) { __builtin_amdgcn_s_sleep(1); \
    if ((++_sp & 255u) == 0u) { if (xb_ld(&(bar)[XB_TMO])) break; if (_sp > XB_SPIN_CAP) { atomicAdd(&(bar)[XB_TMO], 1u); break; } } } } while (0)
struct XcdBarrier { unsigned* bar; unsigned x; volatile LAS unsigned* st; };
__device__ __forceinline__ XcdBarrier xcd_barrier_post(unsigned* bar, volatile LAS unsigned* st) {
    XcdBarrier b; b.bar = bar; b.x = xb_xcc_id(); b.st = st;
    if (threadIdx.x == 0) (void)xb_add(&bar[XB_XCNT(b.x)], 1u);
    return b;
}
__device__ __forceinline__ void xcd_barrier_complete(unsigned* bar, unsigned x, unsigned& nloc, unsigned& nx) {
    const unsigned G = gridDim.x * gridDim.y * gridDim.z;
    unsigned sum, cnt, mine, sp = 0u;
    for (;;) {
        sum = 0u; cnt = 0u; mine = 0u;
#pragma unroll
        for (unsigned j = 0; j < 16; ++j) { const unsigned c = xb_ld(&bar[XB_XCNT(j)]); sum += c; cnt += (c > 0u) ? 1u : 0u; mine = (j == x) ? c : mine; }
        if (sum == G) break;
        __builtin_amdgcn_s_sleep(1);
        if ((++sp & 255u) == 0u) { if (xb_ld(&bar[XB_TMO])) break; if (sp > XB_SPIN_CAP) { atomicAdd(&bar[XB_TMO], 1u); break; } }
    }
    nloc = mine > 0u ? mine : 1u; nx = cnt > 0u ? cnt : 1u;
}
__device__ __forceinline__ void xcd_barrier(const XcdBarrier& b) {
    asm volatile("s_waitcnt vmcnt(0)" ::: "memory");
    __syncthreads();
    if (threadIdx.x == 0) {
        size_t zo_ = 0; asm volatile("" : "+s"(zo_)); unsigned* bar = b.bar + zo_;
        __builtin_amdgcn_s_waitcnt(0);
        unsigned nloc = b.st[0], nx = b.st[1];
        if (nloc == 0u) { xcd_barrier_complete(bar, b.x, nloc, nx); b.st[0] = nloc; b.st[1] = nx; }
        const unsigned old = xb_add(&bar[XB_XSUB(b.x)], 1u);
        const unsigned gen = old / nloc;
        if (old + 1u == (gen + 1u) * nloc) {
            __builtin_amdgcn_fence(__ATOMIC_RELEASE, "agent");
            asm volatile("s_waitcnt vmcnt(0)" ::: "memory");
            const unsigned og = xb_add(&bar[XB_TOP], 1u);
            const unsigned tg = og / nx;
            if (og + 1u == (tg + 1u) * nx) xb_add(&bar[XB_TOPGEN], 1u);
            else XB_SPIN(xb_ld(&bar[XB_TOPGEN]) == tg, bar);
            __builtin_amdgcn_fence(__ATOMIC_ACQUIRE, "agent");
            xb_add(&bar[XB_XGEN(b.x)], 1u);
            asm volatile("s_waitcnt vmcnt(0)" ::: "memory");
        } else {
            XB_SPIN(xb_ld(&bar[XB_XGEN(b.x)]) == gen, bar);
            __builtin_amdgcn_fence(__ATOMIC_ACQUIRE, "agent");
            asm volatile("s_waitcnt vmcnt(0)" ::: "memory");
        }
    }
    __syncthreads();
}

struct SrcIn { __device__ __forceinline__ int operator()(int n) const {
    if (n < 1024) return n;
    const int t = (n - 1024) >> 8, c = (n - 1024) & 255, half = c >> 7, p = c & 127;
    if (t == 0) return 1056 + (p >> 5) * 64 + half * 32 + (p & 31);
    if (t == 1) return 1736 + (p >> 5) * 64 + half * 32 + (p & 31);
    if (t == 2) return 1992 + (p >> 5) * 64 + half * 32 + (p & 31);
    if (t == 3) return 1440 + (p >> 4) * 32 + half * 16 + (p & 15);
    if (t == 4) {
        if (p < 32) return 1312 + half * 32 + p;
        if (p < 48) return 1024 + half * 16 + (p - 32);
        if (p < 64) return 1696 + half * 16 + (p - 48);
        if (half == 0) return 1376 + (p - 64);
        return (p - 64 < 8) ? 1728 + (p - 64) : -1;
    }
    if (t == 5) return 2248 + c;
    return 2504 + c; } };
struct SrcUq { __device__ __forceinline__ int operator()(int n) const {
    if (n < 512) return (n >> 6) * 96 + (n & 63);
    const int c = n - 512, half = c >> 7, p = c & 127; return (p >> 4) * 96 + 64 + half * 16 + (p & 15); } };
struct SrcUkv { __device__ __forceinline__ int operator()(int n) const {
    if (n < 512) return (n >> 6) * 128 + (n & 63);
    const int c = n - 512; return (c >> 6) * 128 + 64 + (c & 63); } };
struct SrcId { __device__ __forceinline__ int operator()(int n) const { return n; } };

template <class SrcF>
__device__ __forceinline__ void transpose_item(const float* W, int K, int Nsrc, int Ndst, const float* gain, bf16* WT, LAS float* scr, int item, int lane, SrcF srcf) {
    const int nblk = Ndst / 32, kb = item / nblk, nb = item % nblk, k0 = 64 * kb, n0 = 32 * nb;
    const int sc = srcf(n0 + (lane & 31));
#pragma unroll 8
    for (int i = 0; i < 32; ++i) { const int kk = 2 * i + (lane >> 5); float v = 0.f; if (sc >= 0) v = W[(size_t)(k0 + kk) * Nsrc + sc]; if (gain) v *= gain[k0 + kk]; scr[kk * 33 + (lane & 31)] = v; }
    LDS_WAIT(); asm volatile("" ::: "memory");
    const int c = lane & 7;
#pragma unroll
    for (int j = 0; j < 4; ++j) { const int n = (lane >> 3) + 8 * j; const LAS float* s = scr + (8 * c) * 33 + n;
        u32x4 o; o.x = cvtpk(s[0 * 33], s[1 * 33]); o.y = cvtpk(s[2 * 33], s[3 * 33]); o.z = cvtpk(s[4 * 33], s[5 * 33]); o.w = cvtpk(s[6 * 33], s[7 * 33]);
        *(u32x4*)(WT + (size_t)(n0 + n) * K + k0 + 8 * c) = o; }
    LDS_WAIT(); asm volatile("" ::: "memory");
}

struct Ptrs {
    const float *x, *g_mix, *w_in, *g_q, *w_uq, *g_kv, *w_ukv, *g_ret, *w_out, *g_mlp, *w_ff1, *w_ff2, *g_final;
    float* out; unsigned char* ws;
};
struct Args { Ptrs p; int ph_lo, ph_hi; };
static_assert(sizeof(Args) == 15 * 8 + 8, "Args has no padding");

template <class F> struct EpiT {
    static constexpr bool PERM = true, AFTER_DRAIN = false;
    F f;
    template <int R0, int NRW>
    __device__ __forceinline__ void rows(const pg8::f32x4 (&acc)[2][2][4][2], const pg8::Unit& u, int row0, int wc, int fq, const typename F::Ctx& ctx) const {
        typename F::AuxT ax[NRW];
#pragma unroll
        for (int i = 0; i < NRW; ++i) ax[i] = f.load(row0 + ((R0 + i) >> 2) * 128 + ((R0 + i) & 3) * 16, u.pn, wc, fq);
        asm volatile("" ::: "memory");
#pragma unroll
        for (int i = 0; i < NRW; ++i) {
            const int it = R0 + i, ai = it >> 2, m = it & 3, row = row0 + ai * 128 + m * 16;
            float x1[8], x2[8];
#pragma unroll
            for (int j = 0; j < 4; ++j) { x1[j] = acc[ai][0][m][0][j]; x1[4 + j] = acc[ai][0][m][1][j]; x2[j] = acc[ai][1][m][0][j]; x2[4 + j] = acc[ai][1][m][1][j]; }
            f.apply(ctx, ax[i], row, u.pn, wc, fq, x1, x2);
            asm volatile("" ::: "memory");
        }
    }
    __device__ __forceinline__ void operator()(const pg8::f32x4 (&acc)[2][2][4][2], const pg8::Unit& u, int wr, int wc, int fr, int fq) const {
        { const int ln = lane_here(); fr = ln & 15; fq = ln >> 4; }
#if PROBE_KL
        if (*(volatile LAS unsigned*)(MISC_OFF + 128) & 1u) {
#pragma unroll
            for (int a = 0; a < 2; ++a)
#pragma unroll
                for (int b = 0; b < 2; ++b)
#pragma unroll
                    for (int m = 0; m < 4; ++m)
#pragma unroll
                        for (int n = 0; n < 2; ++n) asm volatile("" :: "v"(acc[a][b][m][n]));
            return; }
#endif
        const int row0 = u.pm * 256 + wr * 64 + fr;
        const typename F::Ctx ctx = f.begin(u.pn, wc, fq);
        if constexpr (F::BATCH == 8) rows<0, 8>(acc, u, row0, wc, fq, ctx);
        else { rows<0, 4>(acc, u, row0, wc, fq, ctx); rows<4, 4>(acc, u, row0, wc, fq, ctx); }
    }
};
__device__ __forceinline__ f32x4 part4(const float* p, int fq, int n4) { f32x4 a = {0.f, 0.f, 0.f, 0.f}; if (fq < n4) a = *(const f32x4*)(p + 4 * fq); return a; }
__device__ __forceinline__ float red4(const f32x4 a) { return xrow16_sum((a.x + a.y) + (a.z + a.w)); }
__device__ __forceinline__ float ssq16(const float* x1, const float* x2) { float s = 0.f;
#pragma unroll
    for (int j = 0; j < 8; ++j) s += x1[j] * x1[j] + x2[j] * x2[j];
    return xrow16_sum(s); }
struct RopeCtx { float inv[8]; };
__device__ __forceinline__ RopeCtx rope_ctx(int f0, bool dim64) { RopeCtx c; const float step = dim64 ? 0.41524101186092029f : 0.83048202372184058f;
#pragma unroll
    for (int j = 0; j < 8; ++j) c.inv[j] = __builtin_amdgcn_exp2f(-(float)(f0 + j) * step) * 0.15915494309189535f;
    return c; }
__device__ __forceinline__ void rope8(float* x1, float* x2, const RopeCtx& c, int pos) {
    const float pf = (float)pos;
#pragma unroll
    for (int j = 0; j < 8; ++j) { const float rev = __builtin_amdgcn_fractf(pf * c.inv[j]); const float cs = __builtin_amdgcn_cosf(rev), sn = __builtin_amdgcn_sinf(rev);
        const float a = x1[j], b = x2[j]; x1[j] = a * cs - b * sn; x2[j] = a * sn + b * cs; }
}

struct FIn {
    typedef f32x4 AuxT; typedef RopeCtx Ctx; static constexpr int BATCH = 8;
    unsigned char* ws;
    __device__ __forceinline__ Ctx begin(int pn, int wc, int fq) const { const int p = wc * 32 + fq * 8; const bool d64 = (pn >= 4 && pn <= 6) || (pn == 8 && wc == 0); return rope_ctx(d64 ? (p & 31) : (p & 15), d64); }
    __device__ __forceinline__ AuxT load(int row, int, int, int fq) const { return part4((const float*)(ws + WS_SSQX) + (size_t)row * 16, fq, 4); }
    __device__ __forceinline__ void apply(const Ctx& ctx, const AuxT& ax, int row, int pn, int wc, int fq, float* x1, float* x2) const {
        float* ssql = (float*)(ws + WS_SSQL);
        const float rs = __builtin_amdgcn_rsqf(red4(ax) * (1.0f / DM) + EPS);
#pragma unroll
        for (int j = 0; j < 8; ++j) { x1[j] *= rs; x2[j] *= rs; }
        const int p = wc * 32 + fq * 8, pos = row & (SEQ - 1);
        if (pn < 3) { bf16* d = (bf16*)(ws + WS_CQ) + (size_t)row * 768 + pn * 256 + p; st8(d, x1); st8(d + 128, x2); const float s = ssq16(x1, x2); if (fq == 0) ssql[(size_t)row * 16 + pn * 4 + wc] = s; }
        else if (pn == 3) { bf16* d = (bf16*)(ws + WS_CKV) + (size_t)row * 256 + p; st8(d, x1); st8(d + 128, x2); const float s = ssq16(x1, x2); if (fq == 0) ssql[(size_t)row * 16 + 12 + wc] = s; }
        else if (pn <= 6) { rope8(x1, x2, ctx, pos);
            const float sc_ = (pn == 4) ? 0.125f * LOG2E : (pn == 5) ? 1.0f : 0.125f;
#pragma unroll
            for (int j = 0; j < 8; ++j) { x1[j] *= sc_; x2[j] *= sc_; }
            bf16* d = (bf16*)(ws + WS_AQ + (size_t)(pn - 4) * (32 * MiB)) + (size_t)row * 256 + (p >> 5) * 64 + (p & 31); st8(d, x1); st8(d + 32, x2); }
        else if (pn == 7) { rope8(x1, x2, ctx, pos); bf16* d = (bf16*)(ws + WS_QI) + (size_t)row * 256 + (p >> 4) * 32 + (p & 15); st8(d, x1); st8(d + 16, x2); }
        else if (pn == 8) { bf16* d = (bf16*)(ws + WS_MS) + (size_t)row * 256;
            if (wc == 0) { rope8(x1, x2, ctx, pos); st8(d + p, x1); st8(d + 32 + p, x2); }
            else if (wc == 1) { const int i = (p - 32) & 15, o = (p < 48) ? 64 : 96; rope8(x1, x2, ctx, pos); st8(d + o + i, x1); st8(d + o + 16 + i, x2); }
            else { st8(d + 128 + (p - 64), x1); if (p == 64) { float w[8];
#pragma unroll
                    for (int j = 0; j < 8; ++j) w[j] = x2[j] * 0.0625f;
                    st8f((float*)(ws + WS_WI) + (size_t)row * 8, w); } } }
        else { bf16* d = (bf16*)(ws + WS_RV + (size_t)(pn - 9) * (32 * MiB)) + (size_t)row * 256 + p; st8(d, x1); st8(d + 128, x2); }
    }
};
static_assert(WS_V == WS_KN + 64 * MiB && WS_RQ == WS_AQ + 32 * MiB && WS_RK == WS_AQ + 64 * MiB && WS_RG == WS_RV + 32 * MiB, "FIn / FUkv compute these destinations by arithmetic");
struct FUq {
    typedef f32x4 AuxT; typedef RopeCtx Ctx; static constexpr int BATCH = 8;
    const float* ssql; bf16* q;
    __device__ __forceinline__ Ctx begin(int, int wc, int fq) const { return rope_ctx((wc * 32 + fq * 8) & 15, false); }
    __device__ __forceinline__ AuxT load(int row, int, int, int fq) const { return part4(ssql + (size_t)row * 16, fq, 3); }
    __device__ __forceinline__ void apply(const Ctx& ctx, const AuxT& ax, int row, int pn, int wc, int fq, float* x1, float* x2) const {
        const float rs = __builtin_amdgcn_rsqf(red4(ax) * (1.0f / 768.0f) + EPS) * (0.10206207261596577f * LOG2E);
#pragma unroll
        for (int j = 0; j < 8; ++j) { x1[j] *= rs; x2[j] *= rs; }
        const int p = wc * 32 + fq * 8;
        if (pn < 2) { const int c1 = pn * 256 + p, c2 = c1 + 128; st8(q + (size_t)row * 768 + (c1 >> 6) * 96 + (c1 & 63), x1); st8(q + (size_t)row * 768 + (c2 >> 6) * 96 + (c2 & 63), x2); }
        else { rope8(x1, x2, ctx, row & (SEQ - 1)); bf16* d = q + (size_t)row * 768 + (p >> 4) * 96 + 64 + (p & 15); st8(d, x1); st8(d + 16, x2); }
    }
};
struct NoCtx { };
struct FUkv {
    typedef f32x4 AuxT; typedef NoCtx Ctx; static constexpr int BATCH = 8;
    const float* ssql; bf16* kn;
    __device__ __forceinline__ Ctx begin(int, int, int) const { return Ctx{}; }
    __device__ __forceinline__ AuxT load(int row, int, int, int) const { return *(const f32x4*)(ssql + (size_t)row * 16 + 12); }
    __device__ __forceinline__ void apply(const Ctx&, const AuxT& ax, int row, int pn, int wc, int fq, float* x1, float* x2) const {
        const float rs = __builtin_amdgcn_rsqf(((ax.x + ax.y) + (ax.z + ax.w)) * (1.0f / 256.0f) + EPS);
#pragma unroll
        for (int j = 0; j < 8; ++j) { x1[j] *= rs; x2[j] *= rs; }
        const int p = wc * 32 + fq * 8; bf16* d = kn + (size_t)(pn >> 1) * (size_t)(32 * MiB) + (size_t)row * 512 + (pn & 1) * 256 + p; st8(d, x1); st8(d + 128, x2);
    }
};
struct ResAux { u32x4 a, b; f32x4 s; };
template <bool SCALE> struct FRes {
    typedef ResAux AuxT; typedef NoCtx Ctx; static constexpr int BATCH = RES_BATCH;
    bf16* xb; const float* ssq_in; float* ssq_out;
    __device__ __forceinline__ Ctx begin(int, int, int) const { return Ctx{}; }
    __device__ __forceinline__ AuxT load(int row, int pn, int wc, int fq) const {
        const size_t o = (size_t)row * DM + pn * 256 + wc * 32 + fq * 8; AuxT ax;
        ax.a = *(const u32x4*)(xb + o); ax.b = *(const u32x4*)(xb + o + 128); ax.s = (f32x4){0.f, 0.f, 0.f, 0.f};
        if (SCALE) ax.s = part4(ssq_in + (size_t)row * 16, fq, 4);
        return ax;
    }
    __device__ __forceinline__ void apply(const Ctx&, const AuxT& ax, int row, int pn, int wc, int fq, float* x1, float* x2) const {
        const int p = wc * 32 + fq * 8; const size_t o = (size_t)row * DM + pn * 256 + p;
        if (SCALE) { const float r2 = 1.0f / (red4(ax.s) * (1.0f / DM) + EPS);
#pragma unroll
            for (int j = 0; j < 8; ++j) { x1[j] *= r2; x2[j] *= r2; } }
        float a[8], b[8]; unpack8(ax.a, a); unpack8(ax.b, b);
#pragma unroll
        for (int j = 0; j < 8; ++j) { x1[j] += a[j]; x2[j] += b[j]; }
        st8(xb + o, x1); st8(xb + o + 128, x2);
        const float s = ssq16(x1, x2); if (fq == 0) ssq_out[(size_t)row * 16 + pn * 4 + wc] = s;
    }
};
struct FFf1 {
    typedef int AuxT; typedef NoCtx Ctx; static constexpr int BATCH = 8;
    bf16* h;
    __device__ __forceinline__ Ctx begin(int, int, int) const { return Ctx{}; }
    __device__ __forceinline__ AuxT load(int, int, int, int) const { return 0; }
    __device__ __forceinline__ void apply(const Ctx&, const AuxT&, int row, int pn, int wc, int fq, float* x1, float* x2) const {
#pragma unroll
        for (int j = 0; j < 8; ++j) { const float a = fmaxf(x1[j], 0.f), b = fmaxf(x2[j], 0.f); x1[j] = a * a; x2[j] = b * b; }
        const int p = wc * 32 + fq * 8; bf16* d = h + (size_t)row * FF + pn * 256 + p; st8nt(d, x1); st8nt(d + 128, x2);
    }
};

struct FNull {
    typedef int AuxT; typedef NoCtx Ctx; static constexpr int BATCH = 8;
    __device__ __forceinline__ Ctx begin(int, int, int) const { return Ctx{}; }
    __device__ __forceinline__ AuxT load(int, int, int, int) const { return 0; }
    __device__ __forceinline__ void apply(const Ctx&, const AuxT&, int, int, int, int, float* x1, float* x2) const {
#pragma unroll
        for (int j = 0; j < 8; ++j) asm volatile("" :: "v"(x1[j]), "v"(x2[j])); }
};
#if MK_NAIVE_GEMM
template <class Epi, class Sched>
__device__ __forceinline__ void gemm_phase_x(LAS unsigned char*, const pg8::Gemm g, const Sched& S, const Epi& E, const int wave_id) {
    const int tid = tid_here(), wid = wave_id, lane = tid & 63, wr = wid >> 2, wc = wid & 3, fr = lane & 15, fq = lane >> 4;
    pg8::Unit u;
    for (int it = 0; S.next(it, u); ++it) {
        pg8::f32x4 acc[2][2][4][2];
#pragma unroll
        for (int a = 0; a < 2; ++a)
#pragma unroll
            for (int b = 0; b < 2; ++b)
#pragma unroll
                for (int m = 0; m < 4; ++m)
#pragma unroll
                    for (int n = 0; n < 2; ++n) acc[a][b][m][n] = (pg8::f32x4){0.f, 0.f, 0.f, 0.f};
        for (int k = 0; k < g.K; k += 8) {
            float bv[2][8][8];
#pragma unroll
            for (int bj = 0; bj < 2; ++bj)
#pragma unroll
                for (int c = 0; c < 8; ++c) { const int col = u.pn * 256 + bj * 128 + wc * 32 + fq * 8 + c; unpack8(*(const u32x4*)(g.Bt + (size_t)col * g.K + k), bv[bj][c]); }
#pragma unroll
            for (int ai = 0; ai < 2; ++ai)
#pragma unroll
                for (int m = 0; m < 4; ++m) { const int row = u.pm * 256 + ai * 128 + wr * 64 + m * 16 + fr; float av[8]; unpack8(*(const u32x4*)(g.A + (size_t)row * g.K + k), av);
#pragma unroll
                    for (int bj = 0; bj < 2; ++bj)
#pragma unroll
                        for (int c = 0; c < 8; ++c) { float s = 0.f;
#pragma unroll
                            for (int j = 0; j < 8; ++j) s += av[j] * bv[bj][c][j];
                            acc[ai][bj][m][c >> 2][c & 3] += s; } }
        }
        E(acc, u, wr, wc, fr, fq);
    }
    __syncthreads();
}
#define GEMM_PHASE(EpiType, lds, g, S, E) gemm_phase_x<EpiType, pg8::StaticOrder>(lds, g, S, E, wave_id)
#else
#define GEMM_PHASE(EpiType, lds, g, S, E) pg8::gemm_phase<EpiType, pg8::StaticOrder, true, true>(lds, g, S, E, wave_id)
#endif
#if PROBE_KL
#define KL_RUN(bit, FT, ...) do { EpiT<FT> E{FT{__VA_ARGS__}}; for (int rep_ = 0; rep_ < ((PROBE_KL >> (bit)) & 1) + 1; ++rep_) { __syncthreads(); if (tid_here() == 0) *(volatile LAS unsigned*)(lds + MISC_OFF + 128) = (rep_ + 1 < ((PROBE_KL >> (bit)) & 1) + 1) ? 1u : 0u; __syncthreads(); GEMM_PHASE(EpiT<FT>, lds, g, S, E); } } while (0)
#else
#define KL_RUN(bit, FT, ...) do { EpiT<FT> E{FT{__VA_ARGS__}}; GEMM_PHASE(EpiT<FT>, lds, g, S, E); } while (0)
#endif

__device__ __forceinline__ void mla_naive(const bf16* Q, const bf16* KN, const bf16* MS, const bf16* V, bf16* O, const int wave_id) {
    const int tid = tid_here();
    for (int u = blockIdx.x; u < BATCH * 8 * 4; u += gridDim.x) {
        const int b = u >> 5, h = (u >> 2) & 7, tb = u & 3, t = tb * 512 + tid; const size_t row = (size_t)b * SEQ + t;
        float q[96], o[64];
#pragma unroll
        for (int c = 0; c < 12; ++c) unpack8(*(const u32x4*)(Q + row * 768 + h * 96 + c * 8), q + c * 8);
#pragma unroll
        for (int d = 0; d < 64; ++d) o[d] = 0.f;
        float mx = -1e30f, l = 0.f;
        const int smax = tb * 512 + (tid | 63);
        for (int s = 0; s <= smax; ++s) {
            const size_t rs = (size_t)b * SEQ + s; float sc = 0.f;
#pragma unroll
            for (int c = 0; c < 8; ++c) { float k[8]; unpack8(*(const u32x4*)(KN + rs * 512 + h * 64 + c * 8), k);
#pragma unroll
                for (int j = 0; j < 8; ++j) sc += q[c * 8 + j] * k[j]; }
#pragma unroll
            for (int c = 0; c < 4; ++c) { float k[8]; unpack8(*(const u32x4*)(MS + rs * 256 + 64 + c * 8), k);
#pragma unroll
                for (int j = 0; j < 8; ++j) sc += q[64 + c * 8 + j] * k[j]; }
            if (s <= t) {
                const float mn = fmaxf(mx, sc), a = __builtin_amdgcn_exp2f(mx - mn), pp = __builtin_amdgcn_exp2f(sc - mn);
                l = l * a + pp; mx = mn;
#pragma unroll
                for (int c = 0; c < 8; ++c) { float v[8]; unpack8(*(const u32x4*)(V + rs * 512 + h * 64 + c * 8), v);
#pragma unroll
                    for (int j = 0; j < 8; ++j) o[c * 8 + j] = o[c * 8 + j] * a + pp * v[j]; }
            }
        }
        const float inv = 1.0f / l;
#pragma unroll
        for (int c = 0; c < 8; ++c) { float w[8];
#pragma unroll
            for (int j = 0; j < 8; ++j) w[j] = o[c * 8 + j] * inv;
            st8(O + row * DM + h * 64 + c * 8, w); }
    }
}
__device__ __forceinline__ void dsa_naive(const bf16* AQ, const bf16* MS, const unsigned* BM, bf16* O, const int wave_id) {
    const int tid = tid_here();
    for (int u = blockIdx.x; u < BATCH * 4 * 4; u += gridDim.x) {
        const int b = u >> 4, h = (u >> 2) & 3, tb = u & 3, t = tb * 512 + tid; const size_t row = (size_t)b * SEQ + t;
        float q[64], o[64];
#pragma unroll
        for (int c = 0; c < 8; ++c) { unpack8(*(const u32x4*)(AQ + row * 256 + h * 64 + c * 8), q + c * 8);
#pragma unroll
            for (int j = 0; j < 8; ++j) q[c * 8 + j] *= 1.0f; }
#pragma unroll
        for (int d = 0; d < 64; ++d) o[d] = 0.f;
        float mx = -1e30f, l = 0.f; unsigned word = 0;
        const int smax = tb * 512 + (tid | 63);
        for (int s = 0; s <= smax; ++s) {
            if ((s & 31) == 0) word = BM[row * 64 + (s >> 5)];
            const bool sel = (s <= t) && ((word >> (s & 31)) & 1u);
            if (sel) {
                const size_t rs = (size_t)b * SEQ + s; float sc = 0.f;
#pragma unroll
                for (int c = 0; c < 8; ++c) { float k[8]; unpack8(*(const u32x4*)(MS + rs * 256 + c * 8), k);
#pragma unroll
                    for (int j = 0; j < 8; ++j) sc += q[c * 8 + j] * k[j]; }
                const float mn = fmaxf(mx, sc), a = __builtin_amdgcn_exp2f(mx - mn), pp = __builtin_amdgcn_exp2f(sc - mn);
                l = l * a + pp; mx = mn;
#pragma unroll
                for (int c = 0; c < 8; ++c) { float v[8]; unpack8(*(const u32x4*)(MS + rs * 256 + 128 + c * 8), v);
#pragma unroll
                    for (int j = 0; j < 8; ++j) o[c * 8 + j] = o[c * 8 + j] * a + pp * v[j]; }
            }
        }
        const float inv = 1.0f / l;
#pragma unroll
        for (int c = 0; c < 8; ++c) { float w[8];
#pragma unroll
            for (int j = 0; j < 8; ++j) w[j] = o[c * 8 + j] * inv;
            st8(O + row * DM + 512 + h * 64 + c * 8, w); }
    }
}
typedef float f32x2s __attribute__((ext_vector_type(2)));
__device__ __forceinline__ f32x2s pk_gt(f32x2s v, f32x2s big, f32x2s nm) { f32x2s e; asm("v_pk_fma_f32 %0, %1, %2, %3 clamp" : "=v"(e) : "v"(v), "v"(big), "v"(nm)); return e; }
__device__ __forceinline__ float max3_raw(float a, float b, float c) { float r; asm("v_max3_f32 %0, %1, %2, %3" : "=v"(r) : "v"(a), "v"(b), "v"(c)); return r; }
__device__ __forceinline__ float min3_raw(float a, float b, float c) { float r; asm("v_min3_f32 %0, %1, %2, %3" : "=v"(r) : "v"(a), "v"(b), "v"(c)); return r; }
__device__ __forceinline__ float wave_sum_f(float x) {
    x += __int_as_float(DPP_I(__float_as_int(x), 0xB1)); x += __int_as_float(DPP_I(__float_as_int(x), 0x4E)); x += __int_as_float(DPP_I(__float_as_int(x), 0x141)); x += __int_as_float(DPP_I(__float_as_int(x), 0x140));
    const int xi = __float_as_int(x);
    return (__int_as_float(__builtin_amdgcn_readlane(xi, 0)) + __int_as_float(__builtin_amdgcn_readlane(xi, 16))) + (__int_as_float(__builtin_amdgcn_readlane(xi, 32)) + __int_as_float(__builtin_amdgcn_readlane(xi, 48))); }
__device__ __forceinline__ int fkey(int u) { return u ^ ((u >> 31) & 0x7fffffff); }
template <int NR>
__device__ __forceinline__ void select_row(const f32x2s (&vp)[NR / 2], int nk, u64* bm, int lane) {
    static_assert(NR % 2 == 0, "pairs");
    float mx = vp[0].x, mn = vp[0].x;
#pragma unroll
    for (int j = 0; j < NR / 2; ++j) { mx = max3_raw(mx, vp[j].x, vp[j].y); mn = min3_raw(mn, vp[j].x, vp[j].y); }
    float hi = wave_max_f(mx); const float mnw = wave_min_f(mn);
    float lo = mnw - fabsf(mnw) * 1e-3f - 1e-3f;
    int clo = nk, chi = 0;
    bool exact = false; float thr = hi;
    float bigs = 1.152921504606847e18f, zf = 0.f; asm volatile("" : "+v"(bigs), "+v"(zf));
    const f32x2s big = {bigs, bigs};
    constexpr int NS = (NR == 8) ? 4 : NR - 8;
#define OPQ(c) ({ float c_ = (c); asm volatile("" : "+v"(c_)); c_; })
    f32x2s s1 = {zf, zf}, s2 = {zf, zf};
#pragma unroll
    for (int j = 0; j < NS / 2; ++j) { s1 += vp[j]; s2 += vp[j] * vp[j]; }
    const float S1 = wave_sum_f(s1.x + s1.y), S2 = wave_sum_f(s2.x + s2.y);
    const float invn = OPQ(1.0f / (64.0f * NS));
    float mu = S1 * invn; asm volatile("" : "+v"(mu));
    float var = fmaxf(__builtin_fmaf(S2, invn, -mu * mu), OPQ(1e-20f)); asm volatile("" : "+v"(var));
    float sd = var * __builtin_amdgcn_rsqf(var); asm volatile("" : "+v"(sd));
    float pq = 1.0f - OPQ(256.5f) * __builtin_amdgcn_rcpf((float)nk); pq = fminf(fmaxf(pq, OPQ(0.025f)), OPQ(0.975f));
    const float z = __builtin_amdgcn_logf(pq * __builtin_amdgcn_rcpf(1.0f - pq)) * OPQ(0.40725434f);
    float zz2 = z * z; asm volatile("" : "+v"(zz2));
    float rdens = sd * __builtin_amdgcn_rcpf((float)nk * OPQ(0.3989422804f) * __builtin_amdgcn_exp2f(OPQ(-0.72134752f) * zz2));
    asm volatile("" : "+v"(rdens));
    float nxt = __builtin_fmaf(z, sd, mu); asm volatile("" : "+v"(nxt)); bool have_nxt = true; int nsteps = 0;
    for (int it = 0; it < 200; ++it) {
        const int kl = fkey(__float_as_int(lo)), kh = fkey(__float_as_int(hi));
        if ((unsigned)kh - (unsigned)kl <= 1u) break;
        const float kmid = __int_as_float(fkey(kl + (int)(((unsigned)kh - (unsigned)kl) >> 1)));
        float mid = 0.5f * lo + 0.5f * hi;
        const bool third = (it % 3 == 2);
        if (third || !(mid > lo) || !(mid < hi)) mid = kmid;
        if (have_nxt) { if (nxt > lo && nxt < hi) mid = nxt; have_nxt = false; }
        else if (!third) { const float gq = lo + (hi - lo) * (((float)(clo - 256) + 0.5f) * __builtin_amdgcn_rcpf((float)(clo - chi))); if (gq > lo && gq < hi) mid = gq; }
        const float nmv = -mid * 1.152921504606847e18f; const f32x2s nm = {nmv, nmv};
        f32x2s acc0 = {zf, zf}, acc1 = {zf, zf}, acc2 = {zf, zf}, acc3 = {zf, zf};
#pragma unroll
        for (int j = 0; j < NR / 2; j += 4) { acc0 += pk_gt(vp[j], big, nm); acc1 += pk_gt(vp[j + 1], big, nm); acc2 += pk_gt(vp[j + 2], big, nm); acc3 += pk_gt(vp[j + 3], big, nm); }
        const f32x2s acc = (acc0 + acc1) + (acc2 + acc3);
        const int c = (int)wave_sum_f(acc.x + acc.y);
        if (c == 256) { exact = true; thr = mid; break; }
        if (c > 256) { lo = mid; clo = c; } else { hi = mid; chi = c; }
        if (nsteps < 2) { ++nsteps; nxt = mid + ((float)(c - 256) + 0.5f) * rdens; have_nxt = true; }
    }
    if (exact) {
#pragma unroll
        for (int j = 0; j < NR / 2; ++j) { const u64 w0 = __ballot(vp[j].x > thr), w1 = __ballot(vp[j].y > thr); bm[2 * j] = w0; bm[2 * j + 1] = w1; }
    } else {
        const int need = 256 - chi; int tr = 0; const u64 lt = (1ull << lane) - 1ull;
#pragma unroll
        for (int i = 0; i < NR; ++i) { const float x = (i & 1) ? vp[i >> 1].y : vp[i >> 1].x; const bool gt = x > hi, tie = (x == hi); const u64 tb = __ballot(tie); const int rank = tr + __popcll(tb & lt); tr += __popcll(tb);
            const u64 w = __ballot(gt || (tie && rank < need)); bm[i] = w; }
    }
}
__device__ __forceinline__ void select_naive(LAS unsigned char* lds, const bf16* QI, const bf16* MS, const float* WI, u64* BM, const int wave_id) {
    const int tid = tid_here(), wave = wave_id, lane = tid & 63;
    LAS float* sc_lds = (LAS float*)(lds + wave * 8192);
    LAS float* qi_lds = (LAS float*)(lds + 65536 + wave * 1024);
    for (int qb = blockIdx.x; qb < M / 8; qb += gridDim.x) {
        const int row = qb * 8 + wave, b = row >> 11, t = row & (SEQ - 1);
        u64* bm = BM + (size_t)row * 32;
        if (t < 256) { if (lane < 32) { const int k0 = 64 * lane; bm[lane] = (t >= k0 + 63) ? ~0ull : (t < k0 ? 0ull : ((1ull << (t - k0 + 1)) - 1ull)); } continue; }
        { const u32x2 r = *(const u32x2*)(QI + (size_t)row * 256 + lane * 4); qi_lds[lane * 4] = bf_lo(r.x); qi_lds[lane * 4 + 1] = bf_hi(r.x); qi_lds[lane * 4 + 2] = bf_lo(r.y); qi_lds[lane * 4 + 3] = bf_hi(r.y); }
        float w8[8];
#pragma unroll
        for (int hh = 0; hh < 8; ++hh) w8[hh] = WI[(size_t)row * 8 + hh];
        LDS_WAIT();
        const int nk = t + 1;
        for (int s0 = 0; s0 < nk; s0 += 64) {
            const int s = s0 + lane; float scv = -INFINITY;
            if (s < nk) { float k[32];
#pragma unroll
                for (int c = 0; c < 4; ++c) unpack8(*(const u32x4*)(MS + ((size_t)b * SEQ + s) * 256 + 96 + c * 8), k + c * 8);
                scv = 0.f;
#pragma unroll
                for (int hh = 0; hh < 8; ++hh) { float d = 0.f;
#pragma unroll
                    for (int j = 0; j < 32; ++j) d += qi_lds[hh * 32 + j] * k[j];
                    scv += w8[hh] * fmaxf(d, 0.f); } }
            sc_lds[s] = scv; }
        LDS_WAIT();
        float v[32];
#pragma unroll
        for (int i = 0; i < 32; ++i) v[i] = (i * 64 + lane < nk) ? sc_lds[i * 64 + lane] : __builtin_nanf("");
        { f32x2s vp[16];
#pragma unroll
          for (int i = 0; i < 32; ++i) { if (i & 1) vp[i >> 1].y = v[i]; else vp[i >> 1].x = v[i]; }
          select_row<32>(vp, nk, bm, lane); }
        LDS_WAIT();
    }
}
__device__ __forceinline__ void ret_naive(const bf16* RQ, const bf16* RK, const bf16* RV, const bf16* RG, const float* g_ret, bf16* O, const int wave_id) {
    const int tid = tid_here();
    for (int u = blockIdx.x; u < BATCH * 4 * 4; u += gridDim.x) {
        const int b = u >> 4, h = (u >> 2) & 3, tb = u & 3, t = tb * 512 + tid; const size_t row = (size_t)b * SEQ + t;
        const float lg2 = (h == 0) ? -0.045803689613124935f : (h == 1) ? -0.022720076500083562f : (h == 2) ? -0.011315313227834123f : -0.0056465631411395075f;
        float q[64], o[64];
#pragma unroll
        for (int c = 0; c < 8; ++c) unpack8(*(const u32x4*)(RQ + row * 256 + h * 64 + c * 8), q + c * 8);
#pragma unroll
        for (int d = 0; d < 64; ++d) o[d] = 0.f;
        const int smax = tb * 512 + (tid | 63);
        for (int s = 0; s <= smax; ++s) {
            const size_t rs = (size_t)b * SEQ + s; float sc = 0.f;
#pragma unroll
            for (int c = 0; c < 8; ++c) { float k[8]; unpack8(*(const u32x4*)(RK + rs * 256 + h * 64 + c * 8), k);
#pragma unroll
                for (int j = 0; j < 8; ++j) sc += q[c * 8 + j] * k[j]; }
            if (s <= t) {
                const float w = sc * __builtin_amdgcn_exp2f((float)(t - s) * lg2);
#pragma unroll
                for (int c = 0; c < 8; ++c) { float v[8]; unpack8(*(const u32x4*)(RV + rs * 256 + h * 64 + c * 8), v);
#pragma unroll
                    for (int j = 0; j < 8; ++j) o[c * 8 + j] += w * v[j]; }
            }
        }
        float mu = 0.f;
#pragma unroll
        for (int d = 0; d < 64; ++d) mu += o[d];
        mu *= (1.0f / 64.0f); float var = 0.f;
#pragma unroll
        for (int d = 0; d < 64; ++d) { const float e = o[d] - mu; var += e * e; }
        const float rstd = 1.0f / sqrtf(var * (1.0f / 64.0f) + EPS);
#pragma unroll
        for (int c = 0; c < 8; ++c) { float g[8], w[8]; unpack8(*(const u32x4*)(RG + row * 256 + h * 64 + c * 8), g);
#pragma unroll
            for (int j = 0; j < 8; ++j) { const float y = (o[c * 8 + j] - mu) * rstd * g_ret[h * 64 + c * 8 + j]; w[j] = y * g[j] / (1.0f + __expf(-g[j])); }
            st8(O + row * DM + 768 + h * 64 + c * 8, w); }
    }
}

typedef short bf16x8 __attribute__((ext_vector_type(8)));
typedef float f32x16 __attribute__((ext_vector_type(16)));
typedef short s16x4 __attribute__((ext_vector_type(4)));
__device__ __forceinline__ s16x4 ds_tr16(LAS const unsigned char* p) { return __builtin_bit_cast(s16x4, __builtin_amdgcn_ds_read_tr16_b64_v4i16((LAS s16x4*)p)); }
struct TagF { static constexpr bool value = true; }; struct TagG { static constexpr bool value = false; };
template <bool MLA>
__device__ __forceinline__ void attn_phase(LAS unsigned char* lds, const bf16* Qp, const bf16* KNp, const bf16* MSp, const bf16* Vp, const u64* BMp, bf16* Op, const int wave_id) {
    constexpr int DQK = MLA ? 96 : 64, KS = DQK / 16, KP = DQK * 2 + 16, VP = 192, KBUF = 64 * KP, VBUF = 64 * VP, BUF = KBUF + VBUF, QG = 2, NQR = MLA ? ATT_NQR : 4, QSLOT = QG * (KS - NQR) * 1024;
    static_assert(2 * BUF + 8 * QSLOT <= RING_BYTES, "attention LDS");
    const int tid = tid_here(), wave = wave_id, lane = tid & 63, l31 = lane & 31, hi = lane >> 5;
    const int G = gridDim.x, NU = MLA ? 1024 : 512;
    const int keyA = tid >> 3, chA = tid & 7;
    const int vb = (4 * hi + ((lane & 15) >> 2)) * VP + (16 * ((lane >> 4) & 1) + 4 * (lane & 3)) * 2;
    for (int u = blockIdx.x; u < NU; u += G) {
        int b, h, qw0, nt;
        if (MLA) { const int bh = u & 255, r = u >> 8, qb = (r + bh) & 3; b = bh >> 3; h = bh & 7; qw0 = qb * 512 + 64 * wave; nt = 8 * (qb + 1); }
        else { const int bj = u & 255, r = u >> 8, j = bj & 7, qb = (r == 0) ? j : 15 - j; b = bj >> 3; h = wave >> 1; qw0 = qb * 128 + 64 * (wave & 1); nt = 2 * (qb + 1); }
        const int qg0[2] = {MLA ? qw0 - 32 * wave : qw0, MLA ? qw0 - 64 * wave + 32 * (15 - wave) : qw0 + 32};
        const size_t rowb = (size_t)b * SEQ;
        bf16x8 qf[QG][NQR];
        LAS unsigned char* qrl = lds + 2 * BUF + wave * QSLOT + lane * 16;
#pragma unroll
        for (int g = 0; g < QG; ++g)
#pragma unroll
            for (int s = 0; s < KS; ++s) { const bf16* qb_ = Qp + (rowb + qg0[g]) * (MLA ? 768 : 256) + h * DQK + 16 * s;
                const bf16x8 f = *(const bf16x8*)((const char*)qb_ + (unsigned)(l31 * (MLA ? 1536 : 512) + 16 * hi));
                if (s < NQR) qf[g][s < NQR ? s : 0] = f; else *(LAS bf16x8*)(qrl + (g * (KS - NQR) + (s - NQR)) * 1024) = f; }
        f32x16 ot[QG][2];
#pragma unroll
        for (int g = 0; g < QG; ++g)
#pragma unroll
            for (int r = 0; r < 16; ++r) { ot[g][0][r] = 0.f; ot[g][1][r] = 0.f; }
        float mrun[QG], lrun[QG];
#pragma unroll
        for (int g = 0; g < QG; ++g) { mrun[g] = -1e30f; lrun[g] = 0.f; }
        u32x4 sa, sb, sc;
        const unsigned offA_ = 2u * (unsigned)(MLA ? keyA * 512 + chA * 8 : keyA * 256 + chA * 8);
        const unsigned offB_ = 2u * (unsigned)(MLA ? (tid < 256 ? (tid >> 2) * 256 + 64 + (tid & 3) * 8 : ((tid - 256) >> 3) * 512 + chA * 8) : keyA * 256 + 128 + chA * 8);
        const unsigned offC_ = 2u * (unsigned)((32 + keyA) * 512 + chA * 8);
#define ATT_LOAD(j) do { const size_t rk = rowb + 64 * (j); unsigned offA = offA_, offB = offB_, offC = offC_; asm volatile("" : "+v"(offA), "+v"(offB), "+v"(offC));     \
            if (MLA) { const bf16* kb_ = KNp + rk * 512 + h * 64; const bf16* vb2_ = Vp + rk * 512 + h * 64; const bf16* mb_ = MSp + rk * 256; \
                       sa = *(const u32x4*)((const char*)kb_ + offA); \
                       if (tid < 256) { sb = *(const u32x4*)((const char*)mb_ + offB); sc = *(const u32x4*)((const char*)vb2_ + offC); } \
                       else sb = *(const u32x4*)((const char*)vb2_ + offB); } \
            else { const bf16* mb_ = MSp + rk * 256; sa = *(const u32x4*)((const char*)mb_ + offA); sb = *(const u32x4*)((const char*)mb_ + offB); } } while (0)
#define ATT_WRITE(buf) do { LAS unsigned char* kb_ = lds + (buf) * BUF; LAS unsigned char* vb_ = kb_ + KBUF; \
            *(LAS u32x4*)(kb_ + keyA * KP + chA * 16) = sa; \
            if (MLA) { if (tid < 256) { *(LAS u32x4*)(kb_ + (tid >> 2) * KP + 128 + (tid & 3) * 16) = sb; *(LAS u32x4*)(vb_ + (32 + keyA) * VP + chA * 16) = sc; } \
                       else *(LAS u32x4*)(vb_ + ((tid - 256) >> 3) * VP + chA * 16) = sb; } \
            else *(LAS u32x4*)(vb_ + keyA * VP + chA * 16) = sb; } while (0)
        u64 bmw[QG] = {0ull, 0ull};
#define ATT_BMLD(jj) do { if (!MLA) { _Pragma("unroll") for (int g = 0; g < QG; ++g) { const u64* bmb_ = BMp + (rowb + qg0[g]) * 32 + (jj); unsigned lo_ = (unsigned)(l31 * 256); asm volatile("" : "+v"(lo_)); \
            bmw[g] = *(const u64*)((const char*)bmb_ + lo_); } } } while (0)
        ATT_BMLD(0);
        auto tile = [&](auto tag_, const int j) __attribute__((always_inline)) {
            constexpr bool FULL = decltype(tag_)::value;
            u64 bmc[QG] = {bmw[0], bmw[1]};
            if (!MLA && j + 1 < nt) ATT_BMLD(j + 1);
            const bool active = (MLA && !FULL) ? (64 * j <= qg0[1] + 31) : true, act0 = (MLA && !FULL) ? (64 * j <= qg0[0] + 31) : true;
            if (active) {
                LAS const unsigned char* kbuf = lds + (j & 1) * BUF; LAS const unsigned char* vbuf = kbuf + KBUF;
                f32x16 st[QG][2];
#pragma unroll
                for (int g = 0; g < QG; ++g)
#pragma unroll
                    for (int r = 0; r < 16; ++r) { st[g][0][r] = 0.f; st[g][1][r] = 0.f; }
#pragma unroll
                for (int s = 0; s < KS; ++s) {
                    const bf16x8 k0 = *(LAS const bf16x8*)(kbuf + l31 * KP + (16 * s + 8 * hi) * 2), k1 = *(LAS const bf16x8*)(kbuf + (32 + l31) * KP + (16 * s + 8 * hi) * 2);
#pragma unroll
                    for (int g = 0; g < QG; ++g) { if (g == 0 && !act0) continue; bf16x8 qq; if (s < NQR) qq = qf[g][s < NQR ? s : 0]; else qq = *(LAS const bf16x8*)(qrl + (g * (KS - NQR) + (s - NQR)) * 1024);
                        st[g][0] = __builtin_amdgcn_mfma_f32_32x32x16_bf16(k0, qq, st[g][0], 0, 0, 0); st[g][1] = __builtin_amdgcn_mfma_f32_32x32x16_bf16(k1, qq, st[g][1], 0, 0, 0); } }
                bf16x8 pf[QG][4];
#define ATT_MASK(g) do { const int qpos = qg0[g] + l31; \
                    if (MLA) { if (64 * j + 63 > qg0[g]) { const int lim = qpos - 64 * j - 4 * hi; \
                            _Pragma("unroll") for (int r = 0; r < 16; ++r) { const int ko = (r & 3) + 8 * (r >> 2); if (ko > lim) st[g][0][r] = -INFINITY; if (ko + 32 > lim) st[g][1][r] = -INFINITY; } } } \
                    else { \
                        const u64 w = bmc[g]; const unsigned wlo = (unsigned)(w >> (4 * hi)), whi = (unsigned)(w >> (32 + 4 * hi)); \
                        _Pragma("unroll") for (int r = 0; r < 16; ++r) { const int ko = (r & 3) + 8 * (r >> 2); \
                            { const unsigned m_ = (unsigned)__builtin_amdgcn_sbfe((int)wlo, ko, 1); st[g][0][r] = __uint_as_float((m_ & __float_as_uint(st[g][0][r])) | (~m_ & 0xff800000u)); } \
                            { const unsigned m_ = (unsigned)__builtin_amdgcn_sbfe((int)whi, ko, 1); st[g][1][r] = __uint_as_float((m_ & __float_as_uint(st[g][1][r])) | (~m_ & 0xff800000u)); } } } } while (0)
#define ATT_MX3(a, b, c) __builtin_fmaxf(__builtin_fmaxf((a), (b)), (c))
#define ATT_MAXR(g, mt) do { float ma_ = st[g][0][0], mb_ = st[g][1][0]; \
                    _Pragma("unroll") for (int r = 1; r < 16; r += 2) { ma_ = ATT_MX3(ma_, st[g][0][r], st[g][0][r + 1 < 16 ? r + 1 : r]); mb_ = ATT_MX3(mb_, st[g][1][r], st[g][1][r + 1 < 16 ? r + 1 : r]); } \
                    mt = xhalf_max(__builtin_fmaxf(ma_, mb_)); } while (0)
#define ATT_RESC(g, mt) do { const float mn0 = fmaxf(mrun[g], mt), alpha = __builtin_amdgcn_exp2f(mrun[g] - mn0); mrun[g] = mn0; lrun[g] *= alpha; \
                    _Pragma("unroll") for (int r = 0; r < 16; ++r) { ot[g][0][r] *= alpha; ot[g][1][r] *= alpha; } } while (0)
#define ATT_EXPS(g) do { const float mn = mrun[g]; float ps = 0.f; \
                    _Pragma("unroll") for (int r = 0; r < 16; ++r) { st[g][0][r] = __builtin_amdgcn_exp2f(st[g][0][r] - mn); st[g][1][r] = __builtin_amdgcn_exp2f(st[g][1][r] - mn); ps += st[g][0][r] + st[g][1][r]; } \
                    lrun[g] += ps; \
                    _Pragma("unroll") for (int t = 0; t < 2; ++t) _Pragma("unroll") for (int s = 0; s < 2; ++s) { u32x4 a; a.x = cvtpk(st[g][t][8 * s], st[g][t][8 * s + 1]); a.y = cvtpk(st[g][t][8 * s + 2], st[g][t][8 * s + 3]); \
                            a.z = cvtpk(st[g][t][8 * s + 4], st[g][t][8 * s + 5]); a.w = cvtpk(st[g][t][8 * s + 6], st[g][t][8 * s + 7]); pf[g][2 * t + s] = __builtin_bit_cast(bf16x8, a); } } while (0)
                if (FULL || !MLA) {
                    float mt0, mt1;
                    if (!FULL) { ATT_MASK(0); ATT_MASK(1); } ATT_MAXR(0, mt0); ATT_MAXR(1, mt1);
                    if (__builtin_amdgcn_ballot_w64((mt0 > mrun[0] + 6.0f) || (mt1 > mrun[1] + 6.0f)) != 0ull) { ATT_RESC(0, mt0); ATT_RESC(1, mt1); }
                    __builtin_amdgcn_sched_barrier(0); ATT_EXPS(0); __builtin_amdgcn_sched_barrier(0); ATT_EXPS(1);
                } else {
                    if (act0) { float mt0; ATT_MASK(0); ATT_MAXR(0, mt0); if (__builtin_amdgcn_ballot_w64(mt0 > mrun[0] + 6.0f) != 0ull) { ATT_RESC(0, mt0); } ATT_EXPS(0); }
                    float mt1;
                    ATT_MASK(1); ATT_MAXR(1, mt1);
                    if (__builtin_amdgcn_ballot_w64(mt1 > mrun[1] + 6.0f) != 0ull) { ATT_RESC(1, mt1); }
                    ATT_EXPS(1);
                }
#undef ATT_MASK
#undef ATT_MAXR
#undef ATT_RESC
#undef ATT_EXPS
#pragma unroll
                for (int ks = 0; ks < 4; ++ks) {
                    const s16x4 a0 = ds_tr16(vbuf + vb + (16 * ks) * VP), a1 = ds_tr16(vbuf + vb + (16 * ks + 8) * VP), c0 = ds_tr16(vbuf + vb + (16 * ks) * VP + 64), c1 = ds_tr16(vbuf + vb + (16 * ks + 8) * VP + 64);
                    const bf16x8 v0 = {a0[0], a0[1], a0[2], a0[3], a1[0], a1[1], a1[2], a1[3]}, v1 = {c0[0], c0[1], c0[2], c0[3], c1[0], c1[1], c1[2], c1[3]};
#pragma unroll
                    for (int g = 0; g < QG; ++g) { if (g == 0 && !act0) continue; ot[g][0] = __builtin_amdgcn_mfma_f32_32x32x16_bf16(v0, pf[g][ks], ot[g][0], 0, 0, 0); ot[g][1] = __builtin_amdgcn_mfma_f32_32x32x16_bf16(v1, pf[g][ks], ot[g][1], 0, 0, 0); } }
            }
        };
        const int jf = (MLA && ATT_SPLIT) ? (((qg0[0] + 1) >> 6) < nt ? ((qg0[0] + 1) >> 6) : nt) : 0;
        ATT_LOAD(0); ATT_WRITE(0); __syncthreads();
        int j = 0;
        if (MLA && ATT_SPLIT) {
            for (; j < jf; ++j) {
                const bool more = (j + 1 < nt);
                if (more) ATT_LOAD(j + 1);
                tile(TagF{}, j);
                if (more) ATT_WRITE((j + 1) & 1);
                __syncthreads();
            }
        }
        for (; j < nt; ++j) {
            const bool more = (j + 1 < nt);
            if (more) ATT_LOAD(j + 1);
            tile(TagG{}, j);
            if (more) ATT_WRITE((j + 1) & 1);
            __syncthreads();
        }
#undef ATT_LOAD
#undef ATT_BMLD
#undef ATT_WRITE
        const int le = lane_here(), l31e = le & 31, hie = le >> 5;
#pragma unroll
        for (int g = 0; g < QG; ++g) {
            const float inv = 1.0f / xhalf_sum(lrun[g]);
            bf16* orow = Op + (rowb + qg0[g] + l31e) * DM + (MLA ? h * 64 : 512 + h * 64) + 8 * hie;
#pragma unroll
            for (int t = 0; t < 2; ++t)
#pragma unroll
                for (int k = 0; k < 4; k += 2) {
                    u32x2 a, b2; a.x = cvtpk(ot[g][t][4 * k] * inv, ot[g][t][4 * k + 1] * inv); a.y = cvtpk(ot[g][t][4 * k + 2] * inv, ot[g][t][4 * k + 3] * inv);
                    b2.x = cvtpk(ot[g][t][4 * k + 4] * inv, ot[g][t][4 * k + 5] * inv); b2.y = cvtpk(ot[g][t][4 * k + 6] * inv, ot[g][t][4 * k + 7] * inv);
                    const auto rx = __builtin_amdgcn_permlane32_swap(a.x, b2.x, false, false); const auto ry = __builtin_amdgcn_permlane32_swap(a.y, b2.y, false, false);
                    u32x4 w; w.x = rx[0]; w.y = ry[0]; w.z = rx[1]; w.w = ry[1];
                    *(u32x4*)(orow + 32 * t + 8 * k) = w; }
        }
    }
}

__device__ __forceinline__ void ret_phase(LAS unsigned char* lds, const bf16* RQ, const bf16* RK, const bf16* RV, const bf16* RG, const float* g_ret, bf16* Op, const int wave_id) {
    constexpr int KP = 144, VP = 192, OFF_K = 0, OFF_V = 128 * KP, OFF_Z = OFF_V + 128 * VP, OFF_R = OFF_Z + 128 * VP;
    const int tid = tid_here(), wave = wave_id, lane = tid & 63, l31 = lane & 31, hi = lane >> 5;
    const int trq = (lane & 15) >> 2, trc = (16 * ((lane >> 4) & 1) + 4 * (lane & 3)) * 2;
    const int trn = (8 * hi + trq) * VP + trc, trp = (4 * hi + trq) * VP + trc;
    LAS unsigned char* KT = lds + OFF_K; LAS unsigned char* VT = lds + OFF_V; LAS unsigned char* KZ = lds + OFF_Z; LAS unsigned char* RT = lds + OFF_R;
    for (int u = blockIdx.x; u < BATCH * 4; u += gridDim.x) {
        const int b = u >> 2, h = u & 3; const size_t rowb = (size_t)b * SEQ;
        const float lg = (h == 0) ? -0.04580368961312479f : (h == 1) ? -0.02272007650008353f : (h == 2) ? -0.011315313227834146f : -0.005646563141142063f;
        { unsigned zz = 0u; asm volatile("" : "+v"(zz)); *(LAS u32x4*)(RT + (tid >> 3) * VP + (tid & 7) * 16) = (u32x4){zz, zz, zz, zz}; }
        f32x16 sacc;
#pragma unroll
        for (int r = 0; r < 16; ++r) sacc[r] = 0.f;
        u32x4 k0, k1, v0, v1;
#define RET_LOAD(n) do { const size_t r0 = rowb + 128 * (n) + (tid >> 3), r1 = r0 + 64; const int co = h * 64 + (tid & 7) * 8; \
            k0 = *(const u32x4*)(RK + r0 * 256 + co); k1 = *(const u32x4*)(RK + r1 * 256 + co); v0 = *(const u32x4*)(RV + r0 * 256 + co); v1 = *(const u32x4*)(RV + r1 * 256 + co); } while (0)
        RET_LOAD(0);
        for (int n = 0; n < 16; ++n) {
            {
                const int r0 = tid >> 3, cb = (tid & 7) * 16;
                *(LAS u32x4*)(KT + r0 * KP + cb) = k0; *(LAS u32x4*)(KT + (r0 + 64) * KP + cb) = k1; *(LAS u32x4*)(VT + r0 * VP + cb) = v0; *(LAS u32x4*)(VT + (r0 + 64) * VP + cb) = v1;
                float f[8]; const float z0 = __builtin_amdgcn_exp2f((float)(127 - r0) * lg), z1 = __builtin_amdgcn_exp2f((float)(63 - r0) * lg);
                unpack8(k0, f);
#pragma unroll
                for (int j = 0; j < 8; ++j) f[j] *= z0;
                { u32x4 w; w.x = cvtpk(f[0], f[1]); w.y = cvtpk(f[2], f[3]); w.z = cvtpk(f[4], f[5]); w.w = cvtpk(f[6], f[7]); *(LAS u32x4*)(KZ + r0 * VP + cb) = w; }
                unpack8(k1, f);
#pragma unroll
                for (int j = 0; j < 8; ++j) f[j] *= z1;
                { u32x4 w; w.x = cvtpk(f[0], f[1]); w.y = cvtpk(f[2], f[3]); w.z = cvtpk(f[4], f[5]); w.w = cvtpk(f[6], f[7]); *(LAS u32x4*)(KZ + (r0 + 64) * VP + cb) = w; }
            }
            const int posq = 32 * wave + l31; const size_t rowq = rowb + 128 * n + (wave < 4 ? posq : 0);
            bf16x8 qf[4];
            if (wave < 4) {
#pragma unroll
                for (int s = 0; s < 4; ++s) qf[s] = *(const bf16x8*)(RQ + rowq * 256 + h * 64 + 16 * s + 8 * hi); }
            __syncthreads();
            if (n + 1 < 16) RET_LOAD(n + 1);
            f32x16 a0, a1;
            if (wave < 4) {
#pragma unroll
                for (int r = 0; r < 16; ++r) { a0[r] = 0.f; a1[r] = 0.f; }
#pragma unroll
                for (int s = 0; s < 4; ++s) {
                    const s16x4 x0 = ds_tr16(RT + trn + (16 * s) * VP), x1 = ds_tr16(RT + trn + (16 * s + 4) * VP), y0 = ds_tr16(RT + trn + (16 * s) * VP + 64), y1 = ds_tr16(RT + trn + (16 * s + 4) * VP + 64);
                    const bf16x8 f0 = {x0[0], x0[1], x0[2], x0[3], x1[0], x1[1], x1[2], x1[3]}, f1 = {y0[0], y0[1], y0[2], y0[3], y1[0], y1[1], y1[2], y1[3]};
                    a0 = __builtin_amdgcn_mfma_f32_32x32x16_bf16(f0, qf[s], a0, 0, 0, 0); a1 = __builtin_amdgcn_mfma_f32_32x32x16_bf16(f1, qf[s], a1, 0, 0, 0); }
                const float xi = __builtin_amdgcn_exp2f((float)(posq + 1) * lg);
#pragma unroll
                for (int r = 0; r < 16; ++r) { a0[r] *= xi; a1[r] *= xi; }
#pragma unroll 1
                for (int kt = 0; kt <= wave; ++kt) {
                    {
                        f32x16 st;
#pragma unroll
                        for (int r = 0; r < 16; ++r) st[r] = 0.f;
#pragma unroll
                        for (int s = 0; s < 4; ++s) { const bf16x8 kf = *(LAS const bf16x8*)(KT + (32 * kt + l31) * KP + (16 * s + 8 * hi) * 2); st = __builtin_amdgcn_mfma_f32_32x32x16_bf16(kf, qf[s], st, 0, 0, 0); }
#pragma unroll
                        for (int r = 0; r < 16; ++r) { const int rel = posq - (32 * kt + (r & 3) + 8 * (r >> 2) + 4 * hi); const float w = __builtin_amdgcn_exp2f((float)rel * lg); st[r] = (rel >= 0) ? st[r] * w : 0.f; }
#pragma unroll
                        for (int s = 0; s < 2; ++s) {
                            u32x4 pw; pw.x = cvtpk(st[8 * s], st[8 * s + 1]); pw.y = cvtpk(st[8 * s + 2], st[8 * s + 3]); pw.z = cvtpk(st[8 * s + 4], st[8 * s + 5]); pw.w = cvtpk(st[8 * s + 6], st[8 * s + 7]);
                            const bf16x8 pf = __builtin_bit_cast(bf16x8, pw);
                            const int ro = (32 * kt + 16 * s) * VP;
                            const s16x4 x0 = ds_tr16(VT + trp + ro), x1 = ds_tr16(VT + trp + ro + 8 * VP), y0 = ds_tr16(VT + trp + ro + 64), y1 = ds_tr16(VT + trp + ro + 8 * VP + 64);
                            const bf16x8 f0 = {x0[0], x0[1], x0[2], x0[3], x1[0], x1[1], x1[2], x1[3]}, f1 = {y0[0], y0[1], y0[2], y0[3], y1[0], y1[1], y1[2], y1[3]};
                            a0 = __builtin_amdgcn_mfma_f32_32x32x16_bf16(f0, pf, a0, 0, 0, 0); a1 = __builtin_amdgcn_mfma_f32_32x32x16_bf16(f1, pf, a1, 0, 0, 0); }
                    }
                }
            } else {
                const int et = wave & 1, dt = (wave >> 1) & 1; const float cd = __builtin_amdgcn_exp2f(128.0f * lg);
#pragma unroll
                for (int r = 0; r < 16; ++r) sacc[r] *= cd;
#pragma unroll
                for (int s = 0; s < 8; ++s) {
                    const s16x4 x0 = ds_tr16(VT + trn + (16 * s) * VP + et * 64), x1 = ds_tr16(VT + trn + (16 * s + 4) * VP + et * 64), y0 = ds_tr16(KZ + trn + (16 * s) * VP + dt * 64), y1 = ds_tr16(KZ + trn + (16 * s + 4) * VP + dt * 64);
                    const bf16x8 fa = {x0[0], x0[1], x0[2], x0[3], x1[0], x1[1], x1[2], x1[3]}, fb = {y0[0], y0[1], y0[2], y0[3], y1[0], y1[1], y1[2], y1[3]};
                    sacc = __builtin_amdgcn_mfma_f32_32x32x16_bf16(fa, fb, sacc, 0, 0, 0); }
            }
            __syncthreads();
            if (wave < 4) {
                float s1 = 0.f;
#pragma unroll
                for (int r = 0; r < 16; ++r) s1 += a0[r] + a1[r];
                s1 = xhalf_sum(s1); const float mu = s1 * (1.0f / 64.0f); float s2 = 0.f;
#pragma unroll
                for (int r = 0; r < 16; ++r) { const float d0 = a0[r] - mu, d1 = a1[r] - mu; s2 += d0 * d0 + d1 * d1; }
                s2 = xhalf_sum(s2); const float rstd = __builtin_amdgcn_rsqf(s2 * (1.0f / 64.0f) + EPS);
#pragma unroll
                for (int t = 0; t < 2; ++t)
#pragma unroll
                    for (int g = 0; g < 4; ++g) { const int e0 = h * 64 + 32 * t + 8 * g + 4 * hi;
                        const u32x2 gr = *(const u32x2*)(RG + rowq * 256 + e0); const f32x4 gg = *(const f32x4*)(g_ret + e0);
                        const float gt[4] = {bf_lo(gr.x), bf_hi(gr.x), bf_lo(gr.y), bf_hi(gr.y)}; const float gn[4] = {gg.x, gg.y, gg.z, gg.w}; float y[4];
#pragma unroll
                        for (int i = 0; i < 4; ++i) { const float x = (t == 0 ? a0[4 * g + i] : a1[4 * g + i]); y[i] = (x - mu) * rstd * gn[i] * gt[i] / (1.0f + __expf(-gt[i])); }
                        u32x2 w; w.x = cvtpk(y[0], y[1]); w.y = cvtpk(y[2], y[3]); *(u32x2*)(Op + rowq * DM + 768 + e0) = w; }
            } else {
                const int et = wave & 1, dt = (wave >> 1) & 1;
#pragma unroll
                for (int g = 0; g < 4; ++g) { u32x2 w; w.x = cvtpk(sacc[4 * g], sacc[4 * g + 1]); w.y = cvtpk(sacc[4 * g + 2], sacc[4 * g + 3]);
                    *(LAS u32x2*)(RT + (32 * dt + l31) * VP + (32 * et + 8 * g + 4 * hi) * 2) = w; }
            }
        }
#undef RET_LOAD
        __syncthreads();
    }
}


template <int NR>
__device__ __forceinline__ void select_two(LAS const float* sc, LAS float* cand, LAS unsigned* ticket, int lane, int t0, int nkt, u64* bmrow0) {
    for (;;) {
        unsigned qv = 0u; if (lane == 0) qv = __hip_atomic_fetch_add(ticket, 1u, __ATOMIC_RELAXED, __HIP_MEMORY_SCOPE_WORKGROUP);
        const int q = __builtin_amdgcn_readfirstlane((int)qv);
        if (q >= 16) break;
        const int nk = t0 + q + 1; u64* bm = bmrow0 + (size_t)q * 32;
        f32x2s vp[NR / 2];
#pragma unroll
        for (int i = 0; i < NR; ++i) { float x = __builtin_nanf(""); if (2 * i < nkt) { x = sc[q * 2048 + i * 64 + lane]; if (2 * i + 1 >= nkt && lane >= 32) x = __builtin_nanf(""); }
            if (i & 1) vp[i >> 1].y = x; else vp[i >> 1].x = x; }
        select_row<NR>(vp, nk, bm, lane);
        if (NR < 32 && lane >= NR && lane < 32) { unsigned zz = 0u; asm volatile("" : "+v"(zz)); *(u32x2*)(bm + lane) = (u32x2){zz, zz}; }
    }
}
__device__ __forceinline__ void select_phase(LAS unsigned char* lds, const bf16* QI, const bf16* MS, const float* WI, u64* BM, const int wave_id) {
    const int tid = tid_here(), wave = wave_id, lane = tid & 63, l31 = lane & 31, hi = lane >> 5;
    LAS float* sc = (LAS float*)lds;
    const bool deal256 = (gridDim.x == 256); const int cblk = blockIdx.x;
    constexpr int NB = SEL_NB;
    const int nmine = deal256 ? (cblk < 128 ? NB : NB + 2 * (16 - NB)) : (M / 16 - cblk + (int)gridDim.x - 1) / (int)gridDim.x;
    for (int iu = 0; iu < nmine; ++iu) {
        int r, x;
        if (deal256) { if (iu < NB) { r = iu; x = cblk; } else { r = NB + ((iu - NB) >> 1); x = (cblk - 128) + 128 * ((iu - NB) & 1); } }
        else { const int v = cblk + iu * (int)gridDim.x; r = v >> 8; x = v & 255; }
        const int pr = (r < 7) ? r : (r < 14 ? r + 2 : r - 7);
        const int b = x >> 3, tb = pr * 8 + (x & 7), t0 = tb * 16; const size_t rowb = (size_t)b * SEQ;
        if (t0 < 256) {
            const int t = t0 + 2 * wave + (lane >> 5); u64* bm = BM + (rowb + t) * 32; const int k0 = 64 * l31;
            bm[l31] = (t >= k0 + 63) ? ~0ull : (t < k0 ? 0ull : ((1ull << (t - k0 + 1)) - 1ull));
            continue;
        }
        const int nkt = (t0 + 16 + 31) >> 5;
        if (tid == 0) *(LAS unsigned*)(lds + RING_BYTES + 512) = 0u;
        const int qloc = 2 * ((l31 >> 2) & 1) + (l31 >> 4), hd = 4 * ((l31 >> 3) & 1) + (l31 & 3);
        bf16x8 qa[4][2]; float wv[4][2][8];
#pragma unroll
        for (int qg = 0; qg < 4; ++qg) {
            const size_t rq = rowb + t0 + 4 * qg + qloc;
            qa[qg][0] = *(const bf16x8*)(QI + rq * 256 + hd * 32 + 8 * hi); qa[qg][1] = *(const bf16x8*)(QI + rq * 256 + hd * 32 + 16 + 8 * hi);
#pragma unroll
            for (int jq = 0; jq < 2; ++jq) { const float* wp = WI + (rowb + t0 + 4 * qg + 2 * hi + jq) * 8; const f32x4 wa = *(const f32x4*)wp, wb = *(const f32x4*)(wp + 4);
                wv[qg][jq][0] = wa.x; wv[qg][jq][1] = wa.y; wv[qg][jq][2] = wa.z; wv[qg][jq][3] = wa.w; wv[qg][jq][4] = wb.x; wv[qg][jq][5] = wb.y; wv[qg][jq][6] = wb.z; wv[qg][jq][7] = wb.w; }
        }
        const bf16* kp0 = MS + (rowb + l31) * 256 + 96 + 8 * hi;
        REP(7) {
        if (wave < nkt) {
        bf16x8 kb0 = *(const bf16x8*)(kp0 + (size_t)(32 * wave) * 256), kb1 = *(const bf16x8*)(kp0 + (size_t)(32 * wave) * 256 + 16);
        for (int kt = wave; kt < nkt; kt += 8) {
            const int ktn = (kt + 8 < nkt) ? kt + 8 : kt;
            const bf16x8 nb0 = *(const bf16x8*)(kp0 + (size_t)(32 * ktn) * 256), nb1 = *(const bf16x8*)(kp0 + (size_t)(32 * ktn) * 256 + 16);
#pragma unroll
            for (int qg = 0; qg < 4; ++qg) {
                f32x16 d;
#pragma unroll
                for (int r = 0; r < 16; ++r) d[r] = 0.f;
                d = __builtin_amdgcn_mfma_f32_32x32x16_bf16(qa[qg][0], kb0, d, 0, 0, 0); d = __builtin_amdgcn_mfma_f32_32x32x16_bf16(qa[qg][1], kb1, d, 0, 0, 0);
                float w0 = 0.f, w1 = 0.f;
#pragma unroll
                for (int i = 0; i < 8; ++i) { w0 += wv[qg][0][i] * fmaxf(d[i], 0.f); w1 += wv[qg][1][i] * fmaxf(d[8 + i], 0.f); }
                LAS float* o = sc + (4 * qg + 2 * hi) * 2048 + 32 * kt + l31;
                if (kt == nkt - 1) { const int tq0 = t0 + 4 * qg + 2 * hi, key = 32 * kt + l31; if (key > tq0) w0 = __builtin_nanf(""); if (key > tq0 + 1) w1 = __builtin_nanf(""); }
                o[0] = w0; o[2048] = w1;
            }
            kb0 = nb0; kb1 = nb1;
        }
        }
        }
        __syncthreads();
        u64* bmrow0 = BM + (rowb + t0) * 32;
        REP(8) {
        LAS float* cand = (LAS float*)(lds + RING_BYTES + 1024) + wave * 128; LAS unsigned* ticket = (LAS unsigned*)(lds + RING_BYTES + 512);
        if (t0 + 16 <= 512) select_two<8>(sc, cand, ticket, lane, t0, nkt, bmrow0);
        else if (t0 + 16 <= 1024) select_two<16>(sc, cand, ticket, lane, t0, nkt, bmrow0);
        else if (t0 + 16 <= 1536) select_two<24>(sc, cand, ticket, lane, t0, nkt, bmrow0);
        else select_two<32>(sc, cand, ticket, lane, t0, nkt, bmrow0);
        }
        __syncthreads();
    }
}

__device__ __forceinline__ void prologue(const Ptrs& P, LAS unsigned char* lds, const int wave_id) {
    const int tid = tid_here(), wave = wave_id, lane = tid & 63;
    LAS float* scr = (LAS float*)(lds + wave * 16384);
    const int gw = blockIdx.x * NWAVES + wave, NGW = gridDim.x * NWAVES;
    constexpr int I_IN = (DM / 64) * (NIN / 32), I_UQ = (768 / 64) * (768 / 32), I_UKV = (256 / 64) * (1024 / 32), I_OUT = (DM / 64) * (DM / 32), I_F1 = (DM / 64) * (FF / 32), I_F2 = (FF / 64) * (DM / 32);
    constexpr int I_L = I_IN + I_UQ + I_UKV + I_OUT + I_F1 + I_F2;
    for (int it = gw; it < DEPTH * I_L; it += NGW) {
        const int l = it / I_L; int r = it % I_L; unsigned char* wl = P.ws + WS_W + (size_t)l * WL_BYTES;
        if (r < I_IN) { transpose_item(P.w_in + (size_t)l * DM * IN_W, DM, IN_W, NIN, P.g_mix + l * DM, (bf16*)(wl + WL_IN), scr, r, lane, SrcIn()); continue; } r -= I_IN;
        if (r < I_UQ) { transpose_item(P.w_uq + (size_t)l * 768 * 768, 768, 768, 768, P.g_q + l * 768, (bf16*)(wl + WL_UQ), scr, r, lane, SrcUq()); continue; } r -= I_UQ;
        if (r < I_UKV) { transpose_item(P.w_ukv + (size_t)l * 256 * 1024, 256, 1024, 1024, P.g_kv + l * 256, (bf16*)(wl + WL_UKV), scr, r, lane, SrcUkv()); continue; } r -= I_UKV;
        if (r < I_OUT) { transpose_item(P.w_out + (size_t)l * DM * DM, DM, DM, DM, nullptr, (bf16*)(wl + WL_OUT), scr, r, lane, SrcId()); continue; } r -= I_OUT;
        if (r < I_F1) { transpose_item(P.w_ff1 + (size_t)l * DM * FF, DM, FF, FF, P.g_mlp + l * DM, (bf16*)(wl + WL_F1), scr, r, lane, SrcId()); continue; } r -= I_F1;
        transpose_item(P.w_ff2 + (size_t)l * FF * DM, FF, DM, DM, nullptr, (bf16*)(wl + WL_F2), scr, r, lane, SrcId());
    }
    bf16* xb = (bf16*)(P.ws + WS_XB); float* ssqx = (float*)(P.ws + WS_SSQX);
    for (int m0 = gw * 4; m0 < M; m0 += NGW * 4) {
        f32x4 v[4][4];
#pragma unroll
        for (int r = 0; r < 4; ++r) { const f32x4* xr = (const f32x4*)(P.x + (size_t)(m0 + r) * DM) + lane;
#pragma unroll
            for (int j = 0; j < 4; ++j) v[r][j] = xr[64 * j]; }
#pragma unroll
        for (int r = 0; r < 4; ++r) {
            float s = 0.f;
#pragma unroll
            for (int j = 0; j < 4; ++j) s += (v[r][j].x * v[r][j].x + v[r][j].y * v[r][j].y) + (v[r][j].z * v[r][j].z + v[r][j].w * v[r][j].w);
            s = wave_sum_f(s);
            u32x2* o8 = (u32x2*)(xb + (size_t)(m0 + r) * DM) + lane;
#pragma unroll
            for (int j = 0; j < 4; ++j) { u32x2 w; w.x = cvtpk(v[r][j].x, v[r][j].y); w.y = cvtpk(v[r][j].z, v[r][j].w); o8[64 * j] = w; }
            if (lane < 16) ssqx[(size_t)(m0 + r) * 16 + lane] = (lane == 0) ? s : 0.f;
        }
    }
}
__device__ __forceinline__ void final_norm(const Ptrs& P, const int wave_id) {
    const int tid = tid_here(), wave = wave_id, lane = tid & 63;
    const int gw = blockIdx.x * NWAVES + wave, NGW = gridDim.x * NWAVES;
    const float* ssqx = (const float*)(P.ws + WS_SSQX); const bf16* xb = (const bf16*)(P.ws + WS_XB);
    const f32x4* g = (const f32x4*)P.g_final + 2 * lane;
    const f32x4 g00 = g[0], g01 = g[1], g10 = g[128], g11 = g[129];
    for (int m0 = gw * 4; m0 < M; m0 += NGW * 4) {
        u32x4 xv[4][2]; float ss[4];
#pragma unroll
        for (int r = 0; r < 4; ++r) { const u32x4* xr = (const u32x4*)(xb + (size_t)(m0 + r) * DM) + lane; xv[r][0] = xr[0]; xv[r][1] = xr[64];
            const float* sp = ssqx + (size_t)(m0 + r) * 16; ss[r] = (lane < 16) ? sp[lane] : 0.f; }
#pragma unroll
        for (int r = 0; r < 4; ++r) {
            const float rs = __builtin_amdgcn_rsqf(wave_sum_f(ss[r]) * (1.0f / DM) + EPS);
            f32x4* orow = (f32x4*)(P.out + (size_t)(m0 + r) * DM) + 2 * lane;
            float a[8], b[8]; unpack8(xv[r][0], a); unpack8(xv[r][1], b);
            orow[0] = (f32x4){a[0] * rs * g00.x, a[1] * rs * g00.y, a[2] * rs * g00.z, a[3] * rs * g00.w}; orow[1] = (f32x4){a[4] * rs * g01.x, a[5] * rs * g01.y, a[6] * rs * g01.z, a[7] * rs * g01.w};
            orow[128] = (f32x4){b[0] * rs * g10.x, b[1] * rs * g10.y, b[2] * rs * g10.z, b[3] * rs * g10.w}; orow[129] = (f32x4){b[4] * rs * g11.x, b[5] * rs * g11.y, b[6] * rs * g11.z, b[7] * rs * g11.w};
        }
    }
}

constexpr int PH_PER_LAYER = 6, N_PHASES = 2 + DEPTH * PH_PER_LAYER;

__global__ void __launch_bounds__(NTHREADS, 2) fwd(Args args) {
    extern __shared__ __attribute__((aligned(16))) unsigned char lds_raw[];
    LAS unsigned char* lds = (LAS unsigned char*)lds_raw;
    const Ptrs& P = args.p;
    const int wave_id = __builtin_amdgcn_readfirstlane((int)threadIdx.x >> 6);
    const int tid = tid_here();
    for (int u = tid; u < (LDS_BYTES - RING_BYTES) / 4; u += NTHREADS) ((LAS unsigned*)(lds + RING_BYTES))[u] = 0u;
    __syncthreads();
    unsigned char* const ws0 = P.ws;
    XcdBarrier bar; bar.bar = (unsigned*)(ws0 + WS_CTL) + CW_BAR; bar.x = 0; bar.st = nullptr;
#if MK_N_LAUNCHES == 1
    bar = xcd_barrier_post((unsigned*)(ws0 + WS_CTL) + CW_BAR, (volatile LAS unsigned*)(lds + MISC_OFF) + 8);
#define GRID_BAR() xcd_barrier(bar)
#else
#define GRID_BAR() do { } while (0)
#endif
    const int lo = args.ph_lo, hi = args.ph_hi;
#define IN(k) (lo <= (k) && (k) < hi)
#define LAUNDER_WS() size_t zo_ = 0; asm volatile("" : "+s"(zo_)); unsigned char* const ws = ws0 + zo_
#define SEAM(k) do { if (IN(k) && IN((k) + 1)) { REP(10) GRID_BAR(); } } while (0)
    const int G = gridDim.x, c = blockIdx.x;

#define XB ((bf16*)(ws + WS_XB))
#define SSQX ((float*)(ws + WS_SSQX))
#define SSQL ((float*)(ws + WS_SSQL))
#define SSQ2 ((float*)(ws + WS_SSQ2))
#define WI ((float*)(ws + WS_WI))
#define CQ ((bf16*)(ws + WS_CQ))
#define CKV ((bf16*)(ws + WS_CKV))
#define AQ ((bf16*)(ws + WS_AQ))
#define RQ ((bf16*)(ws + WS_RQ))
#define RK ((bf16*)(ws + WS_RK))
#define QI ((bf16*)(ws + WS_QI))
#define MS ((bf16*)(ws + WS_MS))
#define RV ((bf16*)(ws + WS_RV))
#define RG ((bf16*)(ws + WS_RG))
#define Q ((bf16*)(ws + WS_Q))
#define KN ((bf16*)(ws + WS_KN))
#define V ((bf16*)(ws + WS_V))
#define O ((bf16*)(ws + WS_O))
#define H ((bf16*)(ws + WS_H))
#define BM ((u64*)(ws + WS_BM))
    if (IN(0)) { REP(9) prologue(P, lds, wave_id); } SEAM(0);

    for (int l = 0; l < DEPTH; ++l) {
        const int pb = 1 + l * PH_PER_LAYER;
        if (IN(pb + 0)) {
            LAUNDER_WS(); unsigned char* wl = ws + WS_W + (size_t)l * WL_BYTES; (void)wl;
            pg8::Gemm g{XB, (const bf16*)(wl + WL_IN), M, NIN, DM}; pg8::StaticOrder S; S.init(M, NIN, G, c);
            KL_RUN(0, FIn, ws);
        } SEAM(pb + 0);
        if (IN(pb + 1)) {
            { LAUNDER_WS(); unsigned char* wl = ws + WS_W + (size_t)l * WL_BYTES; pg8::Gemm g{CQ, (const bf16*)(wl + WL_UQ), M, 768, 768}; pg8::StaticOrder S; S.init(M, 768, G, c); KL_RUN(1, FUq, SSQL, Q); }
            { LAUNDER_WS(); unsigned char* wl = ws + WS_W + (size_t)l * WL_BYTES; pg8::Gemm g{CKV, (const bf16*)(wl + WL_UKV), M, 1024, 256}; pg8::StaticOrder S; S.init(M, 1024, G, c); KL_RUN(2, FUkv, SSQL, KN); }
            { LAUNDER_WS(); REP(2) select_phase(lds, QI, MS, WI, BM, wave_id); }
            __syncthreads();
            { LAUNDER_WS(); const float* gr = P.g_ret + l * 256 + zo_; REP(3) ret_phase(lds, RQ, RK, RV, RG, gr, O, wave_id); }
        } SEAM(pb + 1);
        if (IN(pb + 2)) {
            LAUNDER_WS(); unsigned char* wl = ws + WS_W + (size_t)l * WL_BYTES; (void)wl;
            REP(4) attn_phase<true>(lds, Q, KN, MS, V, nullptr, O, wave_id);
            REP(5) attn_phase<false>(lds, AQ, nullptr, MS, nullptr, BM, O, wave_id);
        } SEAM(pb + 2);
        if (IN(pb + 3)) {
            LAUNDER_WS(); unsigned char* wl = ws + WS_W + (size_t)l * WL_BYTES; (void)wl;
            pg8::Gemm g{O, (const bf16*)(wl + WL_OUT), M, DM, DM}; pg8::StaticOrder S; S.init(M, DM, G, c);
            KL_RUN(3, FRes<false>, XB, nullptr, SSQ2);
        } SEAM(pb + 3);
        if (IN(pb + 4)) {
            LAUNDER_WS(); unsigned char* wl = ws + WS_W + (size_t)l * WL_BYTES; (void)wl;
            pg8::Gemm g{XB, (const bf16*)(wl + WL_F1), M, FF, DM}; pg8::StaticOrder S; S.init(M, FF, G, c);
            KL_RUN(4, FFf1, H);
        } SEAM(pb + 4);
        if (IN(pb + 5)) {
            LAUNDER_WS(); unsigned char* wl = ws + WS_W + (size_t)l * WL_BYTES; (void)wl;
            pg8::Gemm g{H, (const bf16*)(wl + WL_F2), M, DM, FF}; pg8::StaticOrder S; S.init(M, DM, G, c);
            KL_RUN(5, FRes<true>, XB, SSQ2, SSQX);
        } SEAM(pb + 5);
    }
    if (IN(N_PHASES - 1)) final_norm(P, wave_id);
#undef IN
#undef SEAM
}
}

extern "C" void kernel_launch(void* const* d_in, const int* in_sizes, int n_in, void* d_out, int out_size, void* d_ws, size_t ws_size, hipStream_t stream) {
    using namespace mk;
    static int grid = 0;
    if (grid == 0) {
        if (n_in != 13 || in_sizes[0] != M * DM || out_size != M * DM || ws_size < WS_END || ws_size < WS_H + 512 * MiB) {
            fprintf(stderr, "kernel_launch: unexpected shapes (n_in %d, in0 %d, out %d, ws %zu); nothing launched\n", n_in, n_in > 0 ? in_sizes[0] : -1, out_size, ws_size); grid = -1; return; }
        int dev = 0, cus = 0, per_cu = 0;
        if (hipGetDevice(&dev) != hipSuccess || hipDeviceGetAttribute(&cus, hipDeviceAttributeMultiprocessorCount, dev) != hipSuccess) { grid = -1; return; }
        if (hipFuncSetAttribute((const void*)fwd, hipFuncAttributeMaxDynamicSharedMemorySize, LDS_BYTES) != hipSuccess) { fprintf(stderr, "kernel_launch: hipFuncSetAttribute failed\n"); grid = -1; return; }
        if (hipOccupancyMaxActiveBlocksPerMultiprocessor(&per_cu, (const void*)fwd, NTHREADS, LDS_BYTES) != hipSuccess || per_cu < 1) { fprintf(stderr, "kernel_launch: occupancy query says %d\n", per_cu); }
        (void)hipGetLastError();
        grid = cus;
    }
    if (grid < 0) return;
    if (hipMemsetAsync((char*)d_ws + WS_CTL, 0, CTL_ZERO_BYTES, stream) != hipSuccess) return;
    Args a{};
    a.p.x = (const float*)d_in[0]; a.p.g_mix = (const float*)d_in[1]; a.p.w_in = (const float*)d_in[2]; a.p.g_q = (const float*)d_in[3]; a.p.w_uq = (const float*)d_in[4];
    a.p.g_kv = (const float*)d_in[5]; a.p.w_ukv = (const float*)d_in[6]; a.p.g_ret = (const float*)d_in[7]; a.p.w_out = (const float*)d_in[8]; a.p.g_mlp = (const float*)d_in[9];
    a.p.w_ff1 = (const float*)d_in[10]; a.p.w_ff2 = (const float*)d_in[11]; a.p.g_final = (const float*)d_in[12];
    a.p.out = (float*)d_out; a.p.ws = (unsigned char*)d_ws;
#if MK_N_LAUNCHES == 1
    a.ph_lo = 0; a.ph_hi = N_PHASES;
    hipLaunchKernelGGL(fwd, dim3(grid), dim3(NTHREADS), LDS_BYTES, stream, a);
#else
    for (int ph = 0; ph < N_PHASES; ++ph) { a.ph_lo = ph; a.ph_hi = ph + 1; hipLaunchKernelGGL(fwd, dim3(grid), dim3(NTHREADS), LDS_BYTES, stream, a); }
#endif
}
```

```cpp
#include <hip/hip_runtime.h>
#include <cstdio>
#include <cstdint>
namespace pg8 {
#define PG8_LAS __attribute__((address_space(3)))
typedef unsigned short bf16_t;
typedef short bf16x8 __attribute__((ext_vector_type(8)));
typedef float f32x4 __attribute__((ext_vector_type(4)));
typedef unsigned u32x4 __attribute__((ext_vector_type(4)));
constexpr int BM = 256, BK = 64, HALF = 128, HTB = HALF * BK * 2  , STAGE_BYTES = 8 * HTB, NXCD = 8, WGM = 8;

__host__ __device__ __forceinline__ int lds_byte(int r, int c) { const int st = (r >> 4) * 2 + (c >> 5), rr = r & 15, cc = c & 31, ob = rr * 64 + cc * 2; return st * 1024 + (ob ^ (((ob >> 9) & 1) << 5)); }
__host__ __device__ __forceinline__ void stage_rc(int b, int& R, int& C) { const int st = b / 1024, sb = b % 1024, swz = sb ^ (((sb >> 9) & 1) << 5); R = (st >> 1) * 16 + swz / 64; C = (st & 1) * 32 + (swz % 64) / 2; }
__host__ __device__ __forceinline__ int perm32(int rho) { const int n = rho >> 4, i = rho & 15; return 8 * (i >> 2) + 4 * n + (i & 3); }

struct Unit { int pm, pn; };
struct Gemm { const bf16_t* A; const bf16_t* Bt; int M, N, K; };

struct StaticOrder {
    int nM, nN, nwg, G, c;
    __host__ __device__ void init(int M, int N, int G_, int c_) { nM = M / BM; nN = N / BM; nwg = nM * nN; G = G_; c = c_; }
    __host__ __device__ bool next(int i, Unit& u) const {
        const long L = (long)i * G + c; if (L >= nwg) return false;
        int wgid = (int)L; { const int q = nwg / NXCD, r = nwg % NXCD, xcd = wgid % NXCD, off = wgid / NXCD; wgid = (xcd < r ? xcd * (q + 1) : r * (q + 1) + (xcd - r) * q) + off; }
        const int nig = WGM * nN, gid = wgid / nig, fm = gid * WGM, gsz = (nM - fm) < WGM ? (nM - fm) : WGM;
        u.pm = fm + ((wgid % nig) % gsz); u.pn = (wgid % nig) / gsz; return true;
    }
    __device__ __forceinline__ void a_ready(const Unit&) const {}
    __device__ __forceinline__ void done(const Unit&) const {}
};

__device__ __forceinline__ unsigned cvt_pk_bf16(float lo, float hi) { unsigned r; asm volatile("v_cvt_pk_bf16_f32 %0, %1, %2" : "=v"(r) : "v"(lo), "v"(hi)); return r; }
typedef float f32x2 __attribute__((ext_vector_type(2)));

template <class Epi, class Sched, bool ALIGN_EPI = false, bool SP2 = false>
__device__ __forceinline__ void gemm_phase(PG8_LAS unsigned char* lds, const Gemm g, const Sched& S, const Epi& E, const int wid_in) {
    int lane_l; asm volatile("v_mbcnt_lo_u32_b32 %0, -1, 0\n\tv_mbcnt_hi_u32_b32 %0, -1, %0" : "=v"(lane_l));
    int wid_l = wid_in; asm volatile("" : "+s"(wid_l));
    const int wid = wid_l, lane = lane_l, tid = wid * 64 + lane, wr = wid >> 2, wc = wid & 3, fr = lane & 15, fq = lane >> 4;
    const int K = g.K, nt = K / BK;
    unsigned voffA[2], voffB[2];
#pragma unroll
    for (int i = 0; i < 2; ++i) { int R, C; stage_rc(tid * 16 + i * 8192, R, C); const int Rb = Epi::PERM ? ((R & ~31) + perm32(R & 31)) : R;
        voffA[i] = (unsigned)(R * K + C) * 2u; voffB[i] = (unsigned)(Rb * K + C) * 2u; }
    const size_t kstep = (size_t)(BK * 2);
    const size_t hstep = (size_t)HALF * K * 2;
    const size_t tstep = 2 * hstep;
    const unsigned ldsw = (unsigned)wid * 1024u;
    const int aoff = lds_byte(wr * 64 + fr, fq * 8), boff = lds_byte(wc * 32 + fr, fq * 8);
#define PG8_SA(b, h) (((b) * 2 + (h)) * HTB)
#define PG8_SB(b, h) ((4 + (b) * 2 + (h)) * HTB)
#define PG8_STAGE(bufoff, gbase, voff) do { _Pragma("unroll") for (int _i = 0; _i < 2; ++_i) \
        __builtin_amdgcn_global_load_lds((const unsigned*)((const char*)(gbase) + (voff)[_i]), (PG8_LAS unsigned*)(lds + (bufoff) + ldsw + _i * 8192), 16, 0, 0); } while (0)
#define PG8_LDA(dst, b, h) do { _Pragma("unroll") for (int m = 0; m < 4; ++m) _Pragma("unroll") for (int k = 0; k < 2; ++k) dst[m][k] = *(const PG8_LAS bf16x8*)(lds + PG8_SA(b, h) + aoff + m * 2048 + k * 1024); } while (0)
#define PG8_LDB(dst, b, h) do { _Pragma("unroll") for (int n = 0; n < 2; ++n) _Pragma("unroll") for (int k = 0; k < 2; ++k) dst[n][k] = *(const PG8_LAS bf16x8*)(lds + PG8_SB(b, h) + boff + n * 2048 + k * 1024); } while (0)
#define PG8_MMA(ai, bj, At, Bt) do { __builtin_amdgcn_s_setprio(1); _Pragma("unroll") for (int m = 0; m < 4; ++m) _Pragma("unroll") for (int n = 0; n < 2; ++n) _Pragma("unroll") for (int k = 0; k < 2; ++k) \
        acc[ai][bj][m][n] = __builtin_amdgcn_mfma_f32_16x16x32_bf16(Bt[n][k], At[m][k], acc[ai][bj][m][n], 0, 0, 0); __builtin_amdgcn_s_setprio(0); } while (0)
#define PG8_WAIT_V(n) asm volatile("s_waitcnt vmcnt(" #n ")" ::: "memory")
#define PG8_WAIT_L(n) asm volatile("s_waitcnt lgkmcnt(" #n ")" ::: "memory")
#define PG8_BAR __builtin_amdgcn_s_barrier()
#define PG8_SCHED __builtin_amdgcn_sched_barrier(0)
    Unit cur, nxt; int ui = 0;
    if (!S.next(0, cur)) return;
    f32x4 acc[2][2][4][2];
#pragma unroll
    for (int a = 0; a < 2; ++a)
#pragma unroll
        for (int b = 0; b < 2; ++b)
#pragma unroll
            for (int m = 0; m < 4; ++m)
#pragma unroll
                for (int n = 0; n < 2; ++n) acc[a][b][m][n] = (f32x4){0.f, 0.f, 0.f, 0.f};
    bf16x8 At[4][2], B0[2][2], B1[2][2];
    const char* cA = (const char*)g.A + (size_t)cur.pm * tstep; const char* cB = (const char*)g.Bt + (size_t)cur.pn * tstep;
    S.a_ready(cur);
    if constexpr (SP2) {
        PG8_STAGE(PG8_SB(0, 0), cB, voffB); PG8_STAGE(PG8_SB(0, 1), cB + hstep, voffB); PG8_STAGE(PG8_SA(0, 0), cA, voffA); PG8_STAGE(PG8_SA(0, 1), cA + hstep, voffA);
        if (wr == 1) PG8_BAR;
        PG8_WAIT_V(2); PG8_BAR;
        PG8_STAGE(PG8_SB(1, 0), cB + kstep, voffB); PG8_STAGE(PG8_SA(1, 0), cA + kstep, voffA); PG8_STAGE(PG8_SB(1, 1), cB + hstep + kstep, voffB);
        PG8_WAIT_V(6); PG8_BAR;
    } else {
        PG8_STAGE(PG8_SB(0, 0), cB, voffB); PG8_STAGE(PG8_SA(0, 0), cA, voffA); PG8_STAGE(PG8_SB(0, 1), cB + hstep, voffB); PG8_STAGE(PG8_SA(0, 1), cA + hstep, voffA);
        if (wr == 1) PG8_BAR;
        PG8_WAIT_V(4); PG8_BAR;
        PG8_STAGE(PG8_SB(1, 0), cB + kstep, voffB); PG8_STAGE(PG8_SA(1, 0), cA + kstep, voffA); PG8_STAGE(PG8_SB(1, 1), cB + hstep + kstep, voffB);
        PG8_WAIT_V(6); PG8_BAR;
    }
    for (;;) {
        const bool has_next = S.next(ui + 1, nxt);
        const char* nA = has_next ? (const char*)g.A + (size_t)nxt.pm * tstep : cA; const char* nB = has_next ? (const char*)g.Bt + (size_t)nxt.pn * tstep : cB;
        for (int t = 0; t < nt; t += 2) {
            const bool last = (t == nt - 2);
            const char* a1 = cA + (size_t)(t + 1) * kstep;
            const char* a2 = last ? nA : cA + (size_t)(t + 2) * kstep; const char* b2 = last ? nB : cB + (size_t)(t + 2) * kstep;
            const char* a3 = a2 + kstep; const char* b3 = b2 + kstep;
            if (last && has_next) S.a_ready(nxt);
            if constexpr (SP2) {
            PG8_LDB(B0, 0, 0); PG8_LDB(B1, 0, 1); PG8_SCHED; PG8_LDA(At, 0, 0); PG8_STAGE(PG8_SA(1, 1), a1 + hstep, voffA);
            PG8_WAIT_V(8); PG8_WAIT_L(0); PG8_BAR; PG8_MMA(0, 0, At, B0); PG8_MMA(0, 1, At, B1); PG8_BAR; PG8_SCHED;
            PG8_LDA(At, 0, 1); PG8_STAGE(PG8_SB(0, 0), b2, voffB); PG8_STAGE(PG8_SB(0, 1), b2 + hstep, voffB); PG8_STAGE(PG8_SA(0, 0), a2, voffA);
            PG8_WAIT_V(8); PG8_WAIT_L(0); PG8_BAR; PG8_MMA(1, 0, At, B0); PG8_MMA(1, 1, At, B1); PG8_BAR; PG8_SCHED;
            PG8_LDB(B0, 1, 0); PG8_LDB(B1, 1, 1); PG8_SCHED; PG8_LDA(At, 1, 0); PG8_STAGE(PG8_SA(0, 1), a2 + hstep, voffA);
            PG8_WAIT_V(8); PG8_WAIT_L(0); PG8_BAR; PG8_MMA(0, 0, At, B0); PG8_MMA(0, 1, At, B1); PG8_BAR; PG8_SCHED;
            PG8_LDA(At, 1, 1); PG8_STAGE(PG8_SB(1, 0), b3, voffB); PG8_STAGE(PG8_SB(1, 1), b3 + hstep, voffB); PG8_STAGE(PG8_SA(1, 0), a3, voffA);
            PG8_WAIT_V(8); PG8_WAIT_L(0); PG8_BAR; PG8_MMA(1, 0, At, B0); PG8_MMA(1, 1, At, B1); PG8_BAR; PG8_SCHED;
            } else {
            PG8_LDB(B0, 0, 0); PG8_SCHED; PG8_LDA(At, 0, 0); PG8_STAGE(PG8_SA(1, 1), a1 + hstep, voffA);
            PG8_WAIT_L(8); PG8_BAR; PG8_WAIT_L(0); PG8_MMA(0, 0, At, B0); PG8_BAR; PG8_SCHED;
            PG8_LDB(B1, 0, 1); PG8_STAGE(PG8_SB(0, 0), b2, voffB);
            PG8_BAR; PG8_WAIT_L(0); PG8_MMA(0, 1, At, B1); PG8_BAR;
            PG8_LDA(At, 0, 1); PG8_STAGE(PG8_SA(0, 0), a2, voffA);
            PG8_BAR; PG8_WAIT_L(0); PG8_MMA(1, 0, At, B0); PG8_BAR; PG8_SCHED;
            PG8_STAGE(PG8_SB(0, 1), b2 + hstep, voffB);
            PG8_WAIT_V(6); PG8_BAR; PG8_MMA(1, 1, At, B1); PG8_BAR;
            PG8_LDB(B0, 1, 0); PG8_SCHED; PG8_LDA(At, 1, 0); PG8_STAGE(PG8_SA(0, 1), a2 + hstep, voffA);
            PG8_WAIT_L(8); PG8_BAR; PG8_WAIT_L(0); PG8_MMA(0, 0, At, B0); PG8_BAR; PG8_SCHED;
            PG8_LDB(B1, 1, 1); PG8_STAGE(PG8_SB(1, 0), b3, voffB);
            PG8_BAR; PG8_WAIT_L(0); PG8_MMA(0, 1, At, B1); PG8_BAR;
            PG8_LDA(At, 1, 1); PG8_STAGE(PG8_SA(1, 0), a3, voffA);
            PG8_BAR; PG8_WAIT_L(0); PG8_MMA(1, 0, At, B0); PG8_BAR; PG8_SCHED;
            PG8_STAGE(PG8_SB(1, 1), b3 + hstep, voffB);
            PG8_WAIT_V(6); PG8_BAR; PG8_MMA(1, 1, At, B1); PG8_BAR;
            }
        }
        if constexpr (ALIGN_EPI) { if (wr == 0) PG8_BAR; }
        if constexpr (!Epi::AFTER_DRAIN) { E(acc, cur, wr, wc, fr, fq); S.done(cur); }
        if (!has_next) break;
#pragma unroll
        for (int a = 0; a < 2; ++a)
#pragma unroll
            for (int b = 0; b < 2; ++b)
#pragma unroll
                for (int m = 0; m < 4; ++m)
#pragma unroll
                    for (int n = 0; n < 2; ++n) acc[a][b][m][n] = (f32x4){0.f, 0.f, 0.f, 0.f};
        cur = nxt; cA = nA; cB = nB; ++ui;
        if constexpr (ALIGN_EPI) { if (wr == 1) PG8_BAR; }
    }
    PG8_WAIT_V(0);
    if constexpr (!ALIGN_EPI) { if (wr == 0) PG8_BAR; }
    PG8_BAR;
    if constexpr (Epi::AFTER_DRAIN) { E.fused(acc, cur, wr, wc, fr, fq, lds, wid, lane); S.done(cur); }
#undef PG8_SA
#undef PG8_SB
#undef PG8_STAGE
#undef PG8_LDA
#undef PG8_LDB
#undef PG8_MMA
#undef PG8_WAIT_V
#undef PG8_WAIT_L
#undef PG8_BAR
#undef PG8_SCHED
}
}

#ifndef MK_N_LAUNCHES
#define MK_N_LAUNCHES 1
#endif
#ifndef PROBE_REP
#define PROBE_REP 0
#endif
#define REP(bit) for (int rep_ = 0; rep_ < ((PROBE_REP >> (bit)) & 1) + 1; ++rep_)
#ifndef PROBE_KL
#define PROBE_KL 0
#endif
#ifndef SEL_NB
#define SEL_NB 13
#endif
#ifndef ATT_FUSE_SM
#define ATT_FUSE_SM 2
#endif
#ifndef ATT_SPLIT
#define ATT_SPLIT 1
#endif
#ifndef ATT_NQR
#define ATT_NQR 2
#endif
#ifndef PRO_ROWS
#define PRO_ROWS 8
#endif
#ifndef FIN_ROWS
#define FIN_ROWS 8
#endif
#ifndef RES_BATCH
#define RES_BATCH 4
#endif
#ifndef MK_NAIVE_GEMM
#define MK_NAIVE_GEMM 0
#endif

namespace mk {
#define GAS __attribute__((address_space(1)))
#define LAS __attribute__((address_space(3)))
typedef unsigned short bf16;
typedef float f32x4 __attribute__((ext_vector_type(4)));
typedef float f32x2 __attribute__((ext_vector_type(2)));
typedef unsigned u32x4 __attribute__((ext_vector_type(4)));
typedef unsigned u32x2 __attribute__((ext_vector_type(2)));
typedef __bf16 bf16x2_t __attribute__((ext_vector_type(2)));
typedef unsigned long long u64;

constexpr int BATCH = 32, SEQ = 2048, DM = 1024, DEPTH = 2, M = BATCH * SEQ, FF = 4096;
constexpr int NIN = 2816;
constexpr int IN_W = 2760;
constexpr float EPS = 1e-6f;
constexpr float LOG2E = 1.4426950408889634f;
constexpr int NWAVES = 8, NTHREADS = 512;

constexpr size_t MiB = 1u << 20;
constexpr size_t WS_CTL = 0, CTL_ZERO_BYTES = 1 * MiB;
constexpr size_t W_IN_B = (size_t)NIN * DM * 2, W_UQ_B = 768 * 768 * 2, W_UKV_B = 1024 * 256 * 2, W_OUT_B = 1024 * 1024 * 2, W_F1_B = (size_t)FF * DM * 2, W_F2_B = (size_t)DM * FF * 2;
constexpr size_t WL_IN = 0, WL_UQ = WL_IN + W_IN_B, WL_UKV = WL_UQ + W_UQ_B, WL_OUT = WL_UKV + W_UKV_B, WL_F1 = WL_OUT + W_OUT_B, WL_F2 = WL_F1 + W_F1_B, WL_BYTES = WL_F2 + W_F2_B;
constexpr size_t WS_W = 1 * MiB;
constexpr size_t WS_SSQX = 55 * MiB, WS_SSQL = 59 * MiB;
constexpr size_t WS_WI = 63 * MiB;
constexpr size_t WS_SSQ2 = 66 * MiB;
constexpr size_t WS_XB = 70 * MiB;
constexpr size_t WS_BIG = 198 * MiB;
constexpr size_t WS_CQ = WS_BIG, WS_CKV = WS_CQ + 96 * MiB, WS_AQ = WS_CKV + 32 * MiB, WS_RQ = WS_AQ + 32 * MiB, WS_RK = WS_RQ + 32 * MiB, WS_QI = WS_RK + 32 * MiB,
                 WS_MS = WS_QI + 32 * MiB, WS_RV = WS_MS + 32 * MiB, WS_RG = WS_RV + 32 * MiB, WS_Q = WS_RG + 32 * MiB, WS_KN = WS_Q + 96 * MiB, WS_V = WS_KN + 64 * MiB,
                 WS_BM = WS_V + 64 * MiB, WS_O = WS_BM + 16 * MiB, WS_END = WS_O + 128 * MiB;
constexpr size_t WS_H = WS_BIG;
static_assert(WS_W + 2 * WL_BYTES <= WS_SSQX && WS_END <= 1024 * MiB && WS_H + 512 * MiB <= 1024 * MiB, "d_ws map");
constexpr int CW_BAR = 4096;

constexpr int RING_BYTES = 131072, MISC_OFF = RING_BYTES + 320, LDS_BYTES = 147456;

__device__ __forceinline__ unsigned cvtpk(float lo, float hi) { f32x2 v = {lo, hi}; bf16x2_t b = __builtin_convertvector(v, bf16x2_t); return __builtin_bit_cast(unsigned, b); }
__device__ __forceinline__ float bf_lo(unsigned u) { return __uint_as_float(u << 16); }
__device__ __forceinline__ float bf_hi(unsigned u) { return __uint_as_float(u & 0xffff0000u); }
__device__ __forceinline__ void unpack8(const u32x4 r, float* f) { f[0] = bf_lo(r.x); f[1] = bf_hi(r.x); f[2] = bf_lo(r.y); f[3] = bf_hi(r.y); f[4] = bf_lo(r.z); f[5] = bf_hi(r.z); f[6] = bf_lo(r.w); f[7] = bf_hi(r.w); }
__device__ __forceinline__ void st8(bf16* dst, const float* v) { u32x4 w; w.x = cvtpk(v[0], v[1]); w.y = cvtpk(v[2], v[3]); w.z = cvtpk(v[4], v[5]); w.w = cvtpk(v[6], v[7]); *(u32x4*)dst = w; }
__device__ __forceinline__ void st8nt(bf16* dst, const float* v) { u32x4 w; w.x = cvtpk(v[0], v[1]); w.y = cvtpk(v[2], v[3]); w.z = cvtpk(v[4], v[5]); w.w = cvtpk(v[6], v[7]); __builtin_nontemporal_store(w, (u32x4*)dst); }
__device__ __forceinline__ void st8f(float* dst, const float* v) { *(f32x4*)dst = (f32x4){v[0], v[1], v[2], v[3]}; *(f32x4*)(dst + 4) = (f32x4){v[4], v[5], v[6], v[7]}; }
__device__ __forceinline__ float sum16(const float* p) { const f32x4 a = *(const f32x4*)p, b = *(const f32x4*)(p + 4), c = *(const f32x4*)(p + 8), d = *(const f32x4*)(p + 12);
    return (((a.x + a.y) + (a.z + a.w)) + ((b.x + b.y) + (b.z + b.w))) + (((c.x + c.y) + (c.z + c.w)) + ((d.x + d.y) + (d.z + d.w))); }
__device__ __forceinline__ float wave_sum(float v) {
#pragma unroll
    for (int o = 1; o < 64; o <<= 1) v += __shfl_xor(v, o);
    return v; }
__device__ __forceinline__ float wave_max(float v) {
#pragma unroll
    for (int o = 1; o < 64; o <<= 1) v = fmaxf(v, __shfl_xor(v, o));
    return v; }
__device__ __forceinline__ float wave_min(float v) {
#pragma unroll
    for (int o = 1; o < 64; o <<= 1) v = fminf(v, __shfl_xor(v, o));
    return v; }

__device__ __forceinline__ float xhalf_sum(float a) { const auto rr = __builtin_amdgcn_permlane32_swap(__float_as_uint(a), __float_as_uint(a), false, false); return __uint_as_float(rr[0]) + __uint_as_float(rr[1]); }
__device__ __forceinline__ float xrow16_sum(float x) { const auto s_ = __builtin_amdgcn_permlane16_swap(__float_as_uint(x), __float_as_uint(x), false, false); x = __uint_as_float(s_[0]) + __uint_as_float(s_[1]);
    const auto t_ = __builtin_amdgcn_permlane32_swap(__float_as_uint(x), __float_as_uint(x), false, false); return __uint_as_float(t_[0]) + __uint_as_float(t_[1]); }
__device__ __forceinline__ float xhalf_max(float a) { const auto rr = __builtin_amdgcn_permlane32_swap(__float_as_uint(a), __float_as_uint(a), false, false); return fmaxf(__uint_as_float(rr[0]), __uint_as_float(rr[1])); }
#define DPP_I(x, ctrl) __builtin_amdgcn_update_dpp(0, (x), (ctrl), 0xf, 0xf, false)
__device__ __forceinline__ int wave_sum_i(int x) {
    x += DPP_I(x, 0xB1); x += DPP_I(x, 0x4E); x += DPP_I(x, 0x141); x += DPP_I(x, 0x140);
    return __builtin_amdgcn_readlane(x, 0) + __builtin_amdgcn_readlane(x, 16) + __builtin_amdgcn_readlane(x, 32) + __builtin_amdgcn_readlane(x, 48); }
__device__ __forceinline__ float wave_max_f(float x) {
    x = fmaxf(x, __int_as_float(DPP_I(__float_as_int(x), 0xB1))); x = fmaxf(x, __int_as_float(DPP_I(__float_as_int(x), 0x4E))); x = fmaxf(x, __int_as_float(DPP_I(__float_as_int(x), 0x141))); x = fmaxf(x, __int_as_float(DPP_I(__float_as_int(x), 0x140)));
    const int xi = __float_as_int(x);
    return fmaxf(fmaxf(__int_as_float(__builtin_amdgcn_readlane(xi, 0)), __int_as_float(__builtin_amdgcn_readlane(xi, 16))), fmaxf(__int_as_float(__builtin_amdgcn_readlane(xi, 32)), __int_as_float(__builtin_amdgcn_readlane(xi, 48)))); }
__device__ __forceinline__ float wave_min_f(float x) { return -wave_max_f(-x); }
#define LDS_WAIT() asm volatile("s_waitcnt lgkmcnt(0)" ::: "memory")
__device__ __forceinline__ int lane_here() { int t; asm volatile("v_mbcnt_lo_u32_b32 %0, -1, 0\n\tv_mbcnt_hi_u32_b32 %0, -1, %0" : "=v"(t)); return t; }
#define tid_here() (wave_id * 64 + lane_here())

#define XB_TMO      128
#define XB_XCNT(j)  (256  + 64 * (j))
#define XB_XSUB(j)  (1280 + 64 * (j))
#define XB_XGEN(j)  (2304 + 64 * (j))
#define XB_TOP      3328
#define XB_TOPGEN   3392
#define XCD_BAR_WORDS 3456
#define XB_SPIN_CAP (1u << 24)
__device__ __forceinline__ unsigned xb_ld(unsigned* p)              { return __hip_atomic_load(p, __ATOMIC_RELAXED, __HIP_MEMORY_SCOPE_AGENT); }
__device__ __forceinline__ unsigned xb_add(unsigned* p, unsigned v) { return __hip_atomic_fetch_add(p, v, __ATOMIC_RELAXED, __HIP_MEMORY_SCOPE_AGENT); }
__device__ __forceinline__ unsigned xb_xcc_id() { return (unsigned)__builtin_amdgcn_s_getreg((3 << 11) | 20) & 0xFu; }
#define XB_SPIN(cond, bar) do { unsigned _sp = 0; while (cond) { __builtin_amdgcn_s_sleep(1); \
    if ((++_sp & 255u) == 0u) { if (xb_ld(&(bar)[XB_TMO])) break; if (_sp > XB_SPIN_CAP) { atomicAdd(&(bar)[XB_TMO], 1u); break; } } } } while (0)
struct XcdBarrier { unsigned* bar; unsigned x; volatile LAS unsigned* st; };
__device__ __forceinline__ XcdBarrier xcd_barrier_post(unsigned* bar, volatile LAS unsigned* st) {
    XcdBarrier b; b.bar = bar; b.x = xb_xcc_id(); b.st = st;
    if (threadIdx.x == 0) (void)xb_add(&bar[XB_XCNT(b.x)], 1u);
    return b;
}
__device__ __forceinline__ void xcd_barrier_complete(unsigned* bar, unsigned x, unsigned& nloc, unsigned& nx) {
    const unsigned G = gridDim.x * gridDim.y * gridDim.z;
    unsigned sum, cnt, mine, sp = 0u;
    for (;;) {
        sum = 0u; cnt = 0u; mine = 0u;
#pragma unroll
        for (unsigned j = 0; j < 16; ++j) { const unsigned c = xb_ld(&bar[XB_XCNT(j)]); sum += c; cnt += (c > 0u) ? 1u : 0u; mine = (j == x) ? c : mine; }
        if (sum == G) break;
        __builtin_amdgcn_s_sleep(1);
        if ((++sp & 255u) == 0u) { if (xb_ld(&bar[XB_TMO])) break; if (sp > XB_SPIN_CAP) { atomicAdd(&bar[XB_TMO], 1u); break; } }
    }
    nloc = mine > 0u ? mine : 1u; nx = cnt > 0u ? cnt : 1u;
}
__device__ __forceinline__ void xcd_barrier(const XcdBarrier& b) {
    asm volatile("s_waitcnt vmcnt(0)" ::: "memory");
    __syncthreads();
    if (threadIdx.x == 0) {
        size_t zo_ = 0; asm volatile("" : "+s"(zo_)); unsigned* bar = b.bar + zo_;
        __builtin_amdgcn_s_waitcnt(0);
        unsigned nloc = b.st[0], nx = b.st[1];
        if (nloc == 0u) { xcd_barrier_complete(bar, b.x, nloc, nx); b.st[0] = nloc; b.st[1] = nx; }
        const unsigned old = xb_add(&bar[XB_XSUB(b.x)], 1u);
        const unsigned gen = old / nloc;
        if (old + 1u == (gen + 1u) * nloc) {
            __builtin_amdgcn_fence(__ATOMIC_RELEASE, "agent");
            asm volatile("s_waitcnt vmcnt(0)" ::: "memory");
            const unsigned og = xb_add(&bar[XB_TOP], 1u);
            const unsigned tg = og / nx;
            if (og + 1u == (tg + 1u) * nx) xb_add(&bar[XB_TOPGEN], 1u);
            else XB_SPIN(xb_ld(&bar[XB_TOPGEN]) == tg, bar);
            __builtin_amdgcn_fence(__ATOMIC_ACQUIRE, "agent");
            xb_add(&bar[XB_XGEN(b.x)], 1u);
            asm volatile("s_waitcnt vmcnt(0)" ::: "memory");
        } else {
            XB_SPIN(xb_ld(&bar[XB_XGEN(b.x)]) == gen, bar);
            __builtin_amdgcn_fence(__ATOMIC_ACQUIRE, "agent");
            asm volatile("s_waitcnt vmcnt(0)" ::: "memory");
        }
    }
    __syncthreads();
}

struct SrcIn { __device__ __forceinline__ int operator()(int n) const {
    if (n < 1024) return n;
    const int t = (n - 1024) >> 8, c = (n - 1024) & 255, half = c >> 7, p = c & 127;
    if (t == 0) return 1056 + (p >> 5) * 64 + half * 32 + (p & 31);
    if (t == 1) return 1736 + (p >> 5) * 64 + half * 32 + (p & 31);
    if (t == 2) return 1992 + (p >> 5) * 64 + half * 32 + (p & 31);
    if (t == 3) return 1440 + (p >> 4) * 32 + half * 16 + (p & 15);
    if (t == 4) {
        if (p < 32) return 1312 + half * 32 + p;
        if (p < 48) return 1024 + half * 16 + (p - 32);
        if (p < 64) return 1696 + half * 16 + (p - 48);
        if (half == 0) return 1376 + (p - 64);
        return (p - 64 < 8) ? 1728 + (p - 64) : -1;
    }
    if (t == 5) return 2248 + c;
    return 2504 + c; } };
struct SrcUq { __device__ __forceinline__ int operator()(int n) const {
    if (n < 512) return (n >> 6) * 96 + (n & 63);
    const int c = n - 512, half = c >> 7, p = c & 127; return (p >> 4) * 96 + 64 + half * 16 + (p & 15); } };
struct SrcUkv { __device__ __forceinline__ int operator()(int n) const {
    if (n < 512) return (n >> 6) * 128 + (n & 63);
    const int c = n - 512; return (c >> 6) * 128 + 64 + (c & 63); } };
struct SrcId { __device__ __forceinline__ int operator()(int n) const { return n; } };

template <class SrcF>
__device__ __forceinline__ void transpose_item(const float* W, int K, int Nsrc, int Ndst, const float* gain, bf16* WT, LAS float* scr, int item, int lane, SrcF srcf) {
    const int nblk = Ndst / 32, kb = item / nblk, nb = item % nblk, k0 = 64 * kb, n0 = 32 * nb;
    const int sc = srcf(n0 + (lane & 31));
#pragma unroll 8
    for (int i = 0; i < 32; ++i) { const int kk = 2 * i + (lane >> 5); float v = 0.f; if (sc >= 0) v = W[(size_t)(k0 + kk) * Nsrc + sc]; if (gain) v *= gain[k0 + kk]; scr[kk * 33 + (lane & 31)] = v; }
    LDS_WAIT(); asm volatile("" ::: "memory");
    const int c = lane & 7;
#pragma unroll
    for (int j = 0; j < 4; ++j) { const int n = (lane >> 3) + 8 * j; const LAS float* s = scr + (8 * c) * 33 + n;
        u32x4 o; o.x = cvtpk(s[0 * 33], s[1 * 33]); o.y = cvtpk(s[2 * 33], s[3 * 33]); o.z = cvtpk(s[4 * 33], s[5 * 33]); o.w = cvtpk(s[6 * 33], s[7 * 33]);
        *(u32x4*)(WT + (size_t)(n0 + n) * K + k0 + 8 * c) = o; }
    LDS_WAIT(); asm volatile("" ::: "memory");
}

struct Ptrs {
    const float *x, *g_mix, *w_in, *g_q, *w_uq, *g_kv, *w_ukv, *g_ret, *w_out, *g_mlp, *w_ff1, *w_ff2, *g_final;
    float* out; unsigned char* ws;
};
struct Args { Ptrs p; int ph_lo, ph_hi; };
static_assert(sizeof(Args) == 15 * 8 + 8, "Args has no padding");

template <class F> struct EpiT {
    static constexpr bool PERM = true, AFTER_DRAIN = false;
    F f;
    template <int R0, int NRW>
    __device__ __forceinline__ void rows(const pg8::f32x4 (&acc)[2][2][4][2], const pg8::Unit& u, int row0, int wc, int fq, const typename F::Ctx& ctx) const {
        typename F::AuxT ax[NRW];
#pragma unroll
        for (int i = 0; i < NRW; ++i) ax[i] = f.load(row0 + ((R0 + i) >> 2) * 128 + ((R0 + i) & 3) * 16, u.pn, wc, fq);
        asm volatile("" ::: "memory");
#pragma unroll
        for (int i = 0; i < NRW; ++i) {
            const int it = R0 + i, ai = it >> 2, m = it & 3, row = row0 + ai * 128 + m * 16;
            float x1[8], x2[8];
#pragma unroll
            for (int j = 0; j < 4; ++j) { x1[j] = acc[ai][0][m][0][j]; x1[4 + j] = acc[ai][0][m][1][j]; x2[j] = acc[ai][1][m][0][j]; x2[4 + j] = acc[ai][1][m][1][j]; }
            f.apply(ctx, ax[i], row, u.pn, wc, fq, x1, x2);
            asm volatile("" ::: "memory");
        }
    }
    __device__ __forceinline__ void operator()(const pg8::f32x4 (&acc)[2][2][4][2], const pg8::Unit& u, int wr, int wc, int fr, int fq) const {
        { const int ln = lane_here(); fr = ln & 15; fq = ln >> 4; }
#if PROBE_KL
        if (*(volatile LAS unsigned*)(MISC_OFF + 128) & 1u) {
#pragma unroll
            for (int a = 0; a < 2; ++a)
#pragma unroll
                for (int b = 0; b < 2; ++b)
#pragma unroll
                    for (int m = 0; m < 4; ++m)
#pragma unroll
                        for (int n = 0; n < 2; ++n) asm volatile("" :: "v"(acc[a][b][m][n]));
            return; }
#endif
        const int row0 = u.pm * 256 + wr * 64 + fr;
        const typename F::Ctx ctx = f.begin(u.pn, wc, fq);
        if constexpr (F::BATCH == 8) rows<0, 8>(acc, u, row0, wc, fq, ctx);
        else { rows<0, 4>(acc, u, row0, wc, fq, ctx); rows<4, 4>(acc, u, row0, wc, fq, ctx); }
    }
};
__device__ __forceinline__ f32x4 part4(const float* p, int fq, int n4) { f32x4 a = {0.f, 0.f, 0.f, 0.f}; if (fq < n4) a = *(const f32x4*)(p + 4 * fq); return a; }
__device__ __forceinline__ float red4(const f32x4 a) { return xrow16_sum((a.x + a.y) + (a.z + a.w)); }
__device__ __forceinline__ float ssq16(const float* x1, const float* x2) { float s = 0.f;
#pragma unroll
    for (int j = 0; j < 8; ++j) s += x1[j] * x1[j] + x2[j] * x2[j];
    return xrow16_sum(s); }
struct RopeCtx { float inv[8]; };
__device__ __forceinline__ RopeCtx rope_ctx(int f0, bool dim64) { RopeCtx c; const float step = dim64 ? 0.41524101186092029f : 0.83048202372184058f;
#pragma unroll
    for (int j = 0; j < 8; ++j) c.inv[j] = __builtin_amdgcn_exp2f(-(float)(f0 + j) * step) * 0.15915494309189535f;
    return c; }
__device__ __forceinline__ void rope8(float* x1, float* x2, const RopeCtx& c, int pos) {
    const float pf = (float)pos;
#pragma unroll
    for (int j = 0; j < 8; ++j) { const float rev = __builtin_amdgcn_fractf(pf * c.inv[j]); const float cs = __builtin_amdgcn_cosf(rev), sn = __builtin_amdgcn_sinf(rev);
        const float a = x1[j], b = x2[j]; x1[j] = a * cs - b * sn; x2[j] = a * sn + b * cs; }
}

struct FIn {
    typedef f32x4 AuxT; typedef RopeCtx Ctx; static constexpr int BATCH = 8;
    unsigned char* ws;
    __device__ __forceinline__ Ctx begin(int pn, int wc, int fq) const { const int p = wc * 32 + fq * 8; const bool d64 = (pn >= 4 && pn <= 6) || (pn == 8 && wc == 0); return rope_ctx(d64 ? (p & 31) : (p & 15), d64); }
    __device__ __forceinline__ AuxT load(int row, int, int, int fq) const { return part4((const float*)(ws + WS_SSQX) + (size_t)row * 16, fq, 4); }
    __device__ __forceinline__ void apply(const Ctx& ctx, const AuxT& ax, int row, int pn, int wc, int fq, float* x1, float* x2) const {
        float* ssql = (float*)(ws + WS_SSQL);
        const float rs = __builtin_amdgcn_rsqf(red4(ax) * (1.0f / DM) + EPS);
#pragma unroll
        for (int j = 0; j < 8; ++j) { x1[j] *= rs; x2[j] *= rs; }
        const int p = wc * 32 + fq * 8, pos = row & (SEQ - 1);
        if (pn < 3) { bf16* d = (bf16*)(ws + WS_CQ) + (size_t)row * 768 + pn * 256 + p; st8(d, x1); st8(d + 128, x2); const float s = ssq16(x1, x2); if (fq == 0) ssql[(size_t)row * 16 + pn * 4 + wc] = s; }
        else if (pn == 3) { bf16* d = (bf16*)(ws + WS_CKV) + (size_t)row * 256 + p; st8(d, x1); st8(d + 128, x2); const float s = ssq16(x1, x2); if (fq == 0) ssql[(size_t)row * 16 + 12 + wc] = s; }
        else if (pn <= 6) { rope8(x1, x2, ctx, pos);
            const float sc_ = (pn == 4) ? 0.125f * LOG2E : (pn == 5) ? 1.0f : 0.125f;
#pragma unroll
            for (int j = 0; j < 8; ++j) { x1[j] *= sc_; x2[j] *= sc_; }
            bf16* d = (bf16*)(ws + WS_AQ + (size_t)(pn - 4) * (32 * MiB)) + (size_t)row * 256 + (p >> 5) * 64 + (p & 31); st8(d, x1); st8(d + 32, x2); }
        else if (pn == 7) { rope8(x1, x2, ctx, pos); bf16* d = (bf16*)(ws + WS_QI) + (size_t)row * 256 + (p >> 4) * 32 + (p & 15); st8(d, x1); st8(d + 16, x2); }
        else if (pn == 8) { bf16* d = (bf16*)(ws + WS_MS) + (size_t)row * 256;
            if (wc == 0) { rope8(x1, x2, ctx, pos); st8(d + p, x1); st8(d + 32 + p, x2); }
            else if (wc == 1) { const int i = (p - 32) & 15, o = (p < 48) ? 64 : 96; rope8(x1, x2, ctx, pos); st8(d + o + i, x1); st8(d + o + 16 + i, x2); }
            else { st8(d + 128 + (p - 64), x1); if (p == 64) { float w[8];
#pragma unroll
                    for (int j = 0; j < 8; ++j) w[j] = x2[j] * 0.0625f;
                    st8f((float*)(ws + WS_WI) + (size_t)row * 8, w); } } }
        else { bf16* d = (bf16*)(ws + WS_RV + (size_t)(pn - 9) * (32 * MiB)) + (size_t)row * 256 + p; st8(d, x1); st8(d + 128, x2); }
    }
};
static_assert(WS_V == WS_KN + 64 * MiB && WS_RQ == WS_AQ + 32 * MiB && WS_RK == WS_AQ + 64 * MiB && WS_RG == WS_RV + 32 * MiB, "FIn / FUkv compute these destinations by arithmetic");
struct FUq {
    typedef f32x4 AuxT; typedef RopeCtx Ctx; static constexpr int BATCH = 8;
    const float* ssql; bf16* q;
    __device__ __forceinline__ Ctx begin(int, int wc, int fq) const { return rope_ctx((wc * 32 + fq * 8) & 15, false); }
    __device__ __forceinline__ AuxT load(int row, int, int, int fq) const { return part4(ssql + (size_t)row * 16, fq, 3); }
    __device__ __forceinline__ void apply(const Ctx& ctx, const AuxT& ax, int row, int pn, int wc, int fq, float* x1, float* x2) const {
        const float rs = __builtin_amdgcn_rsqf(red4(ax) * (1.0f / 768.0f) + EPS) * (0.10206207261596577f * LOG2E);
#pragma unroll
        for (int j = 0; j < 8; ++j) { x1[j] *= rs; x2[j] *= rs; }
        const int p = wc * 32 + fq * 8;
        if (pn < 2) { const int c1 = pn * 256 + p, c2 = c1 + 128; st8(q + (size_t)row * 768 + (c1 >> 6) * 96 + (c1 & 63), x1); st8(q + (size_t)row * 768 + (c2 >> 6) * 96 + (c2 & 63), x2); }
        else { rope8(x1, x2, ctx, row & (SEQ - 1)); bf16* d = q + (size_t)row * 768 + (p >> 4) * 96 + 64 + (p & 15); st8(d, x1); st8(d + 16, x2); }
    }
};
struct NoCtx { };
struct FUkv {
    typedef f32x4 AuxT; typedef NoCtx Ctx; static constexpr int BATCH = 8;
    const float* ssql; bf16* kn;
    __device__ __forceinline__ Ctx begin(int, int, int) const { return Ctx{}; }
    __device__ __forceinline__ AuxT load(int row, int, int, int) const { return *(const f32x4*)(ssql + (size_t)row * 16 + 12); }
    __device__ __forceinline__ void apply(const Ctx&, const AuxT& ax, int row, int pn, int wc, int fq, float* x1, float* x2) const {
        const float rs = __builtin_amdgcn_rsqf(((ax.x + ax.y) + (ax.z + ax.w)) * (1.0f / 256.0f) + EPS);
#pragma unroll
        for (int j = 0; j < 8; ++j) { x1[j] *= rs; x2[j] *= rs; }
        const int p = wc * 32 + fq * 8; bf16* d = kn + (size_t)(pn >> 1) * (size_t)(32 * MiB) + (size_t)row * 512 + (pn & 1) * 256 + p; st8(d, x1); st8(d + 128, x2);
    }
};
struct ResAux { u32x4 a, b; f32x4 s; };
template <bool SCALE> struct FRes {
    typedef ResAux AuxT; typedef NoCtx Ctx; static constexpr int BATCH = RES_BATCH;
    bf16* xb; const float* ssq_in; float* ssq_out;
    __device__ __forceinline__ Ctx begin(int, int, int) const { return Ctx{}; }
    __device__ __forceinline__ AuxT load(int row, int pn, int wc, int fq) const {
        const size_t o = (size_t)row * DM + pn * 256 + wc * 32 + fq * 8; AuxT ax;
        ax.a = *(const u32x4*)(xb + o); ax.b = *(const u32x4*)(xb + o + 128); ax.s = (f32x4){0.f, 0.f, 0.f, 0.f};
        if (SCALE) ax.s = part4(ssq_in + (size_t)row * 16, fq, 4);
        return ax;
    }
    __device__ __forceinline__ void apply(const Ctx&, const AuxT& ax, int row, int pn, int wc, int fq, float* x1, float* x2) const {
        const int p = wc * 32 + fq * 8; const size_t o = (size_t)row * DM + pn * 256 + p;
        if (SCALE) { const float r2 = 1.0f / (red4(ax.s) * (1.0f / DM) + EPS);
#pragma unroll
            for (int j = 0; j < 8; ++j) { x1[j] *= r2; x2[j] *= r2; } }
        float a[8], b[8]; unpack8(ax.a, a); unpack8(ax.b, b);
#pragma unroll
        for (int j = 0; j < 8; ++j) { x1[j] += a[j]; x2[j] += b[j]; }
        st8(xb + o, x1); st8(xb + o + 128, x2);
        const float s = ssq16(x1, x2); if (fq == 0) ssq_out[(size_t)row * 16 + pn * 4 + wc] = s;
    }
};
struct FFf1 {
    typedef int AuxT; typedef NoCtx Ctx; static constexpr int BATCH = 8;
    bf16* h;
    __device__ __forceinline__ Ctx begin(int, int, int) const { return Ctx{}; }
    __device__ __forceinline__ AuxT load(int, int, int, int) const { return 0; }
    __device__ __forceinline__ void apply(const Ctx&, const AuxT&, int row, int pn, int wc, int fq, float* x1, float* x2) const {
#pragma unroll
        for (int j = 0; j < 8; ++j) { const float a = fmaxf(x1[j], 0.f), b = fmaxf(x2[j], 0.f); x1[j] = a * a; x2[j] = b * b; }
        const int p = wc * 32 + fq * 8; bf16* d = h + (size_t)row * FF + pn * 256 + p; st8nt(d, x1); st8nt(d + 128, x2);
    }
};

struct FNull {
    typedef int AuxT; typedef NoCtx Ctx; static constexpr int BATCH = 8;
    __device__ __forceinline__ Ctx begin(int, int, int) const { return Ctx{}; }
    __device__ __forceinline__ AuxT load(int, int, int, int) const { return 0; }
    __device__ __forceinline__ void apply(const Ctx&, const AuxT&, int, int, int, int, float* x1, float* x2) const {
#pragma unroll
        for (int j = 0; j < 8; ++j) asm volatile("" :: "v"(x1[j]), "v"(x2[j])); }
};
#if MK_NAIVE_GEMM
template <class Epi, class Sched>
__device__ __forceinline__ void gemm_phase_x(LAS unsigned char*, const pg8::Gemm g, const Sched& S, const Epi& E, const int wave_id) {
    const int tid = tid_here(), wid = wave_id, lane = tid & 63, wr = wid >> 2, wc = wid & 3, fr = lane & 15, fq = lane >> 4;
    pg8::Unit u;
    for (int it = 0; S.next(it, u); ++it) {
        pg8::f32x4 acc[2][2][4][2];
#pragma unroll
        for (int a = 0; a < 2; ++a)
#pragma unroll
            for (int b = 0; b < 2; ++b)
#pragma unroll
                for (int m = 0; m < 4; ++m)
#pragma unroll
                    for (int n = 0; n < 2; ++n) acc[a][b][m][n] = (pg8::f32x4){0.f, 0.f, 0.f, 0.f};
        for (int k = 0; k < g.K; k += 8) {
            float bv[2][8][8];
#pragma unroll
            for (int bj = 0; bj < 2; ++bj)
#pragma unroll
                for (int c = 0; c < 8; ++c) { const int col = u.pn * 256 + bj * 128 + wc * 32 + fq * 8 + c; unpack8(*(const u32x4*)(g.Bt + (size_t)col * g.K + k), bv[bj][c]); }
#pragma unroll
            for (int ai = 0; ai < 2; ++ai)
#pragma unroll
                for (int m = 0; m < 4; ++m) { const int row = u.pm * 256 + ai * 128 + wr * 64 + m * 16 + fr; float av[8]; unpack8(*(const u32x4*)(g.A + (size_t)row * g.K + k), av);
#pragma unroll
                    for (int bj = 0; bj < 2; ++bj)
#pragma unroll
                        for (int c = 0; c < 8; ++c) { float s = 0.f;
#pragma unroll
                            for (int j = 0; j < 8; ++j) s += av[j] * bv[bj][c][j];
                            acc[ai][bj][m][c >> 2][c & 3] += s; } }
        }
        E(acc, u, wr, wc, fr, fq);
    }
    __syncthreads();
}
#define GEMM_PHASE(EpiType, lds, g, S, E) gemm_phase_x<EpiType, pg8::StaticOrder>(lds, g, S, E, wave_id)
#else
#define GEMM_PHASE(EpiType, lds, g, S, E) pg8::gemm_phase<EpiType, pg8::StaticOrder, true, true>(lds, g, S, E, wave_id)
#endif
#if PROBE_KL
#define KL_RUN(bit, FT, ...) do { EpiT<FT> E{FT{__VA_ARGS__}}; for (int rep_ = 0; rep_ < ((PROBE_KL >> (bit)) & 1) + 1; ++rep_) { __syncthreads(); if (tid_here() == 0) *(volatile LAS unsigned*)(lds + MISC_OFF + 128) = (rep_ + 1 < ((PROBE_KL >> (bit)) & 1) + 1) ? 1u : 0u; __syncthreads(); GEMM_PHASE(EpiT<FT>, lds, g, S, E); } } while (0)
#else
#define KL_RUN(bit, FT, ...) do { EpiT<FT> E{FT{__VA_ARGS__}}; GEMM_PHASE(EpiT<FT>, lds, g, S, E); } while (0)
#endif

__device__ __forceinline__ void mla_naive(const bf16* Q, const bf16* KN, const bf16* MS, const bf16* V, bf16* O, const int wave_id) {
    const int tid = tid_here();
    for (int u = blockIdx.x; u < BATCH * 8 * 4; u += gridDim.x) {
        const int b = u >> 5, h = (u >> 2) & 7, tb = u & 3, t = tb * 512 + tid; const size_t row = (size_t)b * SEQ + t;
        float q[96], o[64];
#pragma unroll
        for (int c = 0; c < 12; ++c) unpack8(*(const u32x4*)(Q + row * 768 + h * 96 + c * 8), q + c * 8);
#pragma unroll
        for (int d = 0; d < 64; ++d) o[d] = 0.f;
        float mx = -1e30f, l = 0.f;
        const int smax = tb * 512 + (tid | 63);
        for (int s = 0; s <= smax; ++s) {
            const size_t rs = (size_t)b * SEQ + s; float sc = 0.f;
#pragma unroll
            for (int c = 0; c < 8; ++c) { float k[8]; unpack8(*(const u32x4*)(KN + rs * 512 + h * 64 + c * 8), k);
#pragma unroll
                for (int j = 0; j < 8; ++j) sc += q[c * 8 + j] * k[j]; }
#pragma unroll
            for (int c = 0; c < 4; ++c) { float k[8]; unpack8(*(const u32x4*)(MS + rs * 256 + 64 + c * 8), k);
#pragma unroll
                for (int j = 0; j < 8; ++j) sc += q[64 + c * 8 + j] * k[j]; }
            if (s <= t) {
                const float mn = fmaxf(mx, sc), a = __builtin_amdgcn_exp2f(mx - mn), pp = __builtin_amdgcn_exp2f(sc - mn);
                l = l * a + pp; mx = mn;
#pragma unroll
                for (int c = 0; c < 8; ++c) { float v[8]; unpack8(*(const u32x4*)(V + rs * 512 + h * 64 + c * 8), v);
#pragma unroll
                    for (int j = 0; j < 8; ++j) o[c * 8 + j] = o[c * 8 + j] * a + pp * v[j]; }
            }
        }
        const float inv = 1.0f / l;
#pragma unroll
        for (int c = 0; c < 8; ++c) { float w[8];
#pragma unroll
            for (int j = 0; j < 8; ++j) w[j] = o[c * 8 + j] * inv;
            st8(O + row * DM + h * 64 + c * 8, w); }
    }
}
__device__ __forceinline__ void dsa_naive(const bf16* AQ, const bf16* MS, const unsigned* BM, bf16* O, const int wave_id) {
    const int tid = tid_here();
    for (int u = blockIdx.x; u < BATCH * 4 * 4; u += gridDim.x) {
        const int b = u >> 4, h = (u >> 2) & 3, tb = u & 3, t = tb * 512 + tid; const size_t row = (size_t)b * SEQ + t;
        float q[64], o[64];
#pragma unroll
        for (int c = 0; c < 8; ++c) { unpack8(*(const u32x4*)(AQ + row * 256 + h * 64 + c * 8), q + c * 8);
#pragma unroll
            for (int j = 0; j < 8; ++j) q[c * 8 + j] *= 1.0f; }
#pragma unroll
        for (int d = 0; d < 64; ++d) o[d] = 0.f;
        float mx = -1e30f, l = 0.f; unsigned word = 0;
        const int smax = tb * 512 + (tid | 63);
        for (int s = 0; s <= smax; ++s) {
            if ((s & 31) == 0) word = BM[row * 64 + (s >> 5)];
            const bool sel = (s <= t) && ((word >> (s & 31)) & 1u);
            if (sel) {
                const size_t rs = (size_t)b * SEQ + s; float sc = 0.f;
#pragma unroll
                for (int c = 0; c < 8; ++c) { float k[8]; unpack8(*(const u32x4*)(MS + rs * 256 + c * 8), k);
#pragma unroll
                    for (int j = 0; j < 8; ++j) sc += q[c * 8 + j] * k[j]; }
                const float mn = fmaxf(mx, sc), a = __builtin_amdgcn_exp2f(mx - mn), pp = __builtin_amdgcn_exp2f(sc - mn);
                l = l * a + pp; mx = mn;
#pragma unroll
                for (int c = 0; c < 8; ++c) { float v[8]; unpack8(*(const u32x4*)(MS + rs * 256 + 128 + c * 8), v);
#pragma unroll
                    for (int j = 0; j < 8; ++j) o[c * 8 + j] = o[c * 8 + j] * a + pp * v[j]; }
            }
        }
        const float inv = 1.0f / l;
#pragma unroll
        for (int c = 0; c < 8; ++c) { float w[8];
#pragma unroll
            for (int j = 0; j < 8; ++j) w[j] = o[c * 8 + j] * inv;
            st8(O + row * DM + 512 + h * 64 + c * 8, w); }
    }
}
typedef float f32x2s __attribute__((ext_vector_type(2)));
__device__ __forceinline__ f32x2s pk_gt(f32x2s v, f32x2s big, f32x2s nm) { f32x2s e; asm("v_pk_fma_f32 %0, %1, %2, %3 clamp" : "=v"(e) : "v"(v), "v"(big), "v"(nm)); return e; }
__device__ __forceinline__ float max3_raw(float a, float b, float c) { float r; asm("v_max3_f32 %0, %1, %2, %3" : "=v"(r) : "v"(a), "v"(b), "v"(c)); return r; }
__device__ __forceinline__ float min3_raw(float a, float b, float c) { float r; asm("v_min3_f32 %0, %1, %2, %3" : "=v"(r) : "v"(a), "v"(b), "v"(c)); return r; }
__device__ __forceinline__ float wave_sum_f(float x) {
    x += __int_as_float(DPP_I(__float_as_int(x), 0xB1)); x += __int_as_float(DPP_I(__float_as_int(x), 0x4E)); x += __int_as_float(DPP_I(__float_as_int(x), 0x141)); x += __int_as_float(DPP_I(__float_as_int(x), 0x140));
    const int xi = __float_as_int(x);
    return (__int_as_float(__builtin_amdgcn_readlane(xi, 0)) + __int_as_float(__builtin_amdgcn_readlane(xi, 16))) + (__int_as_float(__builtin_amdgcn_readlane(xi, 32)) + __int_as_float(__builtin_amdgcn_readlane(xi, 48))); }
__device__ __forceinline__ int fkey(int u) { return u ^ ((u >> 31) & 0x7fffffff); }
template <int NR>
__device__ __forceinline__ void select_row(const f32x2s (&vp)[NR / 2], int nk, u64* bm, int lane) {
    static_assert(NR % 2 == 0, "pairs");
    float mx = vp[0].x, mn = vp[0].x;
#pragma unroll
    for (int j = 0; j < NR / 2; ++j) { mx = max3_raw(mx, vp[j].x, vp[j].y); mn = min3_raw(mn, vp[j].x, vp[j].y); }
    float hi = wave_max_f(mx); const float mnw = wave_min_f(mn);
    float lo = mnw - fabsf(mnw) * 1e-3f - 1e-3f;
    int clo = nk, chi = 0;
    bool exact = false; float thr = hi;
    float bigs = 1.152921504606847e18f, zf = 0.f; asm volatile("" : "+v"(bigs), "+v"(zf));
    const f32x2s big = {bigs, bigs};
    constexpr int NS = (NR == 8) ? 4 : NR - 8;
#define OPQ(c) ({ float c_ = (c); asm volatile("" : "+v"(c_)); c_; })
    f32x2s s1 = {zf, zf}, s2 = {zf, zf};
#pragma unroll
    for (int j = 0; j < NS / 2; ++j) { s1 += vp[j]; s2 += vp[j] * vp[j]; }
    const float S1 = wave_sum_f(s1.x + s1.y), S2 = wave_sum_f(s2.x + s2.y);
    const float invn = OPQ(1.0f / (64.0f * NS));
    float mu = S1 * invn; asm volatile("" : "+v"(mu));
    float var = fmaxf(__builtin_fmaf(S2, invn, -mu * mu), OPQ(1e-20f)); asm volatile("" : "+v"(var));
    float sd = var * __builtin_amdgcn_rsqf(var); asm volatile("" : "+v"(sd));
    float pq = 1.0f - OPQ(256.5f) * __builtin_amdgcn_rcpf((float)nk); pq = fminf(fmaxf(pq, OPQ(0.025f)), OPQ(0.975f));
    const float z = __builtin_amdgcn_logf(pq * __builtin_amdgcn_rcpf(1.0f - pq)) * OPQ(0.40725434f);
    float zz2 = z * z; asm volatile("" : "+v"(zz2));
    float rdens = sd * __builtin_amdgcn_rcpf((float)nk * OPQ(0.3989422804f) * __builtin_amdgcn_exp2f(OPQ(-0.72134752f) * zz2));
    asm volatile("" : "+v"(rdens));
    float nxt = __builtin_fmaf(z, sd, mu); asm volatile("" : "+v"(nxt)); bool have_nxt = true; int nsteps = 0;
    for (int it = 0; it < 200; ++it) {
        const int kl = fkey(__float_as_int(lo)), kh = fkey(__float_as_int(hi));
        if ((unsigned)kh - (unsigned)kl <= 1u) break;
        const float kmid = __int_as_float(fkey(kl + (int)(((unsigned)kh - (unsigned)kl) >> 1)));
        float mid = 0.5f * lo + 0.5f * hi;
        const bool third = (it % 3 == 2);
        if (third || !(mid > lo) || !(mid < hi)) mid = kmid;
        if (have_nxt) { if (nxt > lo && nxt < hi) mid = nxt; have_nxt = false; }
        else if (!third) { const float gq = lo + (hi - lo) * (((float)(clo - 256) + 0.5f) * __builtin_amdgcn_rcpf((float)(clo - chi))); if (gq > lo && gq < hi) mid = gq; }
        const float nmv = -mid * 1.152921504606847e18f; const f32x2s nm = {nmv, nmv};
        f32x2s acc0 = {zf, zf}, acc1 = {zf, zf}, acc2 = {zf, zf}, acc3 = {zf, zf};
#pragma unroll
        for (int j = 0; j < NR / 2; j += 4) { acc0 += pk_gt(vp[j], big, nm); acc1 += pk_gt(vp[j + 1], big, nm); acc2 += pk_gt(vp[j + 2], big, nm); acc3 += pk_gt(vp[j + 3], big, nm); }
        const f32x2s acc = (acc0 + acc1) + (acc2 + acc3);
        const int c = (int)wave_sum_f(acc.x + acc.y);
        if (c == 256) { exact = true; thr = mid; break; }
        if (c > 256) { lo = mid; clo = c; } else { hi = mid; chi = c; }
        if (nsteps < 2) { ++nsteps; nxt = mid + ((float)(c - 256) + 0.5f) * rdens; have_nxt = true; }
    }
    if (exact) {
#pragma unroll
        for (int j = 0; j < NR / 2; ++j) { const u64 w0 = __ballot(vp[j].x > thr), w1 = __ballot(vp[j].y > thr); bm[2 * j] = w0; bm[2 * j + 1] = w1; }
    } else {
        const int need = 256 - chi; int tr = 0; const u64 lt = (1ull << lane) - 1ull;
#pragma unroll
        for (int i = 0; i < NR; ++i) { const float x = (i & 1) ? vp[i >> 1].y : vp[i >> 1].x; const bool gt = x > hi, tie = (x == hi); const u64 tb = __ballot(tie); const int rank = tr + __popcll(tb & lt); tr += __popcll(tb);
            const u64 w = __ballot(gt || (tie && rank < need)); bm[i] = w; }
    }
}
__device__ __forceinline__ void select_naive(LAS unsigned char* lds, const bf16* QI, const bf16* MS, const float* WI, u64* BM, const int wave_id) {
    const int tid = tid_here(), wave = wave_id, lane = tid & 63;
    LAS float* sc_lds = (LAS float*)(lds + wave * 8192);
    LAS float* qi_lds = (LAS float*)(lds + 65536 + wave * 1024);
    for (int qb = blockIdx.x; qb < M / 8; qb += gridDim.x) {
        const int row = qb * 8 + wave, b = row >> 11, t = row & (SEQ - 1);
        u64* bm = BM + (size_t)row * 32;
        if (t < 256) { if (lane < 32) { const int k0 = 64 * lane; bm[lane] = (t >= k0 + 63) ? ~0ull : (t < k0 ? 0ull : ((1ull << (t - k0 + 1)) - 1ull)); } continue; }
        { const u32x2 r = *(const u32x2*)(QI + (size_t)row * 256 + lane * 4); qi_lds[lane * 4] = bf_lo(r.x); qi_lds[lane * 4 + 1] = bf_hi(r.x); qi_lds[lane * 4 + 2] = bf_lo(r.y); qi_lds[lane * 4 + 3] = bf_hi(r.y); }
        float w8[8];
#pragma unroll
        for (int hh = 0; hh < 8; ++hh) w8[hh] = WI[(size_t)row * 8 + hh];
        LDS_WAIT();
        const int nk = t + 1;
        for (int s0 = 0; s0 < nk; s0 += 64) {
            const int s = s0 + lane; float scv = -INFINITY;
            if (s < nk) { float k[32];
#pragma unroll
                for (int c = 0; c < 4; ++c) unpack8(*(const u32x4*)(MS + ((size_t)b * SEQ + s) * 256 + 96 + c * 8), k + c * 8);
                scv = 0.f;
#pragma unroll
                for (int hh = 0; hh < 8; ++hh) { float d = 0.f;
#pragma unroll
                    for (int j = 0; j < 32; ++j) d += qi_lds[hh * 32 + j] * k[j];
                    scv += w8[hh] * fmaxf(d, 0.f); } }
            sc_lds[s] = scv; }
        LDS_WAIT();
        float v[32];
#pragma unroll
        for (int i = 0; i < 32; ++i) v[i] = (i * 64 + lane < nk) ? sc_lds[i * 64 + lane] : __builtin_nanf("");
        { f32x2s vp[16];
#pragma unroll
          for (int i = 0; i < 32; ++i) { if (i & 1) vp[i >> 1].y = v[i]; else vp[i >> 1].x = v[i]; }
          select_row<32>(vp, nk, bm, lane); }
        LDS_WAIT();
    }
}
__device__ __forceinline__ void ret_naive(const bf16* RQ, const bf16* RK, const bf16* RV, const bf16* RG, const float* g_ret, bf16* O, const int wave_id) {
    const int tid = tid_here();
    for (int u = blockIdx.x; u < BATCH * 4 * 4; u += gridDim.x) {
        const int b = u >> 4, h = (u >> 2) & 3, tb = u & 3, t = tb * 512 + tid; const size_t row = (size_t)b * SEQ + t;
        const float lg2 = (h == 0) ? -0.045803689613124935f : (h == 1) ? -0.022720076500083562f : (h == 2) ? -0.011315313227834123f : -0.0056465631411395075f;
        float q[64], o[64];
#pragma unroll
        for (int c = 0; c < 8; ++c) unpack8(*(const u32x4*)(RQ + row * 256 + h * 64 + c * 8), q + c * 8);
#pragma unroll
        for (int d = 0; d < 64; ++d) o[d] = 0.f;
        const int smax = tb * 512 + (tid | 63);
        for (int s = 0; s <= smax; ++s) {
            const size_t rs = (size_t)b * SEQ + s; float sc = 0.f;
#pragma unroll
            for (int c = 0; c < 8; ++c) { float k[8]; unpack8(*(const u32x4*)(RK + rs * 256 + h * 64 + c * 8), k);
#pragma unroll
                for (int j = 0; j < 8; ++j) sc += q[c * 8 + j] * k[j]; }
            if (s <= t) {
                const float w = sc * __builtin_amdgcn_exp2f((float)(t - s) * lg2);
#pragma unroll
                for (int c = 0; c < 8; ++c) { float v[8]; unpack8(*(const u32x4*)(RV + rs * 256 + h * 64 + c * 8), v);
#pragma unroll
                    for (int j = 0; j < 8; ++j) o[c * 8 + j] += w * v[j]; }
            }
        }
        float mu = 0.f;
#pragma unroll
        for (int d = 0; d < 64; ++d) mu += o[d];
        mu *= (1.0f / 64.0f); float var = 0.f;
#pragma unroll
        for (int d = 0; d < 64; ++d) { const float e = o[d] - mu; var += e * e; }
        const float rstd = 1.0f / sqrtf(var * (1.0f / 64.0f) + EPS);
#pragma unroll
        for (int c = 0; c < 8; ++c) { float g[8], w[8]; unpack8(*(const u32x4*)(RG + row * 256 + h * 64 + c * 8), g);
#pragma unroll
            for (int j = 0; j < 8; ++j) { const float y = (o[c * 8 + j] - mu) * rstd * g_ret[h * 64 + c * 8 + j]; w[j] = y * g[j] / (1.0f + __expf(-g[j])); }
            st8(O + row * DM + 768 + h * 64 + c * 8, w); }
    }
}

typedef short bf16x8 __attribute__((ext_vector_type(8)));
typedef float f32x16 __attribute__((ext_vector_type(16)));
typedef short s16x4 __attribute__((ext_vector_type(4)));
__device__ __forceinline__ s16x4 ds_tr16(LAS const unsigned char* p) { return __builtin_bit_cast(s16x4, __builtin_amdgcn_ds_read_tr16_b64_v4i16((LAS s16x4*)p)); }
struct TagF { static constexpr bool value = true; }; struct TagG { static constexpr bool value = false; };
template <bool MLA>
__device__ __forceinline__ void attn_phase(LAS unsigned char* lds, const bf16* Qp, const bf16* KNp, const bf16* MSp, const bf16* Vp, const u64* BMp, bf16* Op, const int wave_id) {
    constexpr int DQK = MLA ? 96 : 64, KS = DQK / 16, KP = DQK * 2 + 16, VP = 192, KBUF = 64 * KP, VBUF = 64 * VP, BUF = KBUF + VBUF, QG = 2, NQR = MLA ? ATT_NQR : 4, QSLOT = QG * (KS - NQR) * 1024;
    static_assert(2 * BUF + 8 * QSLOT <= RING_BYTES, "attention LDS");
    const int tid = tid_here(), wave = wave_id, lane = tid & 63, l31 = lane & 31, hi = lane >> 5;
    const int G = gridDim.x, NU = MLA ? 1024 : 512;
    const int keyA = tid >> 3, chA = tid & 7;
    const int vb = (4 * hi + ((lane & 15) >> 2)) * VP + (16 * ((lane >> 4) & 1) + 4 * (lane & 3)) * 2;
    for (int u = blockIdx.x; u < NU; u += G) {
        int b, h, qw0, nt;
        if (MLA) { const int bh = u & 255, r = u >> 8, qb = (r + bh) & 3; b = bh >> 3; h = bh & 7; qw0 = qb * 512 + 64 * wave; nt = 8 * (qb + 1); }
        else { const int bj = u & 255, r = u >> 8, j = bj & 7, qb = (r == 0) ? j : 15 - j; b = bj >> 3; h = wave >> 1; qw0 = qb * 128 + 64 * (wave & 1); nt = 2 * (qb + 1); }
        const int qg0[2] = {MLA ? qw0 - 32 * wave : qw0, MLA ? qw0 - 64 * wave + 32 * (15 - wave) : qw0 + 32};
        const size_t rowb = (size_t)b * SEQ;
        bf16x8 qf[QG][NQR];
        LAS unsigned char* qrl = lds + 2 * BUF + wave * QSLOT + lane * 16;
#pragma unroll
        for (int g = 0; g < QG; ++g)
#pragma unroll
            for (int s = 0; s < KS; ++s) { const bf16* qb_ = Qp + (rowb + qg0[g]) * (MLA ? 768 : 256) + h * DQK + 16 * s;
                const bf16x8 f = *(const bf16x8*)((const char*)qb_ + (unsigned)(l31 * (MLA ? 1536 : 512) + 16 * hi));
                if (s < NQR) qf[g][s < NQR ? s : 0] = f; else *(LAS bf16x8*)(qrl + (g * (KS - NQR) + (s - NQR)) * 1024) = f; }
        f32x16 ot[QG][2];
#pragma unroll
        for (int g = 0; g < QG; ++g)
#pragma unroll
            for (int r = 0; r < 16; ++r) { ot[g][0][r] = 0.f; ot[g][1][r] = 0.f; }
        float mrun[QG], lrun[QG];
#pragma unroll
        for (int g = 0; g < QG; ++g) { mrun[g] = -1e30f; lrun[g] = 0.f; }
        u32x4 sa, sb, sc;
        const unsigned offA_ = 2u * (unsigned)(MLA ? keyA * 512 + chA * 8 : keyA * 256 + chA * 8);
        const unsigned offB_ = 2u * (unsigned)(MLA ? (tid < 256 ? (tid >> 2) * 256 + 64 + (tid & 3) * 8 : ((tid - 256) >> 3) * 512 + chA * 8) : keyA * 256 + 128 + chA * 8);
        const unsigned offC_ = 2u * (unsigned)((32 + keyA) * 512 + chA * 8);
#define ATT_LOAD(j) do { const size_t rk = rowb + 64 * (j); unsigned offA = offA_, offB = offB_, offC = offC_; asm volatile("" : "+v"(offA), "+v"(offB), "+v"(offC));     \
            if (MLA) { const bf16* kb_ = KNp + rk * 512 + h * 64; const bf16* vb2_ = Vp + rk * 512 + h * 64; const bf16* mb_ = MSp + rk * 256; \
                       sa = *(const u32x4*)((const char*)kb_ + offA); \
                       if (tid < 256) { sb = *(const u32x4*)((const char*)mb_ + offB); sc = *(const u32x4*)((const char*)vb2_ + offC); } \
                       else sb = *(const u32x4*)((const char*)vb2_ + offB); } \
            else { const bf16* mb_ = MSp + rk * 256; sa = *(const u32x4*)((const char*)mb_ + offA); sb = *(const u32x4*)((const char*)mb_ + offB); } } while (0)
#define ATT_WRITE(buf) do { LAS unsigned char* kb_ = lds + (buf) * BUF; LAS unsigned char* vb_ = kb_ + KBUF; \
            *(LAS u32x4*)(kb_ + keyA * KP + chA * 16) = sa; \
            if (MLA) { if (tid < 256) { *(LAS u32x4*)(kb_ + (tid >> 2) * KP + 128 + (tid & 3) * 16) = sb; *(LAS u32x4*)(vb_ + (32 + keyA) * VP + chA * 16) = sc; } \
                       else *(LAS u32x4*)(vb_ + ((tid - 256) >> 3) * VP + chA * 16) = sb; } \
            else *(LAS u32x4*)(vb_ + keyA * VP + chA * 16) = sb; } while (0)
        auto tile = [&](auto tag_, const int j) __attribute__((always_inline)) {
            constexpr bool FULL = decltype(tag_)::value;
            const bool active = (MLA && !FULL) ? (64 * j <= qg0[1] + 31) : true, act0 = (MLA && !FULL) ? (64 * j <= qg0[0] + 31) : true;
            if (active) {
                LAS const unsigned char* kbuf = lds + (j & 1) * BUF; LAS const unsigned char* vbuf = kbuf + KBUF;
                f32x16 st[QG][2];
#pragma unroll
                for (int g = 0; g < QG; ++g)
#pragma unroll
                    for (int r = 0; r < 16; ++r) { st[g][0][r] = 0.f; st[g][1][r] = 0.f; }
#pragma unroll
                for (int s = 0; s < KS; ++s) {
                    const bf16x8 k0 = *(LAS const bf16x8*)(kbuf + l31 * KP + (16 * s + 8 * hi) * 2), k1 = *(LAS const bf16x8*)(kbuf + (32 + l31) * KP + (16 * s + 8 * hi) * 2);
#pragma unroll
                    for (int g = 0; g < QG; ++g) { if (g == 0 && !act0) continue; bf16x8 qq; if (s < NQR) qq = qf[g][s < NQR ? s : 0]; else qq = *(LAS const bf16x8*)(qrl + (g * (KS - NQR) + (s - NQR)) * 1024);
                        st[g][0] = __builtin_amdgcn_mfma_f32_32x32x16_bf16(k0, qq, st[g][0], 0, 0, 0); st[g][1] = __builtin_amdgcn_mfma_f32_32x32x16_bf16(k1, qq, st[g][1], 0, 0, 0); } }
                bf16x8 pf[QG][4];
#define ATT_MASK(g) do { const int qpos = qg0[g] + l31; \
                    if (MLA) { if (64 * j + 63 > qg0[g]) { const int lim = qpos - 64 * j - 4 * hi; \
                            _Pragma("unroll") for (int r = 0; r < 16; ++r) { const int ko = (r & 3) + 8 * (r >> 2); if (ko > lim) st[g][0][r] = -INFINITY; if (ko + 32 > lim) st[g][1][r] = -INFINITY; } } } \
                    else { const u64* bmb_ = BMp + (rowb + qg0[g]) * 32 + j; unsigned lo_ = (unsigned)(l31 * 256); asm volatile("" : "+v"(lo_)); \
                        const u64 w = *(const u64*)((const char*)bmb_ + lo_); const unsigned wlo = (unsigned)(w >> (4 * hi)), whi = (unsigned)(w >> (32 + 4 * hi)); \
                        _Pragma("unroll") for (int r = 0; r < 16; ++r) { const int ko = (r & 3) + 8 * (r >> 2); \
                            { const unsigned m_ = (unsigned)__builtin_amdgcn_sbfe((int)wlo, ko, 1); st[g][0][r] = __uint_as_float((m_ & __float_as_uint(st[g][0][r])) | (~m_ & 0xff800000u)); } \
                            { const unsigned m_ = (unsigned)__builtin_amdgcn_sbfe((int)whi, ko, 1); st[g][1][r] = __uint_as_float((m_ & __float_as_uint(st[g][1][r])) | (~m_ & 0xff800000u)); } } } } while (0)
#define ATT_MX3(a, b, c) __builtin_fmaxf(__builtin_fmaxf((a), (b)), (c))
#define ATT_MAXR(g, mt) do { float ma_ = st[g][0][0], mb_ = st[g][1][0]; \
                    _Pragma("unroll") for (int r = 1; r < 16; r += 2) { ma_ = ATT_MX3(ma_, st[g][0][r], st[g][0][r + 1 < 16 ? r + 1 : r]); mb_ = ATT_MX3(mb_, st[g][1][r], st[g][1][r + 1 < 16 ? r + 1 : r]); } \
                    mt = xhalf_max(__builtin_fmaxf(ma_, mb_)); } while (0)
#define ATT_RESC(g, mt) do { const float mn0 = fmaxf(mrun[g], mt), alpha = __builtin_amdgcn_exp2f(mrun[g] - mn0); mrun[g] = mn0; lrun[g] *= alpha; \
                    _Pragma("unroll") for (int r = 0; r < 16; ++r) { ot[g][0][r] *= alpha; ot[g][1][r] *= alpha; } } while (0)
#define ATT_EXPS(g) do { const float mn = mrun[g]; float ps = 0.f; \
                    _Pragma("unroll") for (int r = 0; r < 16; ++r) { st[g][0][r] = __builtin_amdgcn_exp2f(st[g][0][r] - mn); st[g][1][r] = __builtin_amdgcn_exp2f(st[g][1][r] - mn); ps += st[g][0][r] + st[g][1][r]; } \
                    lrun[g] += ps; \
                    _Pragma("unroll") for (int t = 0; t < 2; ++t) _Pragma("unroll") for (int s = 0; s < 2; ++s) { u32x4 a; a.x = cvtpk(st[g][t][8 * s], st[g][t][8 * s + 1]); a.y = cvtpk(st[g][t][8 * s + 2], st[g][t][8 * s + 3]); \
                            a.z = cvtpk(st[g][t][8 * s + 4], st[g][t][8 * s + 5]); a.w = cvtpk(st[g][t][8 * s + 6], st[g][t][8 * s + 7]); pf[g][2 * t + s] = __builtin_bit_cast(bf16x8, a); } } while (0)
                if (FULL || !MLA) {
                    float mt0, mt1;
                    if (!FULL) { ATT_MASK(0); ATT_MASK(1); } ATT_MAXR(0, mt0); ATT_MAXR(1, mt1);
                    if (__builtin_amdgcn_ballot_w64((mt0 > mrun[0] + 6.0f) || (mt1 > mrun[1] + 6.0f)) != 0ull) { ATT_RESC(0, mt0); ATT_RESC(1, mt1); }
                    __builtin_amdgcn_sched_barrier(0); ATT_EXPS(0); __builtin_amdgcn_sched_barrier(0); ATT_EXPS(1);
                } else {
                    if (act0) { float mt0; ATT_MASK(0); ATT_MAXR(0, mt0); if (__builtin_amdgcn_ballot_w64(mt0 > mrun[0] + 6.0f) != 0ull) { ATT_RESC(0, mt0); } ATT_EXPS(0); }
                    float mt1;
                    ATT_MASK(1); ATT_MAXR(1, mt1);
                    if (__builtin_amdgcn_ballot_w64(mt1 > mrun[1] + 6.0f) != 0ull) { ATT_RESC(1, mt1); }
                    ATT_EXPS(1);
                }
#undef ATT_MASK
#undef ATT_MAXR
#undef ATT_RESC
#undef ATT_EXPS
#pragma unroll
                for (int ks = 0; ks < 4; ++ks) {
                    const s16x4 a0 = ds_tr16(vbuf + vb + (16 * ks) * VP), a1 = ds_tr16(vbuf + vb + (16 * ks + 8) * VP), c0 = ds_tr16(vbuf + vb + (16 * ks) * VP + 64), c1 = ds_tr16(vbuf + vb + (16 * ks + 8) * VP + 64);
                    const bf16x8 v0 = {a0[0], a0[1], a0[2], a0[3], a1[0], a1[1], a1[2], a1[3]}, v1 = {c0[0], c0[1], c0[2], c0[3], c1[0], c1[1], c1[2], c1[3]};
#pragma unroll
                    for (int g = 0; g < QG; ++g) { if (g == 0 && !act0) continue; ot[g][0] = __builtin_amdgcn_mfma_f32_32x32x16_bf16(v0, pf[g][ks], ot[g][0], 0, 0, 0); ot[g][1] = __builtin_amdgcn_mfma_f32_32x32x16_bf16(v1, pf[g][ks], ot[g][1], 0, 0, 0); } }
            }
        };
        const int jf = (MLA && ATT_SPLIT) ? (((qg0[0] + 1) >> 6) < nt ? ((qg0[0] + 1) >> 6) : nt) : 0;
        ATT_LOAD(0); ATT_WRITE(0); __syncthreads();
        int j = 0;
        if (MLA && ATT_SPLIT) {
            for (; j < jf; ++j) {
                const bool more = (j + 1 < nt);
                if (more) ATT_LOAD(j + 1);
                tile(TagF{}, j);
                if (more) ATT_WRITE((j + 1) & 1);
                __syncthreads();
            }
        }
        for (; j < nt; ++j) {
            const bool more = (j + 1 < nt);
            if (more) ATT_LOAD(j + 1);
            tile(TagG{}, j);
            if (more) ATT_WRITE((j + 1) & 1);
            __syncthreads();
        }
#undef ATT_LOAD
#undef ATT_WRITE
        const int le = lane_here(), l31e = le & 31, hie = le >> 5;
#pragma unroll
        for (int g = 0; g < QG; ++g) {
            const float inv = 1.0f / xhalf_sum(lrun[g]);
            bf16* orow = Op + (rowb + qg0[g] + l31e) * DM + (MLA ? h * 64 : 512 + h * 64) + 8 * hie;
#pragma unroll
            for (int t = 0; t < 2; ++t)
#pragma unroll
                for (int k = 0; k < 4; k += 2) {
                    u32x2 a, b2; a.x = cvtpk(ot[g][t][4 * k] * inv, ot[g][t][4 * k + 1] * inv); a.y = cvtpk(ot[g][t][4 * k + 2] * inv, ot[g][t][4 * k + 3] * inv);
                    b2.x = cvtpk(ot[g][t][4 * k + 4] * inv, ot[g][t][4 * k + 5] * inv); b2.y = cvtpk(ot[g][t][4 * k + 6] * inv, ot[g][t][4 * k + 7] * inv);
                    const auto rx = __builtin_amdgcn_permlane32_swap(a.x, b2.x, false, false); const auto ry = __builtin_amdgcn_permlane32_swap(a.y, b2.y, false, false);
                    u32x4 w; w.x = rx[0]; w.y = ry[0]; w.z = rx[1]; w.w = ry[1];
                    *(u32x4*)(orow + 32 * t + 8 * k) = w; }
        }
    }
}

__device__ __forceinline__ void ret_phase(LAS unsigned char* lds, const bf16* RQ, const bf16* RK, const bf16* RV, const bf16* RG, const float* g_ret, bf16* Op, const int wave_id) {
    constexpr int KP = 144, VP = 192, OFF_K = 0, OFF_V = 128 * KP, OFF_Z = OFF_V + 128 * VP, OFF_R = OFF_Z + 128 * VP;
    const int tid = tid_here(), wave = wave_id, lane = tid & 63, l31 = lane & 31, hi = lane >> 5;
    const int trq = (lane & 15) >> 2, trc = (16 * ((lane >> 4) & 1) + 4 * (lane & 3)) * 2;
    const int trn = (8 * hi + trq) * VP + trc, trp = (4 * hi + trq) * VP + trc;
    LAS unsigned char* KT = lds + OFF_K; LAS unsigned char* VT = lds + OFF_V; LAS unsigned char* KZ = lds + OFF_Z; LAS unsigned char* RT = lds + OFF_R;
    for (int u = blockIdx.x; u < BATCH * 4; u += gridDim.x) {
        const int b = u >> 2, h = u & 3; const size_t rowb = (size_t)b * SEQ;
        const float lg = (h == 0) ? -0.04580368961312479f : (h == 1) ? -0.02272007650008353f : (h == 2) ? -0.011315313227834146f : -0.005646563141142063f;
        { unsigned zz = 0u; asm volatile("" : "+v"(zz)); *(LAS u32x4*)(RT + (tid >> 3) * VP + (tid & 7) * 16) = (u32x4){zz, zz, zz, zz}; }
        f32x16 sacc;
#pragma unroll
        for (int r = 0; r < 16; ++r) sacc[r] = 0.f;
        u32x4 k0, k1, v0, v1;
#define RET_LOAD(n) do { const size_t r0 = rowb + 128 * (n) + (tid >> 3), r1 = r0 + 64; const int co = h * 64 + (tid & 7) * 8; \
            k0 = *(const u32x4*)(RK + r0 * 256 + co); k1 = *(const u32x4*)(RK + r1 * 256 + co); v0 = *(const u32x4*)(RV + r0 * 256 + co); v1 = *(const u32x4*)(RV + r1 * 256 + co); } while (0)
        RET_LOAD(0);
        for (int n = 0; n < 16; ++n) {
            {
                const int r0 = tid >> 3, cb = (tid & 7) * 16;
                *(LAS u32x4*)(KT + r0 * KP + cb) = k0; *(LAS u32x4*)(KT + (r0 + 64) * KP + cb) = k1; *(LAS u32x4*)(VT + r0 * VP + cb) = v0; *(LAS u32x4*)(VT + (r0 + 64) * VP + cb) = v1;
                float f[8]; const float z0 = __builtin_amdgcn_exp2f((float)(127 - r0) * lg), z1 = __builtin_amdgcn_exp2f((float)(63 - r0) * lg);
                unpack8(k0, f);
#pragma unroll
                for (int j = 0; j < 8; ++j) f[j] *= z0;
                { u32x4 w; w.x = cvtpk(f[0], f[1]); w.y = cvtpk(f[2], f[3]); w.z = cvtpk(f[4], f[5]); w.w = cvtpk(f[6], f[7]); *(LAS u32x4*)(KZ + r0 * VP + cb) = w; }
                unpack8(k1, f);
#pragma unroll
                for (int j = 0; j < 8; ++j) f[j] *= z1;
                { u32x4 w; w.x = cvtpk(f[0], f[1]); w.y = cvtpk(f[2], f[3]); w.z = cvtpk(f[4], f[5]); w.w = cvtpk(f[6], f[7]); *(LAS u32x4*)(KZ + (r0 + 64) * VP + cb) = w; }
            }
            const int posq = 32 * wave + l31; const size_t rowq = rowb + 128 * n + (wave < 4 ? posq : 0);
            bf16x8 qf[4];
            if (wave < 4) {
#pragma unroll
                for (int s = 0; s < 4; ++s) qf[s] = *(const bf16x8*)(RQ + rowq * 256 + h * 64 + 16 * s + 8 * hi); }
            __syncthreads();
            if (n + 1 < 16) RET_LOAD(n + 1);
            f32x16 a0, a1;
            if (wave < 4) {
#pragma unroll
                for (int r = 0; r < 16; ++r) { a0[r] = 0.f; a1[r] = 0.f; }
#pragma unroll
                for (int s = 0; s < 4; ++s) {
                    const s16x4 x0 = ds_tr16(RT + trn + (16 * s) * VP), x1 = ds_tr16(RT + trn + (16 * s + 4) * VP), y0 = ds_tr16(RT + trn + (16 * s) * VP + 64), y1 = ds_tr16(RT + trn + (16 * s + 4) * VP + 64);
                    const bf16x8 f0 = {x0[0], x0[1], x0[2], x0[3], x1[0], x1[1], x1[2], x1[3]}, f1 = {y0[0], y0[1], y0[2], y0[3], y1[0], y1[1], y1[2], y1[3]};
                    a0 = __builtin_amdgcn_mfma_f32_32x32x16_bf16(f0, qf[s], a0, 0, 0, 0); a1 = __builtin_amdgcn_mfma_f32_32x32x16_bf16(f1, qf[s], a1, 0, 0, 0); }
                const float xi = __builtin_amdgcn_exp2f((float)(posq + 1) * lg);
#pragma unroll
                for (int r = 0; r < 16; ++r) { a0[r] *= xi; a1[r] *= xi; }
#pragma unroll 1
                for (int kt = 0; kt <= wave; ++kt) {
                    {
                        f32x16 st;
#pragma unroll
                        for (int r = 0; r < 16; ++r) st[r] = 0.f;
#pragma unroll
                        for (int s = 0; s < 4; ++s) { const bf16x8 kf = *(LAS const bf16x8*)(KT + (32 * kt + l31) * KP + (16 * s + 8 * hi) * 2); st = __builtin_amdgcn_mfma_f32_32x32x16_bf16(kf, qf[s], st, 0, 0, 0); }
#pragma unroll
                        for (int r = 0; r < 16; ++r) { const int rel = posq - (32 * kt + (r & 3) + 8 * (r >> 2) + 4 * hi); const float w = __builtin_amdgcn_exp2f((float)rel * lg); st[r] = (rel >= 0) ? st[r] * w : 0.f; }
#pragma unroll
                        for (int s = 0; s < 2; ++s) {
                            u32x4 pw; pw.x = cvtpk(st[8 * s], st[8 * s + 1]); pw.y = cvtpk(st[8 * s + 2], st[8 * s + 3]); pw.z = cvtpk(st[8 * s + 4], st[8 * s + 5]); pw.w = cvtpk(st[8 * s + 6], st[8 * s + 7]);
                            const bf16x8 pf = __builtin_bit_cast(bf16x8, pw);
                            const int ro = (32 * kt + 16 * s) * VP;
                            const s16x4 x0 = ds_tr16(VT + trp + ro), x1 = ds_tr16(VT + trp + ro + 8 * VP), y0 = ds_tr16(VT + trp + ro + 64), y1 = ds_tr16(VT + trp + ro + 8 * VP + 64);
                            const bf16x8 f0 = {x0[0], x0[1], x0[2], x0[3], x1[0], x1[1], x1[2], x1[3]}, f1 = {y0[0], y0[1], y0[2], y0[3], y1[0], y1[1], y1[2], y1[3]};
                            a0 = __builtin_amdgcn_mfma_f32_32x32x16_bf16(f0, pf, a0, 0, 0, 0); a1 = __builtin_amdgcn_mfma_f32_32x32x16_bf16(f1, pf, a1, 0, 0, 0); }
                    }
                }
            } else {
                const int et = wave & 1, dt = (wave >> 1) & 1; const float cd = __builtin_amdgcn_exp2f(128.0f * lg);
#pragma unroll
                for (int r = 0; r < 16; ++r) sacc[r] *= cd;
#pragma unroll
                for (int s = 0; s < 8; ++s) {
                    const s16x4 x0 = ds_tr16(VT + trn + (16 * s) * VP + et * 64), x1 = ds_tr16(VT + trn + (16 * s + 4) * VP + et * 64), y0 = ds_tr16(KZ + trn + (16 * s) * VP + dt * 64), y1 = ds_tr16(KZ + trn + (16 * s + 4) * VP + dt * 64);
                    const bf16x8 fa = {x0[0], x0[1], x0[2], x0[3], x1[0], x1[1], x1[2], x1[3]}, fb = {y0[0], y0[1], y0[2], y0[3], y1[0], y1[1], y1[2], y1[3]};
                    sacc = __builtin_amdgcn_mfma_f32_32x32x16_bf16(fa, fb, sacc, 0, 0, 0); }
            }
            __syncthreads();
            if (wave < 4) {
                float s1 = 0.f;
#pragma unroll
                for (int r = 0; r < 16; ++r) s1 += a0[r] + a1[r];
                s1 = xhalf_sum(s1); const float mu = s1 * (1.0f / 64.0f); float s2 = 0.f;
#pragma unroll
                for (int r = 0; r < 16; ++r) { const float d0 = a0[r] - mu, d1 = a1[r] - mu; s2 += d0 * d0 + d1 * d1; }
                s2 = xhalf_sum(s2); const float rstd = __builtin_amdgcn_rsqf(s2 * (1.0f / 64.0f) + EPS);
#pragma unroll
                for (int t = 0; t < 2; ++t)
#pragma unroll
                    for (int g = 0; g < 4; ++g) { const int e0 = h * 64 + 32 * t + 8 * g + 4 * hi;
                        const u32x2 gr = *(const u32x2*)(RG + rowq * 256 + e0); const f32x4 gg = *(const f32x4*)(g_ret + e0);
                        const float gt[4] = {bf_lo(gr.x), bf_hi(gr.x), bf_lo(gr.y), bf_hi(gr.y)}; const float gn[4] = {gg.x, gg.y, gg.z, gg.w}; float y[4];
#pragma unroll
                        for (int i = 0; i < 4; ++i) { const float x = (t == 0 ? a0[4 * g + i] : a1[4 * g + i]); y[i] = (x - mu) * rstd * gn[i] * gt[i] / (1.0f + __expf(-gt[i])); }
                        u32x2 w; w.x = cvtpk(y[0], y[1]); w.y = cvtpk(y[2], y[3]); *(u32x2*)(Op + rowq * DM + 768 + e0) = w; }
            } else {
                const int et = wave & 1, dt = (wave >> 1) & 1;
#pragma unroll
                for (int g = 0; g < 4; ++g) { u32x2 w; w.x = cvtpk(sacc[4 * g], sacc[4 * g + 1]); w.y = cvtpk(sacc[4 * g + 2], sacc[4 * g + 3]);
                    *(LAS u32x2*)(RT + (32 * dt + l31) * VP + (32 * et + 8 * g + 4 * hi) * 2) = w; }
            }
        }
#undef RET_LOAD
        __syncthreads();
    }
}


template <int NR>
__device__ __forceinline__ void select_two(LAS const float* sc, LAS float* cand, LAS unsigned* ticket, int lane, int t0, int nkt, u64* bmrow0) {
    for (;;) {
        unsigned qv = 0u; if (lane == 0) qv = __hip_atomic_fetch_add(ticket, 1u, __ATOMIC_RELAXED, __HIP_MEMORY_SCOPE_WORKGROUP);
        const int q = __builtin_amdgcn_readfirstlane((int)qv);
        if (q >= 16) break;
        const int nk = t0 + q + 1; u64* bm = bmrow0 + (size_t)q * 32;
        f32x2s vp[NR / 2];
#pragma unroll
        for (int i = 0; i < NR; ++i) { float x = __builtin_nanf(""); if (2 * i < nkt) { x = sc[q * 2048 + i * 64 + lane]; if (2 * i + 1 >= nkt && lane >= 32) x = __builtin_nanf(""); }
            if (i & 1) vp[i >> 1].y = x; else vp[i >> 1].x = x; }
        select_row<NR>(vp, nk, bm, lane);
        if (NR < 32 && lane >= NR && lane < 32) { unsigned zz = 0u; asm volatile("" : "+v"(zz)); *(u32x2*)(bm + lane) = (u32x2){zz, zz}; }
    }
}
__device__ __forceinline__ void select_phase(LAS unsigned char* lds, const bf16* QI, const bf16* MS, const float* WI, u64* BM, const int wave_id) {
    const int tid = tid_here(), wave = wave_id, lane = tid & 63, l31 = lane & 31, hi = lane >> 5;
    LAS float* sc = (LAS float*)lds;
    const bool deal256 = (gridDim.x == 256); const int cblk = blockIdx.x;
    constexpr int NB = SEL_NB;
    const int nmine = deal256 ? (cblk < 128 ? NB : NB + 2 * (16 - NB)) : (M / 16 - cblk + (int)gridDim.x - 1) / (int)gridDim.x;
    for (int iu = 0; iu < nmine; ++iu) {
        int r, x;
        if (deal256) { if (iu < NB) { r = iu; x = cblk; } else { r = NB + ((iu - NB) >> 1); x = (cblk - 128) + 128 * ((iu - NB) & 1); } }
        else { const int v = cblk + iu * (int)gridDim.x; r = v >> 8; x = v & 255; }
        const int pr = (r < 7) ? r : (r < 14 ? r + 2 : r - 7);
        const int b = x >> 3, tb = pr * 8 + (x & 7), t0 = tb * 16; const size_t rowb = (size_t)b * SEQ;
        if (t0 < 256) {
            const int t = t0 + 2 * wave + (lane >> 5); u64* bm = BM + (rowb + t) * 32; const int k0 = 64 * l31;
            bm[l31] = (t >= k0 + 63) ? ~0ull : (t < k0 ? 0ull : ((1ull << (t - k0 + 1)) - 1ull));
            continue;
        }
        const int nkt = (t0 + 16 + 31) >> 5;
        if (tid == 0) *(LAS unsigned*)(lds + RING_BYTES + 512) = 0u;
        const int qloc = 2 * ((l31 >> 2) & 1) + (l31 >> 4), hd = 4 * ((l31 >> 3) & 1) + (l31 & 3);
        bf16x8 qa[4][2]; float wv[4][2][8];
#pragma unroll
        for (int qg = 0; qg < 4; ++qg) {
            const size_t rq = rowb + t0 + 4 * qg + qloc;
            qa[qg][0] = *(const bf16x8*)(QI + rq * 256 + hd * 32 + 8 * hi); qa[qg][1] = *(const bf16x8*)(QI + rq * 256 + hd * 32 + 16 + 8 * hi);
#pragma unroll
            for (int jq = 0; jq < 2; ++jq) { const float* wp = WI + (rowb + t0 + 4 * qg + 2 * hi + jq) * 8; const f32x4 wa = *(const f32x4*)wp, wb = *(const f32x4*)(wp + 4);
                wv[qg][jq][0] = wa.x; wv[qg][jq][1] = wa.y; wv[qg][jq][2] = wa.z; wv[qg][jq][3] = wa.w; wv[qg][jq][4] = wb.x; wv[qg][jq][5] = wb.y; wv[qg][jq][6] = wb.z; wv[qg][jq][7] = wb.w; }
        }
        const bf16* kp0 = MS + (rowb + l31) * 256 + 96 + 8 * hi;
        REP(7) {
        if (wave < nkt) {
        bf16x8 kb0 = *(const bf16x8*)(kp0 + (size_t)(32 * wave) * 256), kb1 = *(const bf16x8*)(kp0 + (size_t)(32 * wave) * 256 + 16);
        for (int kt = wave; kt < nkt; kt += 8) {
            const int ktn = (kt + 8 < nkt) ? kt + 8 : kt;
            const bf16x8 nb0 = *(const bf16x8*)(kp0 + (size_t)(32 * ktn) * 256), nb1 = *(const bf16x8*)(kp0 + (size_t)(32 * ktn) * 256 + 16);
#pragma unroll
            for (int qg = 0; qg < 4; ++qg) {
                f32x16 d;
#pragma unroll
                for (int r = 0; r < 16; ++r) d[r] = 0.f;
                d = __builtin_amdgcn_mfma_f32_32x32x16_bf16(qa[qg][0], kb0, d, 0, 0, 0); d = __builtin_amdgcn_mfma_f32_32x32x16_bf16(qa[qg][1], kb1, d, 0, 0, 0);
                float w0 = 0.f, w1 = 0.f;
#pragma unroll
                for (int i = 0; i < 8; ++i) { w0 += wv[qg][0][i] * fmaxf(d[i], 0.f); w1 += wv[qg][1][i] * fmaxf(d[8 + i], 0.f); }
                LAS float* o = sc + (4 * qg + 2 * hi) * 2048 + 32 * kt + l31;
                if (kt == nkt - 1) { const int tq0 = t0 + 4 * qg + 2 * hi, key = 32 * kt + l31; if (key > tq0) w0 = __builtin_nanf(""); if (key > tq0 + 1) w1 = __builtin_nanf(""); }
                o[0] = w0; o[2048] = w1;
            }
            kb0 = nb0; kb1 = nb1;
        }
        }
        }
        __syncthreads();
        u64* bmrow0 = BM + (rowb + t0) * 32;
        REP(8) {
        LAS float* cand = (LAS float*)(lds + RING_BYTES + 1024) + wave * 128; LAS unsigned* ticket = (LAS unsigned*)(lds + RING_BYTES + 512);
        if (t0 + 16 <= 512) select_two<8>(sc, cand, ticket, lane, t0, nkt, bmrow0);
        else if (t0 + 16 <= 1024) select_two<16>(sc, cand, ticket, lane, t0, nkt, bmrow0);
        else if (t0 + 16 <= 1536) select_two<24>(sc, cand, ticket, lane, t0, nkt, bmrow0);
        else select_two<32>(sc, cand, ticket, lane, t0, nkt, bmrow0);
        }
        __syncthreads();
    }
}

__device__ __forceinline__ void prologue(const Ptrs& P, LAS unsigned char* lds, const int wave_id) {
    const int tid = tid_here(), wave = wave_id, lane = tid & 63;
    LAS float* scr = (LAS float*)(lds + wave * 16384);
    const int gw = blockIdx.x * NWAVES + wave, NGW = gridDim.x * NWAVES;
    constexpr int I_IN = (DM / 64) * (NIN / 32), I_UQ = (768 / 64) * (768 / 32), I_UKV = (256 / 64) * (1024 / 32), I_OUT = (DM / 64) * (DM / 32), I_F1 = (DM / 64) * (FF / 32), I_F2 = (FF / 64) * (DM / 32);
    constexpr int I_L = I_IN + I_UQ + I_UKV + I_OUT + I_F1 + I_F2;
    for (int it = gw; it < DEPTH * I_L; it += NGW) {
        const int l = it / I_L; int r = it % I_L; unsigned char* wl = P.ws + WS_W + (size_t)l * WL_BYTES;
        if (r < I_IN) { transpose_item(P.w_in + (size_t)l * DM * IN_W, DM, IN_W, NIN, P.g_mix + l * DM, (bf16*)(wl + WL_IN), scr, r, lane, SrcIn()); continue; } r -= I_IN;
        if (r < I_UQ) { transpose_item(P.w_uq + (size_t)l * 768 * 768, 768, 768, 768, P.g_q + l * 768, (bf16*)(wl + WL_UQ), scr, r, lane, SrcUq()); continue; } r -= I_UQ;
        if (r < I_UKV) { transpose_item(P.w_ukv + (size_t)l * 256 * 1024, 256, 1024, 1024, P.g_kv + l * 256, (bf16*)(wl + WL_UKV), scr, r, lane, SrcUkv()); continue; } r -= I_UKV;
        if (r < I_OUT) { transpose_item(P.w_out + (size_t)l * DM * DM, DM, DM, DM, nullptr, (bf16*)(wl + WL_OUT), scr, r, lane, SrcId()); continue; } r -= I_OUT;
        if (r < I_F1) { transpose_item(P.w_ff1 + (size_t)l * DM * FF, DM, FF, FF, P.g_mlp + l * DM, (bf16*)(wl + WL_F1), scr, r, lane, SrcId()); continue; } r -= I_F1;
        transpose_item(P.w_ff2 + (size_t)l * FF * DM, FF, DM, DM, nullptr, (bf16*)(wl + WL_F2), scr, r, lane, SrcId());
    }
    bf16* xb = (bf16*)(P.ws + WS_XB); float* ssqx = (float*)(P.ws + WS_SSQX);
    for (int m0 = gw * PRO_ROWS; m0 < M; m0 += NGW * PRO_ROWS) {
        f32x4 v[PRO_ROWS][4];
#pragma unroll
        for (int r = 0; r < PRO_ROWS; ++r) { const f32x4* xr = (const f32x4*)(P.x + (size_t)(m0 + r) * DM) + lane;
#pragma unroll
            for (int j = 0; j < 4; ++j) v[r][j] = xr[64 * j]; }
#pragma unroll
        for (int r = 0; r < PRO_ROWS; ++r) {
            float s = 0.f;
#pragma unroll
            for (int j = 0; j < 4; ++j) s += (v[r][j].x * v[r][j].x + v[r][j].y * v[r][j].y) + (v[r][j].z * v[r][j].z + v[r][j].w * v[r][j].w);
            s = wave_sum_f(s);
            u32x2* o8 = (u32x2*)(xb + (size_t)(m0 + r) * DM) + lane;
#pragma unroll
            for (int j = 0; j < 4; ++j) { u32x2 w; w.x = cvtpk(v[r][j].x, v[r][j].y); w.y = cvtpk(v[r][j].z, v[r][j].w); o8[64 * j] = w; }
            if (lane < 16) ssqx[(size_t)(m0 + r) * 16 + lane] = (lane == 0) ? s : 0.f;
        }
    }
}
__device__ __forceinline__ void final_norm(const Ptrs& P, const int wave_id) {
    const int tid = tid_here(), wave = wave_id, lane = tid & 63;
    const int gw = blockIdx.x * NWAVES + wave, NGW = gridDim.x * NWAVES;
    const float* ssqx = (const float*)(P.ws + WS_SSQX); const bf16* xb = (const bf16*)(P.ws + WS_XB);
    const f32x4* g = (const f32x4*)P.g_final + 2 * lane;
    const f32x4 g00 = g[0], g01 = g[1], g10 = g[128], g11 = g[129];
    for (int m0 = gw * FIN_ROWS; m0 < M; m0 += NGW * FIN_ROWS) {
        u32x4 xv[FIN_ROWS][2]; float ss[FIN_ROWS];
#pragma unroll
        for (int r = 0; r < FIN_ROWS; ++r) { const u32x4* xr = (const u32x4*)(xb + (size_t)(m0 + r) * DM) + lane; xv[r][0] = xr[0]; xv[r][1] = xr[64];
            const float* sp = ssqx + (size_t)(m0 + r) * 16; ss[r] = (lane < 16) ? sp[lane] : 0.f; }
#pragma unroll
        for (int r = 0; r < FIN_ROWS; ++r) {
            const float rs = __builtin_amdgcn_rsqf(wave_sum_f(ss[r]) * (1.0f / DM) + EPS);
            f32x4* orow = (f32x4*)(P.out + (size_t)(m0 + r) * DM) + 2 * lane;
            float a[8], b[8]; unpack8(xv[r][0], a); unpack8(xv[r][1], b);
            orow[0] = (f32x4){a[0] * rs * g00.x, a[1] * rs * g00.y, a[2] * rs * g00.z, a[3] * rs * g00.w}; orow[1] = (f32x4){a[4] * rs * g01.x, a[5] * rs * g01.y, a[6] * rs * g01.z, a[7] * rs * g01.w};
            orow[128] = (f32x4){b[0] * rs * g10.x, b[1] * rs * g10.y, b[2] * rs * g10.z, b[3] * rs * g10.w}; orow[129] = (f32x4){b[4] * rs * g11.x, b[5] * rs * g11.y, b[6] * rs * g11.z, b[7] * rs * g11.w};
        }
    }
}

constexpr int PH_PER_LAYER = 6, N_PHASES = 2 + DEPTH * PH_PER_LAYER;

__global__ void __launch_bounds__(NTHREADS, 2) fwd(Args args) {
    extern __shared__ __attribute__((aligned(16))) unsigned char lds_raw[];
    LAS unsigned char* lds = (LAS unsigned char*)lds_raw;
    const Ptrs& P = args.p;
    const int wave_id = __builtin_amdgcn_readfirstlane((int)threadIdx.x >> 6);
    const int tid = tid_here();
    for (int u = tid; u < (LDS_BYTES - RING_BYTES) / 4; u += NTHREADS) ((LAS unsigned*)(lds + RING_BYTES))[u] = 0u;
    __syncthreads();
    unsigned char* const ws0 = P.ws;
    XcdBarrier bar; bar.bar = (unsigned*)(ws0 + WS_CTL) + CW_BAR; bar.x = 0; bar.st = nullptr;
#if MK_N_LAUNCHES == 1
    bar = xcd_barrier_post((unsigned*)(ws0 + WS_CTL) + CW_BAR, (volatile LAS unsigned*)(lds + MISC_OFF) + 8);
#define GRID_BAR() xcd_barrier(bar)
#else
#define GRID_BAR() do { } while (0)
#endif
    const int lo = args.ph_lo, hi = args.ph_hi;
#define IN(k) (lo <= (k) && (k) < hi)
#define LAUNDER_WS() size_t zo_ = 0; asm volatile("" : "+s"(zo_)); unsigned char* const ws = ws0 + zo_
#define SEAM(k) do { if (IN(k) && IN((k) + 1)) { REP(10) GRID_BAR(); } } while (0)
    const int G = gridDim.x, c = blockIdx.x;

#define XB ((bf16*)(ws + WS_XB))
#define SSQX ((float*)(ws + WS_SSQX))
#define SSQL ((float*)(ws + WS_SSQL))
#define SSQ2 ((float*)(ws + WS_SSQ2))
#define WI ((float*)(ws + WS_WI))
#define CQ ((bf16*)(ws + WS_CQ))
#define CKV ((bf16*)(ws + WS_CKV))
#define AQ ((bf16*)(ws + WS_AQ))
#define RQ ((bf16*)(ws + WS_RQ))
#define RK ((bf16*)(ws + WS_RK))
#define QI ((bf16*)(ws + WS_QI))
#define MS ((bf16*)(ws + WS_MS))
#define RV ((bf16*)(ws + WS_RV))
#define RG ((bf16*)(ws + WS_RG))
#define Q ((bf16*)(ws + WS_Q))
#define KN ((bf16*)(ws + WS_KN))
#define V ((bf16*)(ws + WS_V))
#define O ((bf16*)(ws + WS_O))
#define H ((bf16*)(ws + WS_H))
#define BM ((u64*)(ws + WS_BM))
    if (IN(0)) { REP(9) prologue(P, lds, wave_id); } SEAM(0);

    for (int l = 0; l < DEPTH; ++l) {
        const int pb = 1 + l * PH_PER_LAYER;
        if (IN(pb + 0)) {
            LAUNDER_WS(); unsigned char* wl = ws + WS_W + (size_t)l * WL_BYTES; (void)wl;
            pg8::Gemm g{XB, (const bf16*)(wl + WL_IN), M, NIN, DM}; pg8::StaticOrder S; S.init(M, NIN, G, c);
            KL_RUN(0, FIn, ws);
        } SEAM(pb + 0);
        if (IN(pb + 1)) {
            { LAUNDER_WS(); unsigned char* wl = ws + WS_W + (size_t)l * WL_BYTES; pg8::Gemm g{CQ, (const bf16*)(wl + WL_UQ), M, 768, 768}; pg8::StaticOrder S; S.init(M, 768, G, c); KL_RUN(1, FUq, SSQL, Q); }
            { LAUNDER_WS(); unsigned char* wl = ws + WS_W + (size_t)l * WL_BYTES; pg8::Gemm g{CKV, (const bf16*)(wl + WL_UKV), M, 1024, 256}; pg8::StaticOrder S; S.init(M, 1024, G, c); KL_RUN(2, FUkv, SSQL, KN); }
            { LAUNDER_WS(); REP(2) select_phase(lds, QI, MS, WI, BM, wave_id); }
            __syncthreads();
            { LAUNDER_WS(); const float* gr = P.g_ret + l * 256 + zo_; REP(3) ret_phase(lds, RQ, RK, RV, RG, gr, O, wave_id); }
        } SEAM(pb + 1);
        if (IN(pb + 2)) {
            LAUNDER_WS(); unsigned char* wl = ws + WS_W + (size_t)l * WL_BYTES; (void)wl;
            REP(4) attn_phase<true>(lds, Q, KN, MS, V, nullptr, O, wave_id);
            REP(5) attn_phase<false>(lds, AQ, nullptr, MS, nullptr, BM, O, wave_id);
        } SEAM(pb + 2);
        if (IN(pb + 3)) {
            LAUNDER_WS(); unsigned char* wl = ws + WS_W + (size_t)l * WL_BYTES; (void)wl;
            pg8::Gemm g{O, (const bf16*)(wl + WL_OUT), M, DM, DM}; pg8::StaticOrder S; S.init(M, DM, G, c);
            KL_RUN(3, FRes<false>, XB, nullptr, SSQ2);
        } SEAM(pb + 3);
        if (IN(pb + 4)) {
            LAUNDER_WS(); unsigned char* wl = ws + WS_W + (size_t)l * WL_BYTES; (void)wl;
            pg8::Gemm g{XB, (const bf16*)(wl + WL_F1), M, FF, DM}; pg8::StaticOrder S; S.init(M, FF, G, c);
            KL_RUN(4, FFf1, H);
        } SEAM(pb + 4);
        if (IN(pb + 5)) {
            LAUNDER_WS(); unsigned char* wl = ws + WS_W + (size_t)l * WL_BYTES; (void)wl;
            pg8::Gemm g{H, (const bf16*)(wl + WL_F2), M, DM, FF}; pg8::StaticOrder S; S.init(M, DM, G, c);
            KL_RUN(5, FRes<true>, XB, SSQ2, SSQX);
        } SEAM(pb + 5);
    }
    if (IN(N_PHASES - 1)) final_norm(P, wave_id);
#undef IN
#undef SEAM
}
}

extern "C" void kernel_launch(void* const* d_in, const int* in_sizes, int n_in, void* d_out, int out_size, void* d_ws, size_t ws_size, hipStream_t stream) {
    using namespace mk;
    static int grid = 0;
    if (grid == 0) {
        if (n_in != 13 || in_sizes[0] != M * DM || out_size != M * DM || ws_size < WS_END || ws_size < WS_H + 512 * MiB) {
            fprintf(stderr, "kernel_launch: unexpected shapes (n_in %d, in0 %d, out %d, ws %zu); nothing launched\n", n_in, n_in > 0 ? in_sizes[0] : -1, out_size, ws_size); grid = -1; return; }
        int dev = 0, cus = 0, per_cu = 0;
        if (hipGetDevice(&dev) != hipSuccess || hipDeviceGetAttribute(&cus, hipDeviceAttributeMultiprocessorCount, dev) != hipSuccess) { grid = -1; return; }
        if (hipFuncSetAttribute((const void*)fwd, hipFuncAttributeMaxDynamicSharedMemorySize, LDS_BYTES) != hipSuccess) { fprintf(stderr, "kernel_launch: hipFuncSetAttribute failed\n"); grid = -1; return; }
        if (hipOccupancyMaxActiveBlocksPerMultiprocessor(&per_cu, (const void*)fwd, NTHREADS, LDS_BYTES) != hipSuccess || per_cu < 1) { fprintf(stderr, "kernel_launch: occupancy query says %d\n", per_cu); }
        (void)hipGetLastError();
        grid = cus;
    }
    if (grid < 0) return;
    if (hipMemsetAsync((char*)d_ws + WS_CTL, 0, CTL_ZERO_BYTES, stream) != hipSuccess) return;
    Args a{};
    a.p.x = (const float*)d_in[0]; a.p.g_mix = (const float*)d_in[1]; a.p.w_in = (const float*)d_in[2]; a.p.g_q = (const float*)d_in[3]; a.p.w_uq = (const float*)d_in[4];
    a.p.g_kv = (const float*)d_in[5]; a.p.w_ukv = (const float*)d_in[6]; a.p.g_ret = (const float*)d_in[7]; a.p.w_out = (const float*)d_in[8]; a.p.g_mlp = (const float*)d_in[9];
    a.p.w_ff1 = (const float*)d_in[10]; a.p.w_ff2 = (const float*)d_in[11]; a.p.g_final = (const float*)d_in[12];
    a.p.out = (float*)d_out; a.p.ws = (unsigned char*)d_ws;
#if MK_N_LAUNCHES == 1
    a.ph_lo = 0; a.ph_hi = N_PHASES;
    hipLaunchKernelGGL(fwd, dim3(grid), dim3(NTHREADS), LDS_BYTES, stream, a);
#else
    for (int ph = 0; ph < N_PHASES; ++ph) { a.ph_lo = ph; a.ph_hi = ph + 1; hipLaunchKernelGGL(fwd, dim3(grid), dim3(NTHREADS), LDS_BYTES, stream, a); }
#endif
}
```

```cpp
#include <hip/hip_runtime.h>
#include <cstdio>
#include <cstdint>
namespace pg8 {
#define PG8_LAS __attribute__((address_space(3)))
typedef unsigned short bf16_t;
typedef short bf16x8 __attribute__((ext_vector_type(8)));
typedef float f32x4 __attribute__((ext_vector_type(4)));
typedef unsigned u32x4 __attribute__((ext_vector_type(4)));
constexpr int BM = 256, BK = 64, HALF = 128, HTB = HALF * BK * 2  , STAGE_BYTES = 8 * HTB, NXCD = 8, WGM = 8;

__host__ __device__ __forceinline__ int lds_byte(int r, int c) { const int st = (r >> 4) * 2 + (c >> 5), rr = r & 15, cc = c & 31, ob = rr * 64 + cc * 2; return st * 1024 + (ob ^ (((ob >> 9) & 1) << 5)); }
__host__ __device__ __forceinline__ void stage_rc(int b, int& R, int& C) { const int st = b / 1024, sb = b % 1024, swz = sb ^ (((sb >> 9) & 1) << 5); R = (st >> 1) * 16 + swz / 64; C = (st & 1) * 32 + (swz % 64) / 2; }
__host__ __device__ __forceinline__ int perm32(int rho) { const int n = rho >> 4, i = rho & 15; return 8 * (i >> 2) + 4 * n + (i & 3); }

struct Unit { int pm, pn; };
struct Gemm { const bf16_t* A; const bf16_t* Bt; int M, N, K; };

struct StaticOrder {
    int nM, nN, nwg, G, c;
    __host__ __device__ void init(int M, int N, int G_, int c_) { nM = M / BM; nN = N / BM; nwg = nM * nN; G = G_; c = c_; }
    __host__ __device__ bool next(int i, Unit& u) const {
        const long L = (long)i * G + c; if (L >= nwg) return false;
        int wgid = (int)L; { const int q = nwg / NXCD, r = nwg % NXCD, xcd = wgid % NXCD, off = wgid / NXCD; wgid = (xcd < r ? xcd * (q + 1) : r * (q + 1) + (xcd - r) * q) + off; }
        const int nig = WGM * nN, gid = wgid / nig, fm = gid * WGM, gsz = (nM - fm) < WGM ? (nM - fm) : WGM;
        u.pm = fm + ((wgid % nig) % gsz); u.pn = (wgid % nig) / gsz; return true;
    }
    __device__ __forceinline__ void a_ready(const Unit&) const {}
    __device__ __forceinline__ void done(const Unit&) const {}
};

__device__ __forceinline__ unsigned cvt_pk_bf16(float lo, float hi) { unsigned r; asm volatile("v_cvt_pk_bf16_f32 %0, %1, %2" : "=v"(r) : "v"(lo), "v"(hi)); return r; }
typedef float f32x2 __attribute__((ext_vector_type(2)));

template <class Epi, class Sched, bool ALIGN_EPI = false, bool SP2 = false>
__device__ __forceinline__ void gemm_phase(PG8_LAS unsigned char* lds, const Gemm g, const Sched& S, const Epi& E, const int wid_in) {
    int lane_l; asm volatile("v_mbcnt_lo_u32_b32 %0, -1, 0\n\tv_mbcnt_hi_u32_b32 %0, -1, %0" : "=v"(lane_l));
    int wid_l = wid_in; asm volatile("" : "+s"(wid_l));
    const int wid = wid_l, lane = lane_l, tid = wid * 64 + lane, wr = wid >> 2, wc = wid & 3, fr = lane & 15, fq = lane >> 4;
    const int K = g.K, nt = K / BK;
    unsigned voffA[2], voffB[2];
#pragma unroll
    for (int i = 0; i < 2; ++i) { int R, C; stage_rc(tid * 16 + i * 8192, R, C); const int Rb = Epi::PERM ? ((R & ~31) + perm32(R & 31)) : R;
        voffA[i] = (unsigned)(R * K + C) * 2u; voffB[i] = (unsigned)(Rb * K + C) * 2u; }
    const size_t kstep = (size_t)(BK * 2);
    const size_t hstep = (size_t)HALF * K * 2;
    const size_t tstep = 2 * hstep;
    const unsigned ldsw = (unsigned)wid * 1024u;
    const int aoff = lds_byte(wr * 64 + fr, fq * 8), boff = lds_byte(wc * 32 + fr, fq * 8);
#define PG8_SA(b, h) (((b) * 2 + (h)) * HTB)
#define PG8_SB(b, h) ((4 + (b) * 2 + (h)) * HTB)
#define PG8_STAGE(bufoff, gbase, voff) do { _Pragma("unroll") for (int _i = 0; _i < 2; ++_i) \
        __builtin_amdgcn_global_load_lds((const unsigned*)((const char*)(gbase) + (voff)[_i]), (PG8_LAS unsigned*)(lds + (bufoff) + ldsw + _i * 8192), 16, 0, 0); } while (0)
#define PG8_LDA(dst, b, h) do { _Pragma("unroll") for (int m = 0; m < 4; ++m) _Pragma("unroll") for (int k = 0; k < 2; ++k) dst[m][k] = *(const PG8_LAS bf16x8*)(lds + PG8_SA(b, h) + aoff + m * 2048 + k * 1024); } while (0)
#define PG8_LDB(dst, b, h) do { _Pragma("unroll") for (int n = 0; n < 2; ++n) _Pragma("unroll") for (int k = 0; k < 2; ++k) dst[n][k] = *(const PG8_LAS bf16x8*)(lds + PG8_SB(b, h) + boff + n * 2048 + k * 1024); } while (0)
#define PG8_MMA(ai, bj, At, Bt) do { __builtin_amdgcn_s_setprio(1); _Pragma("unroll") for (int m = 0; m < 4; ++m) _Pragma("unroll") for (int n = 0; n < 2; ++n) _Pragma("unroll") for (int k = 0; k < 2; ++k) \
        acc[ai][bj][m][n] = __builtin_amdgcn_mfma_f32_16x16x32_bf16(Bt[n][k], At[m][k], acc[ai][bj][m][n], 0, 0, 0); __builtin_amdgcn_s_setprio(0); } while (0)
#define PG8_WAIT_V(n) asm volatile("s_waitcnt vmcnt(" #n ")" ::: "memory")
#define PG8_WAIT_L(n) asm volatile("s_waitcnt lgkmcnt(" #n ")" ::: "memory")
#define PG8_BAR __builtin_amdgcn_s_barrier()
#define PG8_SCHED __builtin_amdgcn_sched_barrier(0)
    Unit cur, nxt; int ui = 0;
    if (!S.next(0, cur)) return;
    f32x4 acc[2][2][4][2];
#pragma unroll
    for (int a = 0; a < 2; ++a)
#pragma unroll
        for (int b = 0; b < 2; ++b)
#pragma unroll
            for (int m = 0; m < 4; ++m)
#pragma unroll
                for (int n = 0; n < 2; ++n) acc[a][b][m][n] = (f32x4){0.f, 0.f, 0.f, 0.f};
    bf16x8 At[4][2], B0[2][2], B1[2][2];
    const char* cA = (const char*)g.A + (size_t)cur.pm * tstep; const char* cB = (const char*)g.Bt + (size_t)cur.pn * tstep;
    S.a_ready(cur);
    if constexpr (SP2) {
        PG8_STAGE(PG8_SB(0, 0), cB, voffB); PG8_STAGE(PG8_SB(0, 1), cB + hstep, voffB); PG8_STAGE(PG8_SA(0, 0), cA, voffA); PG8_STAGE(PG8_SA(0, 1), cA + hstep, voffA);
        if (wr == 1) PG8_BAR;
        PG8_WAIT_V(2); PG8_BAR;
        PG8_STAGE(PG8_SB(1, 0), cB + kstep, voffB); PG8_STAGE(PG8_SA(1, 0), cA + kstep, voffA); PG8_STAGE(PG8_SB(1, 1), cB + hstep + kstep, voffB);
        PG8_WAIT_V(6); PG8_BAR;
    } else {
        PG8_STAGE(PG8_SB(0, 0), cB, voffB); PG8_STAGE(PG8_SA(0, 0), cA, voffA); PG8_STAGE(PG8_SB(0, 1), cB + hstep, voffB); PG8_STAGE(PG8_SA(0, 1), cA + hstep, voffA);
        if (wr == 1) PG8_BAR;
        PG8_WAIT_V(4); PG8_BAR;
        PG8_STAGE(PG8_SB(1, 0), cB + kstep, voffB); PG8_STAGE(PG8_SA(1, 0), cA + kstep, voffA); PG8_STAGE(PG8_SB(1, 1), cB + hstep + kstep, voffB);
        PG8_WAIT_V(6); PG8_BAR;
    }
    for (;;) {
        const bool has_next = S.next(ui + 1, nxt);
        const char* nA = has_next ? (const char*)g.A + (size_t)nxt.pm * tstep : cA; const char* nB = has_next ? (const char*)g.Bt + (size_t)nxt.pn * tstep : cB;
        for (int t = 0; t < nt; t += 2) {
            const bool last = (t == nt - 2);
            const char* a1 = cA + (size_t)(t + 1) * kstep;
            const char* a2 = last ? nA : cA + (size_t)(t + 2) * kstep; const char* b2 = last ? nB : cB + (size_t)(t + 2) * kstep;
            const char* a3 = a2 + kstep; const char* b3 = b2 + kstep;
            if (last && has_next) S.a_ready(nxt);
            if (last) E.stage_aux(cur, lds, wid, lane);
            if constexpr (SP2) {
            PG8_LDB(B0, 0, 0); PG8_LDB(B1, 0, 1); PG8_SCHED; PG8_LDA(At, 0, 0); PG8_STAGE(PG8_SA(1, 1), a1 + hstep, voffA);
            PG8_WAIT_V(8); PG8_WAIT_L(0); PG8_BAR; PG8_MMA(0, 0, At, B0); PG8_MMA(0, 1, At, B1); PG8_BAR; PG8_SCHED;
            PG8_LDA(At, 0, 1); PG8_STAGE(PG8_SB(0, 0), b2, voffB); PG8_STAGE(PG8_SB(0, 1), b2 + hstep, voffB); PG8_STAGE(PG8_SA(0, 0), a2, voffA);
            PG8_WAIT_V(8); PG8_WAIT_L(0); PG8_BAR; PG8_MMA(1, 0, At, B0); PG8_MMA(1, 1, At, B1); PG8_BAR; PG8_SCHED;
            PG8_LDB(B0, 1, 0); PG8_LDB(B1, 1, 1); PG8_SCHED; PG8_LDA(At, 1, 0); PG8_STAGE(PG8_SA(0, 1), a2 + hstep, voffA);
            PG8_WAIT_V(8); PG8_WAIT_L(0); PG8_BAR; PG8_MMA(0, 0, At, B0); PG8_MMA(0, 1, At, B1); PG8_BAR; PG8_SCHED;
            PG8_LDA(At, 1, 1); PG8_STAGE(PG8_SB(1, 0), b3, voffB); PG8_STAGE(PG8_SB(1, 1), b3 + hstep, voffB); PG8_STAGE(PG8_SA(1, 0), a3, voffA);
            PG8_WAIT_V(8); PG8_WAIT_L(0); PG8_BAR; PG8_MMA(1, 0, At, B0); PG8_MMA(1, 1, At, B1); PG8_BAR; PG8_SCHED;
            } else {
            PG8_LDB(B0, 0, 0); PG8_SCHED; PG8_LDA(At, 0, 0); PG8_STAGE(PG8_SA(1, 1), a1 + hstep, voffA);
            PG8_WAIT_L(8); PG8_BAR; PG8_WAIT_L(0); PG8_MMA(0, 0, At, B0); PG8_BAR; PG8_SCHED;
            PG8_LDB(B1, 0, 1); PG8_STAGE(PG8_SB(0, 0), b2, voffB);
            PG8_BAR; PG8_WAIT_L(0); PG8_MMA(0, 1, At, B1); PG8_BAR;
            PG8_LDA(At, 0, 1); PG8_STAGE(PG8_SA(0, 0), a2, voffA);
            PG8_BAR; PG8_WAIT_L(0); PG8_MMA(1, 0, At, B0); PG8_BAR; PG8_SCHED;
            PG8_STAGE(PG8_SB(0, 1), b2 + hstep, voffB);
            PG8_WAIT_V(6); PG8_BAR; PG8_MMA(1, 1, At, B1); PG8_BAR;
            PG8_LDB(B0, 1, 0); PG8_SCHED; PG8_LDA(At, 1, 0); PG8_STAGE(PG8_SA(0, 1), a2 + hstep, voffA);
            PG8_WAIT_L(8); PG8_BAR; PG8_WAIT_L(0); PG8_MMA(0, 0, At, B0); PG8_BAR; PG8_SCHED;
            PG8_LDB(B1, 1, 1); PG8_STAGE(PG8_SB(1, 0), b3, voffB);
            PG8_BAR; PG8_WAIT_L(0); PG8_MMA(0, 1, At, B1); PG8_BAR;
            PG8_LDA(At, 1, 1); PG8_STAGE(PG8_SA(1, 0), a3, voffA);
            PG8_BAR; PG8_WAIT_L(0); PG8_MMA(1, 0, At, B0); PG8_BAR; PG8_SCHED;
            PG8_STAGE(PG8_SB(1, 1), b3 + hstep, voffB);
            PG8_WAIT_V(6); PG8_BAR; PG8_MMA(1, 1, At, B1); PG8_BAR;
            }
        }
        if constexpr (ALIGN_EPI) { if (wr == 0) PG8_BAR; }
        if constexpr (!Epi::AFTER_DRAIN) { E(acc, cur, wr, wc, fr, fq); S.done(cur); }
        if (!has_next) break;
#pragma unroll
        for (int a = 0; a < 2; ++a)
#pragma unroll
            for (int b = 0; b < 2; ++b)
#pragma unroll
                for (int m = 0; m < 4; ++m)
#pragma unroll
                    for (int n = 0; n < 2; ++n) acc[a][b][m][n] = (f32x4){0.f, 0.f, 0.f, 0.f};
        cur = nxt; cA = nA; cB = nB; ++ui;
        if constexpr (ALIGN_EPI) { if (wr == 1) PG8_BAR; }
    }
    PG8_WAIT_V(0);
    if constexpr (!ALIGN_EPI) { if (wr == 0) PG8_BAR; }
    PG8_BAR;
    if constexpr (Epi::AFTER_DRAIN) { E.fused(acc, cur, wr, wc, fr, fq, lds, wid, lane); S.done(cur); }
#undef PG8_SA
#undef PG8_SB
#undef PG8_STAGE
#undef PG8_LDA
#undef PG8_LDB
#undef PG8_MMA
#undef PG8_WAIT_V
#undef PG8_WAIT_L
#undef PG8_BAR
#undef PG8_SCHED
}
}

#ifndef MK_N_LAUNCHES
#define MK_N_LAUNCHES 1
#endif
#ifndef PROBE_REP
#define PROBE_REP 0
#endif
#define REP(bit) for (int rep_ = 0; rep_ < ((PROBE_REP >> (bit)) & 1) + 1; ++rep_)
#ifndef PROBE_KL
#define PROBE_KL 0
#endif
#ifndef SEL_NB
#define SEL_NB 13
#endif
#ifndef ATT_FUSE_SM
#define ATT_FUSE_SM 2
#endif
#ifndef ATT_SPLIT
#define ATT_SPLIT 1
#endif
#ifndef ATT_NQR
#define ATT_NQR 2
#endif
#ifndef EPI_LDS_AUX
#define EPI_LDS_AUX 1
#endif
#ifndef RES_BATCH
#define RES_BATCH 4
#endif
#ifndef MK_NAIVE_GEMM
#define MK_NAIVE_GEMM 0
#endif

namespace mk {
#define GAS __attribute__((address_space(1)))
#define LAS __attribute__((address_space(3)))
typedef unsigned short bf16;
typedef float f32x4 __attribute__((ext_vector_type(4)));
typedef float f32x2 __attribute__((ext_vector_type(2)));
typedef unsigned u32x4 __attribute__((ext_vector_type(4)));
typedef unsigned u32x2 __attribute__((ext_vector_type(2)));
typedef __bf16 bf16x2_t __attribute__((ext_vector_type(2)));
typedef unsigned long long u64;

constexpr int BATCH = 32, SEQ = 2048, DM = 1024, DEPTH = 2, M = BATCH * SEQ, FF = 4096;
constexpr int NIN = 2816;
constexpr int IN_W = 2760;
constexpr float EPS = 1e-6f;
constexpr float LOG2E = 1.4426950408889634f;
constexpr int NWAVES = 8, NTHREADS = 512;

constexpr size_t MiB = 1u << 20;
constexpr size_t WS_CTL = 0, CTL_ZERO_BYTES = 1 * MiB;
constexpr size_t W_IN_B = (size_t)NIN * DM * 2, W_UQ_B = 768 * 768 * 2, W_UKV_B = 1024 * 256 * 2, W_OUT_B = 1024 * 1024 * 2, W_F1_B = (size_t)FF * DM * 2, W_F2_B = (size_t)DM * FF * 2;
constexpr size_t WL_IN = 0, WL_UQ = WL_IN + W_IN_B, WL_UKV = WL_UQ + W_UQ_B, WL_OUT = WL_UKV + W_UKV_B, WL_F1 = WL_OUT + W_OUT_B, WL_F2 = WL_F1 + W_F1_B, WL_BYTES = WL_F2 + W_F2_B;
constexpr size_t WS_W = 1 * MiB;
constexpr size_t WS_SSQX = 55 * MiB, WS_SSQL = 59 * MiB;
constexpr size_t WS_WI = 63 * MiB;
constexpr size_t WS_SSQ2 = 66 * MiB;
constexpr size_t WS_XB = 70 * MiB;
constexpr size_t WS_BIG = 198 * MiB;
constexpr size_t WS_CQ = WS_BIG, WS_CKV = WS_CQ + 96 * MiB, WS_AQ = WS_CKV + 32 * MiB, WS_RQ = WS_AQ + 32 * MiB, WS_RK = WS_RQ + 32 * MiB, WS_QI = WS_RK + 32 * MiB,
                 WS_MS = WS_QI + 32 * MiB, WS_RV = WS_MS + 32 * MiB, WS_RG = WS_RV + 32 * MiB, WS_Q = WS_RG + 32 * MiB, WS_KN = WS_Q + 96 * MiB, WS_V = WS_KN + 64 * MiB,
                 WS_BM = WS_V + 64 * MiB, WS_O = WS_BM + 16 * MiB, WS_END = WS_O + 128 * MiB;
constexpr size_t WS_H = WS_BIG;
static_assert(WS_W + 2 * WL_BYTES <= WS_SSQX && WS_END <= 1024 * MiB && WS_H + 512 * MiB <= 1024 * MiB, "d_ws map");
constexpr int CW_BAR = 4096;

constexpr int RING_BYTES = 131072, MISC_OFF = RING_BYTES + 320, LDS_BYTES = 147456;

__device__ __forceinline__ unsigned cvtpk(float lo, float hi) { f32x2 v = {lo, hi}; bf16x2_t b = __builtin_convertvector(v, bf16x2_t); return __builtin_bit_cast(unsigned, b); }
__device__ __forceinline__ float bf_lo(unsigned u) { return __uint_as_float(u << 16); }
__device__ __forceinline__ float bf_hi(unsigned u) { return __uint_as_float(u & 0xffff0000u); }
__device__ __forceinline__ void unpack8(const u32x4 r, float* f) { f[0] = bf_lo(r.x); f[1] = bf_hi(r.x); f[2] = bf_lo(r.y); f[3] = bf_hi(r.y); f[4] = bf_lo(r.z); f[5] = bf_hi(r.z); f[6] = bf_lo(r.w); f[7] = bf_hi(r.w); }
__device__ __forceinline__ void st8(bf16* dst, const float* v) { u32x4 w; w.x = cvtpk(v[0], v[1]); w.y = cvtpk(v[2], v[3]); w.z = cvtpk(v[4], v[5]); w.w = cvtpk(v[6], v[7]); *(u32x4*)dst = w; }
__device__ __forceinline__ void st8nt(bf16* dst, const float* v) { u32x4 w; w.x = cvtpk(v[0], v[1]); w.y = cvtpk(v[2], v[3]); w.z = cvtpk(v[4], v[5]); w.w = cvtpk(v[6], v[7]); __builtin_nontemporal_store(w, (u32x4*)dst); }
__device__ __forceinline__ void st8f(float* dst, const float* v) { *(f32x4*)dst = (f32x4){v[0], v[1], v[2], v[3]}; *(f32x4*)(dst + 4) = (f32x4){v[4], v[5], v[6], v[7]}; }
__device__ __forceinline__ float sum16(const float* p) { const f32x4 a = *(const f32x4*)p, b = *(const f32x4*)(p + 4), c = *(const f32x4*)(p + 8), d = *(const f32x4*)(p + 12);
    return (((a.x + a.y) + (a.z + a.w)) + ((b.x + b.y) + (b.z + b.w))) + (((c.x + c.y) + (c.z + c.w)) + ((d.x + d.y) + (d.z + d.w))); }
__device__ __forceinline__ float wave_sum(float v) {
#pragma unroll
    for (int o = 1; o < 64; o <<= 1) v += __shfl_xor(v, o);
    return v; }
__device__ __forceinline__ float wave_max(float v) {
#pragma unroll
    for (int o = 1; o < 64; o <<= 1) v = fmaxf(v, __shfl_xor(v, o));
    return v; }
__device__ __forceinline__ float wave_min(float v) {
#pragma unroll
    for (int o = 1; o < 64; o <<= 1) v = fminf(v, __shfl_xor(v, o));
    return v; }

__device__ __forceinline__ float xhalf_sum(float a) { const auto rr = __builtin_amdgcn_permlane32_swap(__float_as_uint(a), __float_as_uint(a), false, false); return __uint_as_float(rr[0]) + __uint_as_float(rr[1]); }
__device__ __forceinline__ float xrow16_sum(float x) { const auto s_ = __builtin_amdgcn_permlane16_swap(__float_as_uint(x), __float_as_uint(x), false, false); x = __uint_as_float(s_[0]) + __uint_as_float(s_[1]);
    const auto t_ = __builtin_amdgcn_permlane32_swap(__float_as_uint(x), __float_as_uint(x), false, false); return __uint_as_float(t_[0]) + __uint_as_float(t_[1]); }
__device__ __forceinline__ float xhalf_max(float a) { const auto rr = __builtin_amdgcn_permlane32_swap(__float_as_uint(a), __float_as_uint(a), false, false); return fmaxf(__uint_as_float(rr[0]), __uint_as_float(rr[1])); }
#define DPP_I(x, ctrl) __builtin_amdgcn_update_dpp(0, (x), (ctrl), 0xf, 0xf, false)
__device__ __forceinline__ int wave_sum_i(int x) {
    x += DPP_I(x, 0xB1); x += DPP_I(x, 0x4E); x += DPP_I(x, 0x141); x += DPP_I(x, 0x140);
    return __builtin_amdgcn_readlane(x, 0) + __builtin_amdgcn_readlane(x, 16) + __builtin_amdgcn_readlane(x, 32) + __builtin_amdgcn_readlane(x, 48); }
__device__ __forceinline__ float wave_max_f(float x) {
    x = fmaxf(x, __int_as_float(DPP_I(__float_as_int(x), 0xB1))); x = fmaxf(x, __int_as_float(DPP_I(__float_as_int(x), 0x4E))); x = fmaxf(x, __int_as_float(DPP_I(__float_as_int(x), 0x141))); x = fmaxf(x, __int_as_float(DPP_I(__float_as_int(x), 0x140)));
    const int xi = __float_as_int(x);
    return fmaxf(fmaxf(__int_as_float(__builtin_amdgcn_readlane(xi, 0)), __int_as_float(__builtin_amdgcn_readlane(xi, 16))), fmaxf(__int_as_float(__builtin_amdgcn_readlane(xi, 32)), __int_as_float(__builtin_amdgcn_readlane(xi, 48)))); }
__device__ __forceinline__ float wave_min_f(float x) { return -wave_max_f(-x); }
#define LDS_WAIT() asm volatile("s_waitcnt lgkmcnt(0)" ::: "memory")
__device__ __forceinline__ int lane_here() { int t; asm volatile("v_mbcnt_lo_u32_b32 %0, -1, 0\n\tv_mbcnt_hi_u32_b32 %0, -1, %0" : "=v"(t)); return t; }
#define tid_here() (wave_id * 64 + lane_here())

#define XB_TMO      128
#define XB_XCNT(j)  (256  + 64 * (j))
#define XB_XSUB(j)  (1280 + 64 * (j))
#define XB_XGEN(j)  (2304 + 64 * (j))
#define XB_TOP      3328
#define XB_TOPGEN   3392
#define XCD_BAR_WORDS 3456
#define XB_SPIN_CAP (1u << 24)
__device__ __forceinline__ unsigned xb_ld(unsigned* p)              { return __hip_atomic_load(p, __ATOMIC_RELAXED, __HIP_MEMORY_SCOPE_AGENT); }
__device__ __forceinline__ unsigned xb_add(unsigned* p, unsigned v) { return __hip_atomic_fetch_add(p, v, __ATOMIC_RELAXED, __HIP_MEMORY_SCOPE_AGENT); }
__device__ __forceinline__ unsigned xb_xcc_id() { return (unsigned)__builtin_amdgcn_s_getreg((3 << 11) | 20) & 0xFu; }
#define XB_SPIN(cond, bar) do { unsigned _sp = 0; while (cond) { __builtin_amdgcn_s_sleep(1); \
    if ((++_sp & 255u) == 0u) { if (xb_ld(&(bar)[XB_TMO])) break; if (_sp > XB_SPIN_CAP) { atomicAdd(&(bar)[XB_TMO], 1u); break; } } } } while (0)
struct XcdBarrier { unsigned* bar; unsigned x; volatile LAS unsigned* st; };
__device__ __forceinline__ XcdBarrier xcd_barrier_post(unsigned* bar, volatile LAS unsigned* st) {
    XcdBarrier b; b.bar = bar; b.x = xb_xcc_id(); b.st = st;
    if (threadIdx.x == 0) (void)xb_add(&bar[XB_XCNT(b.x)], 1u);
    return b;
}
__device__ __forceinline__ void xcd_barrier_complete(unsigned* bar, unsigned x, unsigned& nloc, unsigned& nx) {
    const unsigned G = gridDim.x * gridDim.y * gridDim.z;
    unsigned sum, cnt, mine, sp = 0u;
    for (;;) {
        sum = 0u; cnt = 0u; mine = 0u;
#pragma unroll
        for (unsigned j = 0; j < 16; ++j) { const unsigned c = xb_ld(&bar[XB_XCNT(j)]); sum += c; cnt += (c > 0u) ? 1u : 0u; mine = (j == x) ? c : mine; }
        if (sum == G) break;
        __builtin_amdgcn_s_sleep(1);
        if ((++sp & 255u) == 0u) { if (xb_ld(&bar[XB_TMO])) break; if (sp > XB_SPIN_CAP) { atomicAdd(&bar[XB_TMO], 1u); break; } }
    }
    nloc = mine > 0u ? mine : 1u; nx = cnt > 0u ? cnt : 1u;
}
__device__ __forceinline__ void xcd_barrier(const XcdBarrier& b) {
    asm volatile("s_waitcnt vmcnt(0)" ::: "memory");
    __syncthreads();
    if (threadIdx.x == 0) {
        size_t zo_ = 0; asm volatile("" : "+s"(zo_)); unsigned* bar = b.bar + zo_;
        __builtin_amdgcn_s_waitcnt(0);
        unsigned nloc = b.st[0], nx = b.st[1];
        if (nloc == 0u) { xcd_barrier_complete(bar, b.x, nloc, nx); b.st[0] = nloc; b.st[1] = nx; }
        const unsigned old = xb_add(&bar[XB_XSUB(b.x)], 1u);
        const unsigned gen = old / nloc;
        if (old + 1u == (gen + 1u) * nloc) {
            __builtin_amdgcn_fence(__ATOMIC_RELEASE, "agent");
            asm volatile("s_waitcnt vmcnt(0)" ::: "memory");
            const unsigned og = xb_add(&bar[XB_TOP], 1u);
            const unsigned tg = og / nx;
            if (og + 1u == (tg + 1u) * nx) xb_add(&bar[XB_TOPGEN], 1u);
            else XB_SPIN(xb_ld(&bar[XB_TOPGEN]) == tg, bar);
            __builtin_amdgcn_fence(__ATOMIC_ACQUIRE, "agent");
            xb_add(&bar[XB_XGEN(b.x)], 1u);
            asm volatile("s_waitcnt vmcnt(0)" ::: "memory");
        } else {
            XB_SPIN(xb_ld(&bar[XB_XGEN(b.x)]) == gen, bar);
            __builtin_amdgcn_fence(__ATOMIC_ACQUIRE, "agent");
            asm volatile("s_waitcnt vmcnt(0)" ::: "memory");
        }
    }
    __syncthreads();
}

struct SrcIn { __device__ __forceinline__ int operator()(int n) const {
    if (n < 1024) return n;
    const int t = (n - 1024) >> 8, c = (n - 1024) & 255, half = c >> 7, p = c & 127;
    if (t == 0) return 1056 + (p >> 5) * 64 + half * 32 + (p & 31);
    if (t == 1) return 1736 + (p >> 5) * 64 + half * 32 + (p & 31);
    if (t == 2) return 1992 + (p >> 5) * 64 + half * 32 + (p & 31);
    if (t == 3) return 1440 + (p >> 4) * 32 + half * 16 + (p & 15);
    if (t == 4) {
        if (p < 32) return 1312 + half * 32 + p;
        if (p < 48) return 1024 + half * 16 + (p - 32);
        if (p < 64) return 1696 + half * 16 + (p - 48);
        if (half == 0) return 1376 + (p - 64);
        return (p - 64 < 8) ? 1728 + (p - 64) : -1;
    }
    if (t == 5) return 2248 + c;
    return 2504 + c; } };
struct SrcUq { __device__ __forceinline__ int operator()(int n) const {
    if (n < 512) return (n >> 6) * 96 + (n & 63);
    const int c = n - 512, half = c >> 7, p = c & 127; return (p >> 4) * 96 + 64 + half * 16 + (p & 15); } };
struct SrcUkv { __device__ __forceinline__ int operator()(int n) const {
    if (n < 512) return (n >> 6) * 128 + (n & 63);
    const int c = n - 512; return (c >> 6) * 128 + 64 + (c & 63); } };
struct SrcId { __device__ __forceinline__ int operator()(int n) const { return n; } };

template <class SrcF>
__device__ __forceinline__ void transpose_item(const float* W, int K, int Nsrc, int Ndst, const float* gain, bf16* WT, LAS float* scr, int item, int lane, SrcF srcf) {
    const int nblk = Ndst / 32, kb = item / nblk, nb = item % nblk, k0 = 64 * kb, n0 = 32 * nb;
    const int sc = srcf(n0 + (lane & 31));
#pragma unroll 8
    for (int i = 0; i < 32; ++i) { const int kk = 2 * i + (lane >> 5); float v = 0.f; if (sc >= 0) v = W[(size_t)(k0 + kk) * Nsrc + sc]; if (gain) v *= gain[k0 + kk]; scr[kk * 33 + (lane & 31)] = v; }
    LDS_WAIT(); asm volatile("" ::: "memory");
    const int c = lane & 7;
#pragma unroll
    for (int j = 0; j < 4; ++j) { const int n = (lane >> 3) + 8 * j; const LAS float* s = scr + (8 * c) * 33 + n;
        u32x4 o; o.x = cvtpk(s[0 * 33], s[1 * 33]); o.y = cvtpk(s[2 * 33], s[3 * 33]); o.z = cvtpk(s[4 * 33], s[5 * 33]); o.w = cvtpk(s[6 * 33], s[7 * 33]);
        *(u32x4*)(WT + (size_t)(n0 + n) * K + k0 + 8 * c) = o; }
    LDS_WAIT(); asm volatile("" ::: "memory");
}

struct Ptrs {
    const float *x, *g_mix, *w_in, *g_q, *w_uq, *g_kv, *w_ukv, *g_ret, *w_out, *g_mlp, *w_ff1, *w_ff2, *g_final;
    float* out; unsigned char* ws;
};
struct Args { Ptrs p; int ph_lo, ph_hi; };
static_assert(sizeof(Args) == 15 * 8 + 8, "Args has no padding");

constexpr int AUX_LDS_OFF = RING_BYTES + 6144;
template <class F> struct EpiT {
    static constexpr bool PERM = true, AFTER_DRAIN = false;
    F f;
    __device__ __forceinline__ void stage_aux(const pg8::Unit& u, PG8_LAS unsigned char* lds, int wid, int lane) const {
        if constexpr (F::LDS_AUX) { unsigned lo = (unsigned)(wid * 1024 + lane * 16); asm volatile("" : "+v"(lo));
            const char* src = (const char*)f.aux_base() + (size_t)u.pm * (256 * 64) + lo;
            __builtin_amdgcn_global_load_lds((const unsigned*)src, (PG8_LAS unsigned*)(lds + AUX_LDS_OFF + wid * 1024), 16, 0, 0); }
    }
    template <int R0, int NRW>
    __device__ __forceinline__ void apply_rows(const pg8::f32x4 (&acc)[2][2][4][2], const pg8::Unit& u, int row0, int wc, int fq, const typename F::Ctx& ctx, const typename F::AuxT* ax) const {
#pragma unroll
        for (int i = 0; i < NRW; ++i) {
            const int it = R0 + i, ai = it >> 2, m = it & 3, row = row0 + ai * 128 + m * 16;
            float x1[8], x2[8];
#pragma unroll
            for (int j = 0; j < 4; ++j) { x1[j] = acc[ai][0][m][0][j]; x1[4 + j] = acc[ai][0][m][1][j]; x2[j] = acc[ai][1][m][0][j]; x2[4 + j] = acc[ai][1][m][1][j]; }
            f.apply(ctx, ax[i], row, u.pn, wc, fq, x1, x2);
            asm volatile("" ::: "memory");
        }
    }
    template <int R0, int NRW>
    __device__ __forceinline__ void rows(const pg8::f32x4 (&acc)[2][2][4][2], const pg8::Unit& u, int row0, int wc, int fq, const typename F::Ctx& ctx) const {
        typename F::AuxT ax[NRW];
#pragma unroll
        for (int i = 0; i < NRW; ++i) ax[i] = f.load(row0 + ((R0 + i) >> 2) * 128 + ((R0 + i) & 3) * 16, u.pn, wc, fq);
        asm volatile("" ::: "memory");
        apply_rows<R0, NRW>(acc, u, row0, wc, fq, ctx, ax);
    }
    __device__ __forceinline__ void operator()(const pg8::f32x4 (&acc)[2][2][4][2], const pg8::Unit& u, int wr, int wc, int fr, int fq) const {
        { const int ln = lane_here(); fr = ln & 15; fq = ln >> 4; }
        const int row0 = u.pm * 256 + wr * 64 + fr;
        const typename F::Ctx ctx = f.begin(u.pn, wc, fq);
        if constexpr (F::LDS_AUX) {
            typename F::AuxT hi4[4], lo4[4];
#pragma unroll
            for (int i = 0; i < 4; ++i) hi4[i] = f.load(row0 + 128 + i * 16, u.pn, wc, fq);
            asm volatile("" ::: "memory");
#pragma unroll
            for (int i = 0; i < 4; ++i) lo4[i] = f.from_lds((LAS const unsigned char*)(AUX_LDS_OFF + (wr * 64 + i * 16 + fr) * 64), fq);
            apply_rows<0, 4>(acc, u, row0, wc, fq, ctx, lo4);
            apply_rows<4, 4>(acc, u, row0, wc, fq, ctx, hi4);
        } else {
            if constexpr (F::BATCH == 8) rows<0, 8>(acc, u, row0, wc, fq, ctx);
            else { rows<0, 4>(acc, u, row0, wc, fq, ctx); rows<4, 4>(acc, u, row0, wc, fq, ctx); }
        }
    }
};
__device__ __forceinline__ f32x4 part4(const float* p, int fq, int n4) { f32x4 a = {0.f, 0.f, 0.f, 0.f}; if (fq < n4) a = *(const f32x4*)(p + 4 * fq); return a; }
__device__ __forceinline__ float red4(const f32x4 a) { return xrow16_sum((a.x + a.y) + (a.z + a.w)); }
__device__ __forceinline__ float ssq16(const float* x1, const float* x2) { float s = 0.f;
#pragma unroll
    for (int j = 0; j < 8; ++j) s += x1[j] * x1[j] + x2[j] * x2[j];
    return xrow16_sum(s); }
struct RopeCtx { float inv[8]; };
__device__ __forceinline__ RopeCtx rope_ctx(int f0, bool dim64) { RopeCtx c; const float step = dim64 ? 0.41524101186092029f : 0.83048202372184058f;
#pragma unroll
    for (int j = 0; j < 8; ++j) c.inv[j] = __builtin_amdgcn_exp2f(-(float)(f0 + j) * step) * 0.15915494309189535f;
    return c; }
__device__ __forceinline__ void rope8(float* x1, float* x2, const RopeCtx& c, int pos) {
    const float pf = (float)pos;
#pragma unroll
    for (int j = 0; j < 8; ++j) { const float rev = __builtin_amdgcn_fractf(pf * c.inv[j]); const float cs = __builtin_amdgcn_cosf(rev), sn = __builtin_amdgcn_sinf(rev);
        const float a = x1[j], b = x2[j]; x1[j] = a * cs - b * sn; x2[j] = a * sn + b * cs; }
}

struct FIn {
    typedef f32x4 AuxT; typedef RopeCtx Ctx; static constexpr int BATCH = 8; static constexpr bool LDS_AUX = (EPI_LDS_AUX != 0);
    unsigned char* ws;
    __device__ __forceinline__ const float* aux_base() const { return (const float*)(ws + WS_SSQX); }
    __device__ __forceinline__ AuxT from_lds(LAS const unsigned char* rowp, int fq) const { return *(LAS const f32x4*)(rowp + fq * 16); }
    __device__ __forceinline__ Ctx begin(int pn, int wc, int fq) const { const int p = wc * 32 + fq * 8; const bool d64 = (pn >= 4 && pn <= 6) || (pn == 8 && wc == 0); return rope_ctx(d64 ? (p & 31) : (p & 15), d64); }
    __device__ __forceinline__ AuxT load(int row, int, int, int fq) const { return part4((const float*)(ws + WS_SSQX) + (size_t)row * 16, fq, 4); }
    __device__ __forceinline__ void apply(const Ctx& ctx, const AuxT& ax, int row, int pn, int wc, int fq, float* x1, float* x2) const {
        float* ssql = (float*)(ws + WS_SSQL);
        const float rs = __builtin_amdgcn_rsqf(red4(ax) * (1.0f / DM) + EPS);
#pragma unroll
        for (int j = 0; j < 8; ++j) { x1[j] *= rs; x2[j] *= rs; }
        const int p = wc * 32 + fq * 8, pos = row & (SEQ - 1);
        if (pn < 3) { bf16* d = (bf16*)(ws + WS_CQ) + (size_t)row * 768 + pn * 256 + p; st8(d, x1); st8(d + 128, x2); const float s = ssq16(x1, x2); if (fq == 0) ssql[(size_t)row * 16 + pn * 4 + wc] = s; }
        else if (pn == 3) { bf16* d = (bf16*)(ws + WS_CKV) + (size_t)row * 256 + p; st8(d, x1); st8(d + 128, x2); const float s = ssq16(x1, x2); if (fq == 0) ssql[(size_t)row * 16 + 12 + wc] = s; }
        else if (pn <= 6) { rope8(x1, x2, ctx, pos);
            const float sc_ = (pn == 4) ? 0.125f * LOG2E : (pn == 5) ? 1.0f : 0.125f;
#pragma unroll
            for (int j = 0; j < 8; ++j) { x1[j] *= sc_; x2[j] *= sc_; }
            bf16* d = (bf16*)(ws + WS_AQ + (size_t)(pn - 4) * (32 * MiB)) + (size_t)row * 256 + (p >> 5) * 64 + (p & 31); st8(d, x1); st8(d + 32, x2); }
        else if (pn == 7) { rope8(x1, x2, ctx, pos); bf16* d = (bf16*)(ws + WS_QI) + (size_t)row * 256 + (p >> 4) * 32 + (p & 15); st8(d, x1); st8(d + 16, x2); }
        else if (pn == 8) { bf16* d = (bf16*)(ws + WS_MS) + (size_t)row * 256;
            if (wc == 0) { rope8(x1, x2, ctx, pos); st8(d + p, x1); st8(d + 32 + p, x2); }
            else if (wc == 1) { const int i = (p - 32) & 15, o = (p < 48) ? 64 : 96; rope8(x1, x2, ctx, pos); st8(d + o + i, x1); st8(d + o + 16 + i, x2); }
            else { st8(d + 128 + (p - 64), x1); if (p == 64) { float w[8];
#pragma unroll
                    for (int j = 0; j < 8; ++j) w[j] = x2[j] * 0.0625f;
                    st8f((float*)(ws + WS_WI) + (size_t)row * 8, w); } } }
        else { bf16* d = (bf16*)(ws + WS_RV + (size_t)(pn - 9) * (32 * MiB)) + (size_t)row * 256 + p; st8(d, x1); st8(d + 128, x2); }
    }
};
static_assert(WS_V == WS_KN + 64 * MiB && WS_RQ == WS_AQ + 32 * MiB && WS_RK == WS_AQ + 64 * MiB && WS_RG == WS_RV + 32 * MiB, "FIn / FUkv compute these destinations by arithmetic");
struct FUq {
    typedef f32x4 AuxT; typedef RopeCtx Ctx; static constexpr int BATCH = 8; static constexpr bool LDS_AUX = (EPI_LDS_AUX != 0);
    const float* ssql; bf16* q;
    __device__ __forceinline__ const float* aux_base() const { return ssql; }
    __device__ __forceinline__ AuxT from_lds(LAS const unsigned char* rowp, int fq) const { f32x4 a = {0.f, 0.f, 0.f, 0.f}; if (fq < 3) a = *(LAS const f32x4*)(rowp + fq * 16); return a; }
    __device__ __forceinline__ Ctx begin(int, int wc, int fq) const { return rope_ctx((wc * 32 + fq * 8) & 15, false); }
    __device__ __forceinline__ AuxT load(int row, int, int, int fq) const { return part4(ssql + (size_t)row * 16, fq, 3); }
    __device__ __forceinline__ void apply(const Ctx& ctx, const AuxT& ax, int row, int pn, int wc, int fq, float* x1, float* x2) const {
        const float rs = __builtin_amdgcn_rsqf(red4(ax) * (1.0f / 768.0f) + EPS) * (0.10206207261596577f * LOG2E);
#pragma unroll
        for (int j = 0; j < 8; ++j) { x1[j] *= rs; x2[j] *= rs; }
        const int p = wc * 32 + fq * 8;
        if (pn < 2) { const int c1 = pn * 256 + p, c2 = c1 + 128; st8(q + (size_t)row * 768 + (c1 >> 6) * 96 + (c1 & 63), x1); st8(q + (size_t)row * 768 + (c2 >> 6) * 96 + (c2 & 63), x2); }
        else { rope8(x1, x2, ctx, row & (SEQ - 1)); bf16* d = q + (size_t)row * 768 + (p >> 4) * 96 + 64 + (p & 15); st8(d, x1); st8(d + 16, x2); }
    }
};
struct NoCtx { };
struct FUkv {
    typedef f32x4 AuxT; typedef NoCtx Ctx; static constexpr int BATCH = 8; static constexpr bool LDS_AUX = ((EPI_LDS_AUX & 2) != 0);
    const float* ssql; bf16* kn;
    __device__ __forceinline__ const float* aux_base() const { return ssql; }
    __device__ __forceinline__ AuxT from_lds(LAS const unsigned char* rowp, int) const { return *(LAS const f32x4*)(rowp + 48); }
    __device__ __forceinline__ Ctx begin(int, int, int) const { return Ctx{}; }
    __device__ __forceinline__ AuxT load(int row, int, int, int) const { return *(const f32x4*)(ssql + (size_t)row * 16 + 12); }
    __device__ __forceinline__ void apply(const Ctx&, const AuxT& ax, int row, int pn, int wc, int fq, float* x1, float* x2) const {
        const float rs = __builtin_amdgcn_rsqf(((ax.x + ax.y) + (ax.z + ax.w)) * (1.0f / 256.0f) + EPS);
#pragma unroll
        for (int j = 0; j < 8; ++j) { x1[j] *= rs; x2[j] *= rs; }
        const int p = wc * 32 + fq * 8; bf16* d = kn + (size_t)(pn >> 1) * (size_t)(32 * MiB) + (size_t)row * 512 + (pn & 1) * 256 + p; st8(d, x1); st8(d + 128, x2);
    }
};
struct ResAux { u32x4 a, b; f32x4 s; };
template <bool SCALE> struct FRes {
    typedef ResAux AuxT; typedef NoCtx Ctx; static constexpr int BATCH = RES_BATCH; static constexpr bool LDS_AUX = false;
    bf16* xb; const float* ssq_in; float* ssq_out;
    __device__ __forceinline__ Ctx begin(int, int, int) const { return Ctx{}; }
    __device__ __forceinline__ AuxT load(int row, int pn, int wc, int fq) const {
        const size_t o = (size_t)row * DM + pn * 256 + wc * 32 + fq * 8; AuxT ax;
        ax.a = *(const u32x4*)(xb + o); ax.b = *(const u32x4*)(xb + o + 128); ax.s = (f32x4){0.f, 0.f, 0.f, 0.f};
        if (SCALE) ax.s = part4(ssq_in + (size_t)row * 16, fq, 4);
        return ax;
    }
    __device__ __forceinline__ void apply(const Ctx&, const AuxT& ax, int row, int pn, int wc, int fq, float* x1, float* x2) const {
        const int p = wc * 32 + fq * 8; const size_t o = (size_t)row * DM + pn * 256 + p;
        if (SCALE) { const float r2 = 1.0f / (red4(ax.s) * (1.0f / DM) + EPS);
#pragma unroll
            for (int j = 0; j < 8; ++j) { x1[j] *= r2; x2[j] *= r2; } }
        float a[8], b[8]; unpack8(ax.a, a); unpack8(ax.b, b);
#pragma unroll
        for (int j = 0; j < 8; ++j) { x1[j] += a[j]; x2[j] += b[j]; }
        st8(xb + o, x1); st8(xb + o + 128, x2);
        const float s = ssq16(x1, x2); if (fq == 0) ssq_out[(size_t)row * 16 + pn * 4 + wc] = s;
    }
};
struct FFf1 {
    typedef int AuxT; typedef NoCtx Ctx; static constexpr int BATCH = 8; static constexpr bool LDS_AUX = false;
    bf16* h;
    __device__ __forceinline__ Ctx begin(int, int, int) const { return Ctx{}; }
    __device__ __forceinline__ AuxT load(int, int, int, int) const { return 0; }
    __device__ __forceinline__ void apply(const Ctx&, const AuxT&, int row, int pn, int wc, int fq, float* x1, float* x2) const {
#pragma unroll
        for (int j = 0; j < 8; ++j) { const float a = fmaxf(x1[j], 0.f), b = fmaxf(x2[j], 0.f); x1[j] = a * a; x2[j] = b * b; }
        const int p = wc * 32 + fq * 8; bf16* d = h + (size_t)row * FF + pn * 256 + p; st8nt(d, x1); st8nt(d + 128, x2);
    }
};

struct FNull {
    typedef int AuxT; typedef NoCtx Ctx; static constexpr int BATCH = 8; static constexpr bool LDS_AUX = false;
    __device__ __forceinline__ Ctx begin(int, int, int) const { return Ctx{}; }
    __device__ __forceinline__ AuxT load(int, int, int, int) const { return 0; }
    __device__ __forceinline__ void apply(const Ctx&, const AuxT&, int, int, int, int, float* x1, float* x2) const {
#pragma unroll
        for (int j = 0; j < 8; ++j) asm volatile("" :: "v"(x1[j]), "v"(x2[j])); }
};
#if MK_NAIVE_GEMM
template <class Epi, class Sched>
__device__ __forceinline__ void gemm_phase_x(LAS unsigned char*, const pg8::Gemm g, const Sched& S, const Epi& E, const int wave_id) {
    const int tid = tid_here(), wid = wave_id, lane = tid & 63, wr = wid >> 2, wc = wid & 3, fr = lane & 15, fq = lane >> 4;
    pg8::Unit u;
    for (int it = 0; S.next(it, u); ++it) {
        pg8::f32x4 acc[2][2][4][2];
#pragma unroll
        for (int a = 0; a < 2; ++a)
#pragma unroll
            for (int b = 0; b < 2; ++b)
#pragma unroll
                for (int m = 0; m < 4; ++m)
#pragma unroll
                    for (int n = 0; n < 2; ++n) acc[a][b][m][n] = (pg8::f32x4){0.f, 0.f, 0.f, 0.f};
        for (int k = 0; k < g.K; k += 8) {
            float bv[2][8][8];
#pragma unroll
            for (int bj = 0; bj < 2; ++bj)
#pragma unroll
                for (int c = 0; c < 8; ++c) { const int col = u.pn * 256 + bj * 128 + wc * 32 + fq * 8 + c; unpack8(*(const u32x4*)(g.Bt + (size_t)col * g.K + k), bv[bj][c]); }
#pragma unroll
            for (int ai = 0; ai < 2; ++ai)
#pragma unroll
                for (int m = 0; m < 4; ++m) { const int row = u.pm * 256 + ai * 128 + wr * 64 + m * 16 + fr; float av[8]; unpack8(*(const u32x4*)(g.A + (size_t)row * g.K + k), av);
#pragma unroll
                    for (int bj = 0; bj < 2; ++bj)
#pragma unroll
                        for (int c = 0; c < 8; ++c) { float s = 0.f;
#pragma unroll
                            for (int j = 0; j < 8; ++j) s += av[j] * bv[bj][c][j];
                            acc[ai][bj][m][c >> 2][c & 3] += s; } }
        }
        E(acc, u, wr, wc, fr, fq);
    }
    __syncthreads();
}
#define GEMM_PHASE(EpiType, lds, g, S, E) gemm_phase_x<EpiType, pg8::StaticOrder>(lds, g, S, E, wave_id)
#else
#define GEMM_PHASE(EpiType, lds, g, S, E) pg8::gemm_phase<EpiType, pg8::StaticOrder, true, true>(lds, g, S, E, wave_id)
#endif
#if PROBE_KL
#define KL_RUN(bit, FT, ...) do { EpiT<FT> E{FT{__VA_ARGS__}}; for (int rep_ = 0; rep_ < ((PROBE_KL >> (bit)) & 1) + 1; ++rep_) { __syncthreads(); if (tid_here() == 0) *(volatile LAS unsigned*)(lds + MISC_OFF + 128) = (rep_ + 1 < ((PROBE_KL >> (bit)) & 1) + 1) ? 1u : 0u; __syncthreads(); GEMM_PHASE(EpiT<FT>, lds, g, S, E); } } while (0)
#else
#define KL_RUN(bit, FT, ...) do { EpiT<FT> E{FT{__VA_ARGS__}}; GEMM_PHASE(EpiT<FT>, lds, g, S, E); } while (0)
#endif

__device__ __forceinline__ void mla_naive(const bf16* Q, const bf16* KN, const bf16* MS, const bf16* V, bf16* O, const int wave_id) {
    const int tid = tid_here();
    for (int u = blockIdx.x; u < BATCH * 8 * 4; u += gridDim.x) {
        const int b = u >> 5, h = (u >> 2) & 7, tb = u & 3, t = tb * 512 + tid; const size_t row = (size_t)b * SEQ + t;
        float q[96], o[64];
#pragma unroll
        for (int c = 0; c < 12; ++c) unpack8(*(const u32x4*)(Q + row * 768 + h * 96 + c * 8), q + c * 8);
#pragma unroll
        for (int d = 0; d < 64; ++d) o[d] = 0.f;
        float mx = -1e30f, l = 0.f;
        const int smax = tb * 512 + (tid | 63);
        for (int s = 0; s <= smax; ++s) {
            const size_t rs = (size_t)b * SEQ + s; float sc = 0.f;
#pragma unroll
            for (int c = 0; c < 8; ++c) { float k[8]; unpack8(*(const u32x4*)(KN + rs * 512 + h * 64 + c * 8), k);
#pragma unroll
                for (int j = 0; j < 8; ++j) sc += q[c * 8 + j] * k[j]; }
#pragma unroll
            for (int c = 0; c < 4; ++c) { float k[8]; unpack8(*(const u32x4*)(MS + rs * 256 + 64 + c * 8), k);
#pragma unroll
                for (int j = 0; j < 8; ++j) sc += q[64 + c * 8 + j] * k[j]; }
            if (s <= t) {
                const float mn = fmaxf(mx, sc), a = __builtin_amdgcn_exp2f(mx - mn), pp = __builtin_amdgcn_exp2f(sc - mn);
                l = l * a + pp; mx = mn;
#pragma unroll
                for (int c = 0; c < 8; ++c) { float v[8]; unpack8(*(const u32x4*)(V + rs * 512 + h * 64 + c * 8), v);
#pragma unroll
                    for (int j = 0; j < 8; ++j) o[c * 8 + j] = o[c * 8 + j] * a + pp * v[j]; }
            }
        }
        const float inv = 1.0f / l;
#pragma unroll
        for (int c = 0; c < 8; ++c) { float w[8];
#pragma unroll
            for (int j = 0; j < 8; ++j) w[j] = o[c * 8 + j] * inv;
            st8(O + row * DM + h * 64 + c * 8, w); }
    }
}
__device__ __forceinline__ void dsa_naive(const bf16* AQ, const bf16* MS, const unsigned* BM, bf16* O, const int wave_id) {
    const int tid = tid_here();
    for (int u = blockIdx.x; u < BATCH * 4 * 4; u += gridDim.x) {
        const int b = u >> 4, h = (u >> 2) & 3, tb = u & 3, t = tb * 512 + tid; const size_t row = (size_t)b * SEQ + t;
        float q[64], o[64];
#pragma unroll
        for (int c = 0; c < 8; ++c) { unpack8(*(const u32x4*)(AQ + row * 256 + h * 64 + c * 8), q + c * 8);
#pragma unroll
            for (int j = 0; j < 8; ++j) q[c * 8 + j] *= 1.0f; }
#pragma unroll
        for (int d = 0; d < 64; ++d) o[d] = 0.f;
        float mx = -1e30f, l = 0.f; unsigned word = 0;
        const int smax = tb * 512 + (tid | 63);
        for (int s = 0; s <= smax; ++s) {
            if ((s & 31) == 0) word = BM[row * 64 + (s >> 5)];
            const bool sel = (s <= t) && ((word >> (s & 31)) & 1u);
            if (sel) {
                const size_t rs = (size_t)b * SEQ + s; float sc = 0.f;
#pragma unroll
                for (int c = 0; c < 8; ++c) { float k[8]; unpack8(*(const u32x4*)(MS + rs * 256 + c * 8), k);
#pragma unroll
                    for (int j = 0; j < 8; ++j) sc += q[c * 8 + j] * k[j]; }
                const float mn = fmaxf(mx, sc), a = __builtin_amdgcn_exp2f(mx - mn), pp = __builtin_amdgcn_exp2f(sc - mn);
                l = l * a + pp; mx = mn;
#pragma unroll
                for (int c = 0; c < 8; ++c) { float v[8]; unpack8(*(const u32x4*)(MS + rs * 256 + 128 + c * 8), v);
#pragma unroll
                    for (int j = 0; j < 8; ++j) o[c * 8 + j] = o[c * 8 + j] * a + pp * v[j]; }
            }
        }
        const float inv = 1.0f / l;
#pragma unroll
        for (int c = 0; c < 8; ++c) { float w[8];
#pragma unroll
            for (int j = 0; j < 8; ++j) w[j] = o[c * 8 + j] * inv;
            st8(O + row * DM + 512 + h * 64 + c * 8, w); }
    }
}
typedef float f32x2s __attribute__((ext_vector_type(2)));
__device__ __forceinline__ f32x2s pk_gt(f32x2s v, f32x2s big, f32x2s nm) { f32x2s e; asm("v_pk_fma_f32 %0, %1, %2, %3 clamp" : "=v"(e) : "v"(v), "v"(big), "v"(nm)); return e; }
__device__ __forceinline__ float max3_raw(float a, float b, float c) { float r; asm("v_max3_f32 %0, %1, %2, %3" : "=v"(r) : "v"(a), "v"(b), "v"(c)); return r; }
__device__ __forceinline__ float min3_raw(float a, float b, float c) { float r; asm("v_min3_f32 %0, %1, %2, %3" : "=v"(r) : "v"(a), "v"(b), "v"(c)); return r; }
__device__ __forceinline__ float wave_sum_f(float x) {
    x += __int_as_float(DPP_I(__float_as_int(x), 0xB1)); x += __int_as_float(DPP_I(__float_as_int(x), 0x4E)); x += __int_as_float(DPP_I(__float_as_int(x), 0x141)); x += __int_as_float(DPP_I(__float_as_int(x), 0x140));
    const int xi = __float_as_int(x);
    return (__int_as_float(__builtin_amdgcn_readlane(xi, 0)) + __int_as_float(__builtin_amdgcn_readlane(xi, 16))) + (__int_as_float(__builtin_amdgcn_readlane(xi, 32)) + __int_as_float(__builtin_amdgcn_readlane(xi, 48))); }
__device__ __forceinline__ int fkey(int u) { return u ^ ((u >> 31) & 0x7fffffff); }
template <int NR>
__device__ __forceinline__ void select_row(const f32x2s (&vp)[NR / 2], int nk, u64* bm, int lane) {
    static_assert(NR % 2 == 0, "pairs");
    float mx = vp[0].x, mn = vp[0].x;
#pragma unroll
    for (int j = 0; j < NR / 2; ++j) { mx = max3_raw(mx, vp[j].x, vp[j].y); mn = min3_raw(mn, vp[j].x, vp[j].y); }
    float hi = wave_max_f(mx); const float mnw = wave_min_f(mn);
    float lo = mnw - fabsf(mnw) * 1e-3f - 1e-3f;
    int clo = nk, chi = 0;
    bool exact = false; float thr = hi;
    float bigs = 1.152921504606847e18f, zf = 0.f; asm volatile("" : "+v"(bigs), "+v"(zf));
    const f32x2s big = {bigs, bigs};
    constexpr int NS = (NR == 8) ? 4 : NR - 8;
#define OPQ(c) ({ float c_ = (c); asm volatile("" : "+v"(c_)); c_; })
    f32x2s s1 = {zf, zf}, s2 = {zf, zf};
#pragma unroll
    for (int j = 0; j < NS / 2; ++j) { s1 += vp[j]; s2 += vp[j] * vp[j]; }
    const float S1 = wave_sum_f(s1.x + s1.y), S2 = wave_sum_f(s2.x + s2.y);
    const float invn = OPQ(1.0f / (64.0f * NS));
    float mu = S1 * invn; asm volatile("" : "+v"(mu));
    float var = fmaxf(__builtin_fmaf(S2, invn, -mu * mu), OPQ(1e-20f)); asm volatile("" : "+v"(var));
    float sd = var * __builtin_amdgcn_rsqf(var); asm volatile("" : "+v"(sd));
    float pq = 1.0f - OPQ(256.5f) * __builtin_amdgcn_rcpf((float)nk); pq = fminf(fmaxf(pq, OPQ(0.025f)), OPQ(0.975f));
    const float z = __builtin_amdgcn_logf(pq * __builtin_amdgcn_rcpf(1.0f - pq)) * OPQ(0.40725434f);
    float zz2 = z * z; asm volatile("" : "+v"(zz2));
    float rdens = sd * __builtin_amdgcn_rcpf((float)nk * OPQ(0.3989422804f) * __builtin_amdgcn_exp2f(OPQ(-0.72134752f) * zz2));
    asm volatile("" : "+v"(rdens));
    float nxt = __builtin_fmaf(z, sd, mu); asm volatile("" : "+v"(nxt)); bool have_nxt = true; int nsteps = 0;
    for (int it = 0; it < 200; ++it) {
        const int kl = fkey(__float_as_int(lo)), kh = fkey(__float_as_int(hi));
        if ((unsigned)kh - (unsigned)kl <= 1u) break;
        const float kmid = __int_as_float(fkey(kl + (int)(((unsigned)kh - (unsigned)kl) >> 1)));
        float mid = 0.5f * lo + 0.5f * hi;
        const bool third = (it % 3 == 2);
        if (third || !(mid > lo) || !(mid < hi)) mid = kmid;
        if (have_nxt) { if (nxt > lo && nxt < hi) mid = nxt; have_nxt = false; }
        else if (!third) { const float gq = lo + (hi - lo) * (((float)(clo - 256) + 0.5f) * __builtin_amdgcn_rcpf((float)(clo - chi))); if (gq > lo && gq < hi) mid = gq; }
        const float nmv = -mid * 1.152921504606847e18f; const f32x2s nm = {nmv, nmv};
        f32x2s acc0 = {zf, zf}, acc1 = {zf, zf}, acc2 = {zf, zf}, acc3 = {zf, zf};
#pragma unroll
        for (int j = 0; j < NR / 2; j += 4) { acc0 += pk_gt(vp[j], big, nm); acc1 += pk_gt(vp[j + 1], big, nm); acc2 += pk_gt(vp[j + 2], big, nm); acc3 += pk_gt(vp[j + 3], big, nm); }
        const f32x2s acc = (acc0 + acc1) + (acc2 + acc3);
        const int c = (int)wave_sum_f(acc.x + acc.y);
        if (c == 256) { exact = true; thr = mid; break; }
        if (c > 256) { lo = mid; clo = c; } else { hi = mid; chi = c; }
        if (nsteps < 2) { ++nsteps; nxt = mid + ((float)(c - 256) + 0.5f) * rdens; have_nxt = true; }
    }
    if (exact) {
#pragma unroll
        for (int j = 0; j < NR / 2; ++j) { const u64 w0 = __ballot(vp[j].x > thr), w1 = __ballot(vp[j].y > thr); bm[2 * j] = w0; bm[2 * j + 1] = w1; }
    } else {
        const int need = 256 - chi; int tr = 0; const u64 lt = (1ull << lane) - 1ull;
#pragma unroll
        for (int i = 0; i < NR; ++i) { const float x = (i & 1) ? vp[i >> 1].y : vp[i >> 1].x; const bool gt = x > hi, tie = (x == hi); const u64 tb = __ballot(tie); const int rank = tr + __popcll(tb & lt); tr += __popcll(tb);
            const u64 w = __ballot(gt || (tie && rank < need)); bm[i] = w; }
    }
}
__device__ __forceinline__ void select_naive(LAS unsigned char* lds, const bf16* QI, const bf16* MS, const float* WI, u64* BM, const int wave_id) {
    const int tid = tid_here(), wave = wave_id, lane = tid & 63;
    LAS float* sc_lds = (LAS float*)(lds + wave * 8192);
    LAS float* qi_lds = (LAS float*)(lds + 65536 + wave * 1024);
    for (int qb = blockIdx.x; qb < M / 8; qb += gridDim.x) {
        const int row = qb * 8 + wave, b = row >> 11, t = row & (SEQ - 1);
        u64* bm = BM + (size_t)row * 32;
        if (t < 256) { if (lane < 32) { const int k0 = 64 * lane; bm[lane] = (t >= k0 + 63) ? ~0ull : (t < k0 ? 0ull : ((1ull << (t - k0 + 1)) - 1ull)); } continue; }
        { const u32x2 r = *(const u32x2*)(QI + (size_t)row * 256 + lane * 4); qi_lds[lane * 4] = bf_lo(r.x); qi_lds[lane * 4 + 1] = bf_hi(r.x); qi_lds[lane * 4 + 2] = bf_lo(r.y); qi_lds[lane * 4 + 3] = bf_hi(r.y); }
        float w8[8];
#pragma unroll
        for (int hh = 0; hh < 8; ++hh) w8[hh] = WI[(size_t)row * 8 + hh];
        LDS_WAIT();
        const int nk = t + 1;
        for (int s0 = 0; s0 < nk; s0 += 64) {
            const int s = s0 + lane; float scv = -INFINITY;
            if (s < nk) { float k[32];
#pragma unroll
                for (int c = 0; c < 4; ++c) unpack8(*(const u32x4*)(MS + ((size_t)b * SEQ + s) * 256 + 96 + c * 8), k + c * 8);
                scv = 0.f;
#pragma unroll
                for (int hh = 0; hh < 8; ++hh) { float d = 0.f;
#pragma unroll
                    for (int j = 0; j < 32; ++j) d += qi_lds[hh * 32 + j] * k[j];
                    scv += w8[hh] * fmaxf(d, 0.f); } }
            sc_lds[s] = scv; }
        LDS_WAIT();
        float v[32];
#pragma unroll
        for (int i = 0; i < 32; ++i) v[i] = (i * 64 + lane < nk) ? sc_lds[i * 64 + lane] : __builtin_nanf("");
        { f32x2s vp[16];
#pragma unroll
          for (int i = 0; i < 32; ++i) { if (i & 1) vp[i >> 1].y = v[i]; else vp[i >> 1].x = v[i]; }
          select_row<32>(vp, nk, bm, lane); }
        LDS_WAIT();
    }
}
__device__ __forceinline__ void ret_naive(const bf16* RQ, const bf16* RK, const bf16* RV, const bf16* RG, const float* g_ret, bf16* O, const int wave_id) {
    const int tid = tid_here();
    for (int u = blockIdx.x; u < BATCH * 4 * 4; u += gridDim.x) {
        const int b = u >> 4, h = (u >> 2) & 3, tb = u & 3, t = tb * 512 + tid; const size_t row = (size_t)b * SEQ + t;
        const float lg2 = (h == 0) ? -0.045803689613124935f : (h == 1) ? -0.022720076500083562f : (h == 2) ? -0.011315313227834123f : -0.0056465631411395075f;
        float q[64], o[64];
#pragma unroll
        for (int c = 0; c < 8; ++c) unpack8(*(const u32x4*)(RQ + row * 256 + h * 64 + c * 8), q + c * 8);
#pragma unroll
        for (int d = 0; d < 64; ++d) o[d] = 0.f;
        const int smax = tb * 512 + (tid | 63);
        for (int s = 0; s <= smax; ++s) {
            const size_t rs = (size_t)b * SEQ + s; float sc = 0.f;
#pragma unroll
            for (int c = 0; c < 8; ++c) { float k[8]; unpack8(*(const u32x4*)(RK + rs * 256 + h * 64 + c * 8), k);
#pragma unroll
                for (int j = 0; j < 8; ++j) sc += q[c * 8 + j] * k[j]; }
            if (s <= t) {
                const float w = sc * __builtin_amdgcn_exp2f((float)(t - s) * lg2);
#pragma unroll
                for (int c = 0; c < 8; ++c) { float v[8]; unpack8(*(const u32x4*)(RV + rs * 256 + h * 64 + c * 8), v);
#pragma unroll
                    for (int j = 0; j < 8; ++j) o[c * 8 + j] += w * v[j]; }
            }
        }
        float mu = 0.f;
#pragma unroll
        for (int d = 0; d < 64; ++d) mu += o[d];
        mu *= (1.0f / 64.0f); float var = 0.f;
#pragma unroll
        for (int d = 0; d < 64; ++d) { const float e = o[d] - mu; var += e * e; }
        const float rstd = 1.0f / sqrtf(var * (1.0f / 64.0f) + EPS);
#pragma unroll
        for (int c = 0; c < 8; ++c) { float g[8], w[8]; unpack8(*(const u32x4*)(RG + row * 256 + h * 64 + c * 8), g);
#pragma unroll
            for (int j = 0; j < 8; ++j) { const float y = (o[c * 8 + j] - mu) * rstd * g_ret[h * 64 + c * 8 + j]; w[j] = y * g[j] / (1.0f + __expf(-g[j])); }
            st8(O + row * DM + 768 + h * 64 + c * 8, w); }
    }
}

typedef short bf16x8 __attribute__((ext_vector_type(8)));
typedef float f32x16 __attribute__((ext_vector_type(16)));
typedef short s16x4 __attribute__((ext_vector_type(4)));
__device__ __forceinline__ s16x4 ds_tr16(LAS const unsigned char* p) { return __builtin_bit_cast(s16x4, __builtin_amdgcn_ds_read_tr16_b64_v4i16((LAS s16x4*)p)); }
struct TagF { static constexpr bool value = true; }; struct TagG { static constexpr bool value = false; };
template <bool MLA>
__device__ __forceinline__ void attn_phase(LAS unsigned char* lds, const bf16* Qp, const bf16* KNp, const bf16* MSp, const bf16* Vp, const u64* BMp, bf16* Op, const int wave_id) {
    constexpr int DQK = MLA ? 96 : 64, KS = DQK / 16, KP = DQK * 2 + 16, VP = 192, KBUF = 64 * KP, VBUF = 64 * VP, BUF = KBUF + VBUF, QG = 2, NQR = MLA ? ATT_NQR : 4, QSLOT = QG * (KS - NQR) * 1024;
    static_assert(2 * BUF + 8 * QSLOT <= RING_BYTES, "attention LDS");
    const int tid = tid_here(), wave = wave_id, lane = tid & 63, l31 = lane & 31, hi = lane >> 5;
    const int G = gridDim.x, NU = MLA ? 1024 : 512;
    const int keyA = tid >> 3, chA = tid & 7;
    const int vb = (4 * hi + ((lane & 15) >> 2)) * VP + (16 * ((lane >> 4) & 1) + 4 * (lane & 3)) * 2;
    for (int u = blockIdx.x; u < NU; u += G) {
        int b, h, qw0, nt;
        if (MLA) { const int bh = u & 255, r = u >> 8, qb = (r + bh) & 3; b = bh >> 3; h = bh & 7; qw0 = qb * 512 + 64 * wave; nt = 8 * (qb + 1); }
        else { const int bj = u & 255, r = u >> 8, j = bj & 7, qb = (r == 0) ? j : 15 - j; b = bj >> 3; h = wave >> 1; qw0 = qb * 128 + 64 * (wave & 1); nt = 2 * (qb + 1); }
        const int qg0[2] = {MLA ? qw0 - 32 * wave : qw0, MLA ? qw0 - 64 * wave + 32 * (15 - wave) : qw0 + 32};
        const size_t rowb = (size_t)b * SEQ;
        bf16x8 qf[QG][NQR];
        LAS unsigned char* qrl = lds + 2 * BUF + wave * QSLOT + lane * 16;
#pragma unroll
        for (int g = 0; g < QG; ++g)
#pragma unroll
            for (int s = 0; s < KS; ++s) { const bf16* qb_ = Qp + (rowb + qg0[g]) * (MLA ? 768 : 256) + h * DQK + 16 * s;
                const bf16x8 f = *(const bf16x8*)((const char*)qb_ + (unsigned)(l31 * (MLA ? 1536 : 512) + 16 * hi));
                if (s < NQR) qf[g][s < NQR ? s : 0] = f; else *(LAS bf16x8*)(qrl + (g * (KS - NQR) + (s - NQR)) * 1024) = f; }
        f32x16 ot[QG][2];
#pragma unroll
        for (int g = 0; g < QG; ++g)
#pragma unroll
            for (int r = 0; r < 16; ++r) { ot[g][0][r] = 0.f; ot[g][1][r] = 0.f; }
        float mrun[QG], lrun[QG];
#pragma unroll
        for (int g = 0; g < QG; ++g) { mrun[g] = -1e30f; lrun[g] = 0.f; }
        u32x4 sa, sb, sc;
        const unsigned offA_ = 2u * (unsigned)(MLA ? keyA * 512 + chA * 8 : keyA * 256 + chA * 8);
        const unsigned offB_ = 2u * (unsigned)(MLA ? (tid < 256 ? (tid >> 2) * 256 + 64 + (tid & 3) * 8 : ((tid - 256) >> 3) * 512 + chA * 8) : keyA * 256 + 128 + chA * 8);
        const unsigned offC_ = 2u * (unsigned)((32 + keyA) * 512 + chA * 8);
#define ATT_LOAD(j) do { const size_t rk = rowb + 64 * (j); unsigned offA = offA_, offB = offB_, offC = offC_; asm volatile("" : "+v"(offA), "+v"(offB), "+v"(offC));     \
            if (MLA) { const bf16* kb_ = KNp + rk * 512 + h * 64; const bf16* vb2_ = Vp + rk * 512 + h * 64; const bf16* mb_ = MSp + rk * 256; \
                       sa = *(const u32x4*)((const char*)kb_ + offA); \
                       if (tid < 256) { sb = *(const u32x4*)((const char*)mb_ + offB); sc = *(const u32x4*)((const char*)vb2_ + offC); } \
                       else sb = *(const u32x4*)((const char*)vb2_ + offB); } \
            else { const bf16* mb_ = MSp + rk * 256; sa = *(const u32x4*)((const char*)mb_ + offA); sb = *(const u32x4*)((const char*)mb_ + offB); } } while (0)
#define ATT_WRITE(buf) do { LAS unsigned char* kb_ = lds + (buf) * BUF; LAS unsigned char* vb_ = kb_ + KBUF; \
            *(LAS u32x4*)(kb_ + keyA * KP + chA * 16) = sa; \
            if (MLA) { if (tid < 256) { *(LAS u32x4*)(kb_ + (tid >> 2) * KP + 128 + (tid & 3) * 16) = sb; *(LAS u32x4*)(vb_ + (32 + keyA) * VP + chA * 16) = sc; } \
                       else *(LAS u32x4*)(vb_ + ((tid - 256) >> 3) * VP + chA * 16) = sb; } \
            else *(LAS u32x4*)(vb_ + keyA * VP + chA * 16) = sb; } while (0)
        auto tile = [&](auto tag_, const int j) __attribute__((always_inline)) {
            constexpr bool FULL = decltype(tag_)::value;
            const bool active = (MLA && !FULL) ? (64 * j <= qg0[1] + 31) : true, act0 = (MLA && !FULL) ? (64 * j <= qg0[0] + 31) : true;
            if (active) {
                LAS const unsigned char* kbuf = lds + (j & 1) * BUF; LAS const unsigned char* vbuf = kbuf + KBUF;
                f32x16 st[QG][2];
#pragma unroll
                for (int g = 0; g < QG; ++g)
#pragma unroll
                    for (int r = 0; r < 16; ++r) { st[g][0][r] = 0.f; st[g][1][r] = 0.f; }
#pragma unroll
                for (int s = 0; s < KS; ++s) {
                    const bf16x8 k0 = *(LAS const bf16x8*)(kbuf + l31 * KP + (16 * s + 8 * hi) * 2), k1 = *(LAS const bf16x8*)(kbuf + (32 + l31) * KP + (16 * s + 8 * hi) * 2);
#pragma unroll
                    for (int g = 0; g < QG; ++g) { if (g == 0 && !act0) continue; bf16x8 qq; if (s < NQR) qq = qf[g][s < NQR ? s : 0]; else qq = *(LAS const bf16x8*)(qrl + (g * (KS - NQR) + (s - NQR)) * 1024);
                        st[g][0] = __builtin_amdgcn_mfma_f32_32x32x16_bf16(k0, qq, st[g][0], 0, 0, 0); st[g][1] = __builtin_amdgcn_mfma_f32_32x32x16_bf16(k1, qq, st[g][1], 0, 0, 0); } }
                bf16x8 pf[QG][4];
#define ATT_MASK(g) do { const int qpos = qg0[g] + l31; \
                    if (MLA) { if (64 * j + 63 > qg0[g]) { const int lim = qpos - 64 * j - 4 * hi; \
                            _Pragma("unroll") for (int r = 0; r < 16; ++r) { const int ko = (r & 3) + 8 * (r >> 2); if (ko > lim) st[g][0][r] = -INFINITY; if (ko + 32 > lim) st[g][1][r] = -INFINITY; } } } \
                    else { const u64* bmb_ = BMp + (rowb + qg0[g]) * 32 + j; unsigned lo_ = (unsigned)(l31 * 256); asm volatile("" : "+v"(lo_)); \
                        const u64 w = *(const u64*)((const char*)bmb_ + lo_); const unsigned wlo = (unsigned)(w >> (4 * hi)), whi = (unsigned)(w >> (32 + 4 * hi)); \
                        _Pragma("unroll") for (int r = 0; r < 16; ++r) { const int ko = (r & 3) + 8 * (r >> 2); \
                            { const unsigned m_ = (unsigned)__builtin_amdgcn_sbfe((int)wlo, ko, 1); st[g][0][r] = __uint_as_float((m_ & __float_as_uint(st[g][0][r])) | (~m_ & 0xff800000u)); } \
                            { const unsigned m_ = (unsigned)__builtin_amdgcn_sbfe((int)whi, ko, 1); st[g][1][r] = __uint_as_float((m_ & __float_as_uint(st[g][1][r])) | (~m_ & 0xff800000u)); } } } } while (0)
#define ATT_MX3(a, b, c) __builtin_fmaxf(__builtin_fmaxf((a), (b)), (c))
#define ATT_MAXR(g, mt) do { float ma_ = st[g][0][0], mb_ = st[g][1][0]; \
                    _Pragma("unroll") for (int r = 1; r < 16; r += 2) { ma_ = ATT_MX3(ma_, st[g][0][r], st[g][0][r + 1 < 16 ? r + 1 : r]); mb_ = ATT_MX3(mb_, st[g][1][r], st[g][1][r + 1 < 16 ? r + 1 : r]); } \
                    mt = xhalf_max(__builtin_fmaxf(ma_, mb_)); } while (0)
#define ATT_RESC(g, mt) do { const float mn0 = fmaxf(mrun[g], mt), alpha = __builtin_amdgcn_exp2f(mrun[g] - mn0); mrun[g] = mn0; lrun[g] *= alpha; \
                    _Pragma("unroll") for (int r = 0; r < 16; ++r) { ot[g][0][r] *= alpha; ot[g][1][r] *= alpha; } } while (0)
#define ATT_EXPS(g) do { const float mn = mrun[g]; float ps = 0.f; \
                    _Pragma("unroll") for (int r = 0; r < 16; ++r) { st[g][0][r] = __builtin_amdgcn_exp2f(st[g][0][r] - mn); st[g][1][r] = __builtin_amdgcn_exp2f(st[g][1][r] - mn); ps += st[g][0][r] + st[g][1][r]; } \
                    lrun[g] += ps; \
                    _Pragma("unroll") for (int t = 0; t < 2; ++t) _Pragma("unroll") for (int s = 0; s < 2; ++s) { u32x4 a; a.x = cvtpk(st[g][t][8 * s], st[g][t][8 * s + 1]); a.y = cvtpk(st[g][t][8 * s + 2], st[g][t][8 * s + 3]); \
                            a.z = cvtpk(st[g][t][8 * s + 4], st[g][t][8 * s + 5]); a.w = cvtpk(st[g][t][8 * s + 6], st[g][t][8 * s + 7]); pf[g][2 * t + s] = __builtin_bit_cast(bf16x8, a); } } while (0)
                if (FULL || !MLA) {
                    float mt0, mt1;
                    if (!FULL) { ATT_MASK(0); ATT_MASK(1); } ATT_MAXR(0, mt0); ATT_MAXR(1, mt1);
                    if (__builtin_amdgcn_ballot_w64((mt0 > mrun[0] + 6.0f) || (mt1 > mrun[1] + 6.0f)) != 0ull) { ATT_RESC(0, mt0); ATT_RESC(1, mt1); }
                    __builtin_amdgcn_sched_barrier(0); ATT_EXPS(0); __builtin_amdgcn_sched_barrier(0); ATT_EXPS(1);
                } else {
                    if (act0) { float mt0; ATT_MASK(0); ATT_MAXR(0, mt0); if (__builtin_amdgcn_ballot_w64(mt0 > mrun[0] + 6.0f) != 0ull) { ATT_RESC(0, mt0); } ATT_EXPS(0); }
                    float mt1;
                    ATT_MASK(1); ATT_MAXR(1, mt1);
                    if (__builtin_amdgcn_ballot_w64(mt1 > mrun[1] + 6.0f) != 0ull) { ATT_RESC(1, mt1); }
                    ATT_EXPS(1);
                }
#undef ATT_MASK
#undef ATT_MAXR
#undef ATT_RESC
#undef ATT_EXPS
#pragma unroll
                for (int ks = 0; ks < 4; ++ks) {
                    const s16x4 a0 = ds_tr16(vbuf + vb + (16 * ks) * VP), a1 = ds_tr16(vbuf + vb + (16 * ks + 8) * VP), c0 = ds_tr16(vbuf + vb + (16 * ks) * VP + 64), c1 = ds_tr16(vbuf + vb + (16 * ks + 8) * VP + 64);
                    const bf16x8 v0 = {a0[0], a0[1], a0[2], a0[3], a1[0], a1[1], a1[2], a1[3]}, v1 = {c0[0], c0[1], c0[2], c0[3], c1[0], c1[1], c1[2], c1[3]};
#pragma unroll
                    for (int g = 0; g < QG; ++g) { if (g == 0 && !act0) continue; ot[g][0] = __builtin_amdgcn_mfma_f32_32x32x16_bf16(v0, pf[g][ks], ot[g][0], 0, 0, 0); ot[g][1] = __builtin_amdgcn_mfma_f32_32x32x16_bf16(v1, pf[g][ks], ot[g][1], 0, 0, 0); } }
            }
        };
        const int jf = (MLA && ATT_SPLIT) ? (((qg0[0] + 1) >> 6) < nt ? ((qg0[0] + 1) >> 6) : nt) : 0;
        ATT_LOAD(0); ATT_WRITE(0); __syncthreads();
        int j = 0;
        if (MLA && ATT_SPLIT) {
            for (; j < jf; ++j) {
                const bool more = (j + 1 < nt);
                if (more) ATT_LOAD(j + 1);
                tile(TagF{}, j);
                if (more) ATT_WRITE((j + 1) & 1);
                __syncthreads();
            }
        }
        for (; j < nt; ++j) {
            const bool more = (j + 1 < nt);
            if (more) ATT_LOAD(j + 1);
            tile(TagG{}, j);
            if (more) ATT_WRITE((j + 1) & 1);
            __syncthreads();
        }
#undef ATT_LOAD
#undef ATT_WRITE
        const int le = lane_here(), l31e = le & 31, hie = le >> 5;
#pragma unroll
        for (int g = 0; g < QG; ++g) {
            const float inv = 1.0f / xhalf_sum(lrun[g]);
            bf16* orow = Op + (rowb + qg0[g] + l31e) * DM + (MLA ? h * 64 : 512 + h * 64) + 8 * hie;
#pragma unroll
            for (int t = 0; t < 2; ++t)
#pragma unroll
                for (int k = 0; k < 4; k += 2) {
                    u32x2 a, b2; a.x = cvtpk(ot[g][t][4 * k] * inv, ot[g][t][4 * k + 1] * inv); a.y = cvtpk(ot[g][t][4 * k + 2] * inv, ot[g][t][4 * k + 3] * inv);
                    b2.x = cvtpk(ot[g][t][4 * k + 4] * inv, ot[g][t][4 * k + 5] * inv); b2.y = cvtpk(ot[g][t][4 * k + 6] * inv, ot[g][t][4 * k + 7] * inv);
                    const auto rx = __builtin_amdgcn_permlane32_swap(a.x, b2.x, false, false); const auto ry = __builtin_amdgcn_permlane32_swap(a.y, b2.y, false, false);
                    u32x4 w; w.x = rx[0]; w.y = ry[0]; w.z = rx[1]; w.w = ry[1];
                    *(u32x4*)(orow + 32 * t + 8 * k) = w; }
        }
    }
}

__device__ __forceinline__ void ret_phase(LAS unsigned char* lds, const bf16* RQ, const bf16* RK, const bf16* RV, const bf16* RG, const float* g_ret, bf16* Op, const int wave_id) {
    constexpr int KP = 144, VP = 192, OFF_K = 0, OFF_V = 128 * KP, OFF_Z = OFF_V + 128 * VP, OFF_R = OFF_Z + 128 * VP;
    const int tid = tid_here(), wave = wave_id, lane = tid & 63, l31 = lane & 31, hi = lane >> 5;
    const int trq = (lane & 15) >> 2, trc = (16 * ((lane >> 4) & 1) + 4 * (lane & 3)) * 2;
    const int trn = (8 * hi + trq) * VP + trc, trp = (4 * hi + trq) * VP + trc;
    LAS unsigned char* KT = lds + OFF_K; LAS unsigned char* VT = lds + OFF_V; LAS unsigned char* KZ = lds + OFF_Z; LAS unsigned char* RT = lds + OFF_R;
    for (int u = blockIdx.x; u < BATCH * 4; u += gridDim.x) {
        const int b = u >> 2, h = u & 3; const size_t rowb = (size_t)b * SEQ;
        const float lg = (h == 0) ? -0.04580368961312479f : (h == 1) ? -0.02272007650008353f : (h == 2) ? -0.011315313227834146f : -0.005646563141142063f;
        { unsigned zz = 0u; asm volatile("" : "+v"(zz)); *(LAS u32x4*)(RT + (tid >> 3) * VP + (tid & 7) * 16) = (u32x4){zz, zz, zz, zz}; }
        f32x16 sacc;
#pragma unroll
        for (int r = 0; r < 16; ++r) sacc[r] = 0.f;
        u32x4 k0, k1, v0, v1;
#define RET_LOAD(n) do { const size_t r0 = rowb + 128 * (n) + (tid >> 3), r1 = r0 + 64; const int co = h * 64 + (tid & 7) * 8; \
            k0 = *(const u32x4*)(RK + r0 * 256 + co); k1 = *(const u32x4*)(RK + r1 * 256 + co); v0 = *(const u32x4*)(RV + r0 * 256 + co); v1 = *(const u32x4*)(RV + r1 * 256 + co); } while (0)
        RET_LOAD(0);
        for (int n = 0; n < 16; ++n) {
            {
                const int r0 = tid >> 3, cb = (tid & 7) * 16;
                *(LAS u32x4*)(KT + r0 * KP + cb) = k0; *(LAS u32x4*)(KT + (r0 + 64) * KP + cb) = k1; *(LAS u32x4*)(VT + r0 * VP + cb) = v0; *(LAS u32x4*)(VT + (r0 + 64) * VP + cb) = v1;
                float f[8]; const float z0 = __builtin_amdgcn_exp2f((float)(127 - r0) * lg), z1 = __builtin_amdgcn_exp2f((float)(63 - r0) * lg);
                unpack8(k0, f);
#pragma unroll
                for (int j = 0; j < 8; ++j) f[j] *= z0;
                { u32x4 w; w.x = cvtpk(f[0], f[1]); w.y = cvtpk(f[2], f[3]); w.z = cvtpk(f[4], f[5]); w.w = cvtpk(f[6], f[7]); *(LAS u32x4*)(KZ + r0 * VP + cb) = w; }
                unpack8(k1, f);
#pragma unroll
                for (int j = 0; j < 8; ++j) f[j] *= z1;
                { u32x4 w; w.x = cvtpk(f[0], f[1]); w.y = cvtpk(f[2], f[3]); w.z = cvtpk(f[4], f[5]); w.w = cvtpk(f[6], f[7]); *(LAS u32x4*)(KZ + (r0 + 64) * VP + cb) = w; }
            }
            const int posq = 32 * wave + l31; const size_t rowq = rowb + 128 * n + (wave < 4 ? posq : 0);
            bf16x8 qf[4];
            if (wave < 4) {
#pragma unroll
                for (int s = 0; s < 4; ++s) qf[s] = *(const bf16x8*)(RQ + rowq * 256 + h * 64 + 16 * s + 8 * hi); }
            __syncthreads();
            if (n + 1 < 16) RET_LOAD(n + 1);
            f32x16 a0, a1;
            if (wave < 4) {
#pragma unroll
                for (int r = 0; r < 16; ++r) { a0[r] = 0.f; a1[r] = 0.f; }
#pragma unroll
                for (int s = 0; s < 4; ++s) {
                    const s16x4 x0 = ds_tr16(RT + trn + (16 * s) * VP), x1 = ds_tr16(RT + trn + (16 * s + 4) * VP), y0 = ds_tr16(RT + trn + (16 * s) * VP + 64), y1 = ds_tr16(RT + trn + (16 * s + 4) * VP + 64);
                    const bf16x8 f0 = {x0[0], x0[1], x0[2], x0[3], x1[0], x1[1], x1[2], x1[3]}, f1 = {y0[0], y0[1], y0[2], y0[3], y1[0], y1[1], y1[2], y1[3]};
                    a0 = __builtin_amdgcn_mfma_f32_32x32x16_bf16(f0, qf[s], a0, 0, 0, 0); a1 = __builtin_amdgcn_mfma_f32_32x32x16_bf16(f1, qf[s], a1, 0, 0, 0); }
                const float xi = __builtin_amdgcn_exp2f((float)(posq + 1) * lg);
#pragma unroll
                for (int r = 0; r < 16; ++r) { a0[r] *= xi; a1[r] *= xi; }
#pragma unroll 1
                for (int kt = 0; kt <= wave; ++kt) {
                    {
                        f32x16 st;
#pragma unroll
                        for (int r = 0; r < 16; ++r) st[r] = 0.f;
#pragma unroll
                        for (int s = 0; s < 4; ++s) { const bf16x8 kf = *(LAS const bf16x8*)(KT + (32 * kt + l31) * KP + (16 * s + 8 * hi) * 2); st = __builtin_amdgcn_mfma_f32_32x32x16_bf16(kf, qf[s], st, 0, 0, 0); }
#pragma unroll
                        for (int r = 0; r < 16; ++r) { const int rel = posq - (32 * kt + (r & 3) + 8 * (r >> 2) + 4 * hi); const float w = __builtin_amdgcn_exp2f((float)rel * lg); st[r] = (rel >= 0) ? st[r] * w : 0.f; }
#pragma unroll
                        for (int s = 0; s < 2; ++s) {
                            u32x4 pw; pw.x = cvtpk(st[8 * s], st[8 * s + 1]); pw.y = cvtpk(st[8 * s + 2], st[8 * s + 3]); pw.z = cvtpk(st[8 * s + 4], st[8 * s + 5]); pw.w = cvtpk(st[8 * s + 6], st[8 * s + 7]);
                            const bf16x8 pf = __builtin_bit_cast(bf16x8, pw);
                            const int ro = (32 * kt + 16 * s) * VP;
                            const s16x4 x0 = ds_tr16(VT + trp + ro), x1 = ds_tr16(VT + trp + ro + 8 * VP), y0 = ds_tr16(VT + trp + ro + 64), y1 = ds_tr16(VT + trp + ro + 8 * VP + 64);
                            const bf16x8 f0 = {x0[0], x0[1], x0[2], x0[3], x1[0], x1[1], x1[2], x1[3]}, f1 = {y0[0], y0[1], y0[2], y0[3], y1[0], y1[1], y1[2], y1[3]};
                            a0 = __builtin_amdgcn_mfma_f32_32x32x16_bf16(f0, pf, a0, 0, 0, 0); a1 = __builtin_amdgcn_mfma_f32_32x32x16_bf16(f1, pf, a1, 0, 0, 0); }
                    }
                }
            } else {
                const int et = wave & 1, dt = (wave >> 1) & 1; const float cd = __builtin_amdgcn_exp2f(128.0f * lg);
#pragma unroll
                for (int r = 0; r < 16; ++r) sacc[r] *= cd;
#pragma unroll
                for (int s = 0; s < 8; ++s) {
                    const s16x4 x0 = ds_tr16(VT + trn + (16 * s) * VP + et * 64), x1 = ds_tr16(VT + trn + (16 * s + 4) * VP + et * 64), y0 = ds_tr16(KZ + trn + (16 * s) * VP + dt * 64), y1 = ds_tr16(KZ + trn + (16 * s + 4) * VP + dt * 64);
                    const bf16x8 fa = {x0[0], x0[1], x0[2], x0[3], x1[0], x1[1], x1[2], x1[3]}, fb = {y0[0], y0[1], y0[2], y0[3], y1[0], y1[1], y1[2], y1[3]};
                    sacc = __builtin_amdgcn_mfma_f32_32x32x16_bf16(fa, fb, sacc, 0, 0, 0); }
            }
            __syncthreads();
            if (wave < 4) {
                float s1 = 0.f;
#pragma unroll
                for (int r = 0; r < 16; ++r) s1 += a0[r] + a1[r];
                s1 = xhalf_sum(s1); const float mu = s1 * (1.0f / 64.0f); float s2 = 0.f;
#pragma unroll
                for (int r = 0; r < 16; ++r) { const float d0 = a0[r] - mu, d1 = a1[r] - mu; s2 += d0 * d0 + d1 * d1; }
                s2 = xhalf_sum(s2); const float rstd = __builtin_amdgcn_rsqf(s2 * (1.0f / 64.0f) + EPS);
#pragma unroll
                for (int t = 0; t < 2; ++t)
#pragma unroll
                    for (int g = 0; g < 4; ++g) { const int e0 = h * 64 + 32 * t + 8 * g + 4 * hi;
                        const u32x2 gr = *(const u32x2*)(RG + rowq * 256 + e0); const f32x4 gg = *(const f32x4*)(g_ret + e0);
                        const float gt[4] = {bf_lo(gr.x), bf_hi(gr.x), bf_lo(gr.y), bf_hi(gr.y)}; const float gn[4] = {gg.x, gg.y, gg.z, gg.w}; float y[4];
#pragma unroll
                        for (int i = 0; i < 4; ++i) { const float x = (t == 0 ? a0[4 * g + i] : a1[4 * g + i]); y[i] = (x - mu) * rstd * gn[i] * gt[i] / (1.0f + __expf(-gt[i])); }
                        u32x2 w; w.x = cvtpk(y[0], y[1]); w.y = cvtpk(y[2], y[3]); *(u32x2*)(Op + rowq * DM + 768 + e0) = w; }
            } else {
                const int et = wave & 1, dt = (wave >> 1) & 1;
#pragma unroll
                for (int g = 0; g < 4; ++g) { u32x2 w; w.x = cvtpk(sacc[4 * g], sacc[4 * g + 1]); w.y = cvtpk(sacc[4 * g + 2], sacc[4 * g + 3]);
                    *(LAS u32x2*)(RT + (32 * dt + l31) * VP + (32 * et + 8 * g + 4 * hi) * 2) = w; }
            }
        }
#undef RET_LOAD
        __syncthreads();
    }
}


template <int NR>
__device__ __forceinline__ void select_two(LAS const float* sc, LAS float* cand, LAS unsigned* ticket, int lane, int t0, int nkt, u64* bmrow0) {
    for (;;) {
        unsigned qv = 0u; if (lane == 0) qv = __hip_atomic_fetch_add(ticket, 1u, __ATOMIC_RELAXED, __HIP_MEMORY_SCOPE_WORKGROUP);
        const int q = __builtin_amdgcn_readfirstlane((int)qv);
        if (q >= 16) break;
        const int nk = t0 + q + 1; u64* bm = bmrow0 + (size_t)q * 32;
        f32x2s vp[NR / 2];
#pragma unroll
        for (int i = 0; i < NR; ++i) { float x = __builtin_nanf(""); if (2 * i < nkt) { x = sc[q * 2048 + i * 64 + lane]; if (2 * i + 1 >= nkt && lane >= 32) x = __builtin_nanf(""); }
            if (i & 1) vp[i >> 1].y = x; else vp[i >> 1].x = x; }
        select_row<NR>(vp, nk, bm, lane);
        if (NR < 32 && lane >= NR && lane < 32) { unsigned zz = 0u; asm volatile("" : "+v"(zz)); *(u32x2*)(bm + lane) = (u32x2){zz, zz}; }
    }
}
__device__ __forceinline__ void select_phase(LAS unsigned char* lds, const bf16* QI, const bf16* MS, const float* WI, u64* BM, const int wave_id) {
    const int tid = tid_here(), wave = wave_id, lane = tid & 63, l31 = lane & 31, hi = lane >> 5;
    LAS float* sc = (LAS float*)lds;
    const bool deal256 = (gridDim.x == 256); const int cblk = blockIdx.x;
    constexpr int NB = SEL_NB;
    const int nmine = deal256 ? (cblk < 128 ? NB : NB + 2 * (16 - NB)) : (M / 16 - cblk + (int)gridDim.x - 1) / (int)gridDim.x;
    for (int iu = 0; iu < nmine; ++iu) {
        int r, x;
        if (deal256) { if (iu < NB) { r = iu; x = cblk; } else { r = NB + ((iu - NB) >> 1); x = (cblk - 128) + 128 * ((iu - NB) & 1); } }
        else { const int v = cblk + iu * (int)gridDim.x; r = v >> 8; x = v & 255; }
        const int pr = (r < 7) ? r : (r < 14 ? r + 2 : r - 7);
        const int b = x >> 3, tb = pr * 8 + (x & 7), t0 = tb * 16; const size_t rowb = (size_t)b * SEQ;
        if (t0 < 256) {
            const int t = t0 + 2 * wave + (lane >> 5); u64* bm = BM + (rowb + t) * 32; const int k0 = 64 * l31;
            bm[l31] = (t >= k0 + 63) ? ~0ull : (t < k0 ? 0ull : ((1ull << (t - k0 + 1)) - 1ull));
            continue;
        }
        const int nkt = (t0 + 16 + 31) >> 5;
        if (tid == 0) *(LAS unsigned*)(lds + RING_BYTES + 512) = 0u;
        const int qloc = 2 * ((l31 >> 2) & 1) + (l31 >> 4), hd = 4 * ((l31 >> 3) & 1) + (l31 & 3);
        bf16x8 qa[4][2]; float wv[4][2][8];
#pragma unroll
        for (int qg = 0; qg < 4; ++qg) {
            const size_t rq = rowb + t0 + 4 * qg + qloc;
            qa[qg][0] = *(const bf16x8*)(QI + rq * 256 + hd * 32 + 8 * hi); qa[qg][1] = *(const bf16x8*)(QI + rq * 256 + hd * 32 + 16 + 8 * hi);
#pragma unroll
            for (int jq = 0; jq < 2; ++jq) { const float* wp = WI + (rowb + t0 + 4 * qg + 2 * hi + jq) * 8; const f32x4 wa = *(const f32x4*)wp, wb = *(const f32x4*)(wp + 4);
                wv[qg][jq][0] = wa.x; wv[qg][jq][1] = wa.y; wv[qg][jq][2] = wa.z; wv[qg][jq][3] = wa.w; wv[qg][jq][4] = wb.x; wv[qg][jq][5] = wb.y; wv[qg][jq][6] = wb.z; wv[qg][jq][7] = wb.w; }
        }
        const bf16* kp0 = MS + (rowb + l31) * 256 + 96 + 8 * hi;
        REP(7) {
        if (wave < nkt) {
        bf16x8 kb0 = *(const bf16x8*)(kp0 + (size_t)(32 * wave) * 256), kb1 = *(const bf16x8*)(kp0 + (size_t)(32 * wave) * 256 + 16);
        for (int kt = wave; kt < nkt; kt += 8) {
            const int ktn = (kt + 8 < nkt) ? kt + 8 : kt;
            const bf16x8 nb0 = *(const bf16x8*)(kp0 + (size_t)(32 * ktn) * 256), nb1 = *(const bf16x8*)(kp0 + (size_t)(32 * ktn) * 256 + 16);
#pragma unroll
            for (int qg = 0; qg < 4; ++qg) {
                f32x16 d;
#pragma unroll
                for (int r = 0; r < 16; ++r) d[r] = 0.f;
                d = __builtin_amdgcn_mfma_f32_32x32x16_bf16(qa[qg][0], kb0, d, 0, 0, 0); d = __builtin_amdgcn_mfma_f32_32x32x16_bf16(qa[qg][1], kb1, d, 0, 0, 0);
                float w0 = 0.f, w1 = 0.f;
#pragma unroll
                for (int i = 0; i < 8; ++i) { w0 += wv[qg][0][i] * fmaxf(d[i], 0.f); w1 += wv[qg][1][i] * fmaxf(d[8 + i], 0.f); }
                LAS float* o = sc + (4 * qg + 2 * hi) * 2048 + 32 * kt + l31;
                if (kt == nkt - 1) { const int tq0 = t0 + 4 * qg + 2 * hi, key = 32 * kt + l31; if (key > tq0) w0 = __builtin_nanf(""); if (key > tq0 + 1) w1 = __builtin_nanf(""); }
                o[0] = w0; o[2048] = w1;
            }
            kb0 = nb0; kb1 = nb1;
        }
        }
        }
        __syncthreads();
        u64* bmrow0 = BM + (rowb + t0) * 32;
        REP(8) {
        LAS float* cand = (LAS float*)(lds + RING_BYTES + 1024) + wave * 128; LAS unsigned* ticket = (LAS unsigned*)(lds + RING_BYTES + 512);
        if (t0 + 16 <= 512) select_two<8>(sc, cand, ticket, lane, t0, nkt, bmrow0);
        else if (t0 + 16 <= 1024) select_two<16>(sc, cand, ticket, lane, t0, nkt, bmrow0);
        else if (t0 + 16 <= 1536) select_two<24>(sc, cand, ticket, lane, t0, nkt, bmrow0);
        else select_two<32>(sc, cand, ticket, lane, t0, nkt, bmrow0);
        }
        __syncthreads();
    }
}

__device__ __forceinline__ void prologue(const Ptrs& P, LAS unsigned char* lds, const int wave_id) {
    const int tid = tid_here(), wave = wave_id, lane = tid & 63;
    LAS float* scr = (LAS float*)(lds + wave * 16384);
    const int gw = blockIdx.x * NWAVES + wave, NGW = gridDim.x * NWAVES;
    constexpr int I_IN = (DM / 64) * (NIN / 32), I_UQ = (768 / 64) * (768 / 32), I_UKV = (256 / 64) * (1024 / 32), I_OUT = (DM / 64) * (DM / 32), I_F1 = (DM / 64) * (FF / 32), I_F2 = (FF / 64) * (DM / 32);
    constexpr int I_L = I_IN + I_UQ + I_UKV + I_OUT + I_F1 + I_F2;
    for (int it = gw; it < DEPTH * I_L; it += NGW) {
        const int l = it / I_L; int r = it % I_L; unsigned char* wl = P.ws + WS_W + (size_t)l * WL_BYTES;
        if (r < I_IN) { transpose_item(P.w_in + (size_t)l * DM * IN_W, DM, IN_W, NIN, P.g_mix + l * DM, (bf16*)(wl + WL_IN), scr, r, lane, SrcIn()); continue; } r -= I_IN;
        if (r < I_UQ) { transpose_item(P.w_uq + (size_t)l * 768 * 768, 768, 768, 768, P.g_q + l * 768, (bf16*)(wl + WL_UQ), scr, r, lane, SrcUq()); continue; } r -= I_UQ;
        if (r < I_UKV) { transpose_item(P.w_ukv + (size_t)l * 256 * 1024, 256, 1024, 1024, P.g_kv + l * 256, (bf16*)(wl + WL_UKV), scr, r, lane, SrcUkv()); continue; } r -= I_UKV;
        if (r < I_OUT) { transpose_item(P.w_out + (size_t)l * DM * DM, DM, DM, DM, nullptr, (bf16*)(wl + WL_OUT), scr, r, lane, SrcId()); continue; } r -= I_OUT;
        if (r < I_F1) { transpose_item(P.w_ff1 + (size_t)l * DM * FF, DM, FF, FF, P.g_mlp + l * DM, (bf16*)(wl + WL_F1), scr, r, lane, SrcId()); continue; } r -= I_F1;
        transpose_item(P.w_ff2 + (size_t)l * FF * DM, FF, DM, DM, nullptr, (bf16*)(wl + WL_F2), scr, r, lane, SrcId());
    }
    bf16* xb = (bf16*)(P.ws + WS_XB); float* ssqx = (float*)(P.ws + WS_SSQX);
    for (int m0 = gw * 4; m0 < M; m0 += NGW * 4) {
        f32x4 v[4][4];
#pragma unroll
        for (int r = 0; r < 4; ++r) { const f32x4* xr = (const f32x4*)(P.x + (size_t)(m0 + r) * DM) + lane;
#pragma unroll
            for (int j = 0; j < 4; ++j) v[r][j] = xr[64 * j]; }
#pragma unroll
        for (int r = 0; r < 4; ++r) {
            float s = 0.f;
#pragma unroll
            for (int j = 0; j < 4; ++j) s += (v[r][j].x * v[r][j].x + v[r][j].y * v[r][j].y) + (v[r][j].z * v[r][j].z + v[r][j].w * v[r][j].w);
            s = wave_sum_f(s);
            u32x2* o8 = (u32x2*)(xb + (size_t)(m0 + r) * DM) + lane;
#pragma unroll
            for (int j = 0; j < 4; ++j) { u32x2 w; w.x = cvtpk(v[r][j].x, v[r][j].y); w.y = cvtpk(v[r][j].z, v[r][j].w); o8[64 * j] = w; }
            if (lane < 16) ssqx[(size_t)(m0 + r) * 16 + lane] = (lane == 0) ? s : 0.f;
        }
    }
}
__device__ __forceinline__ void final_norm(const Ptrs& P, const int wave_id) {
    const int tid = tid_here(), wave = wave_id, lane = tid & 63;
    const int gw = blockIdx.x * NWAVES + wave, NGW = gridDim.x * NWAVES;
    const float* ssqx = (const float*)(P.ws + WS_SSQX); const bf16* xb = (const bf16*)(P.ws + WS_XB);
    const f32x4* g = (const f32x4*)P.g_final + 2 * lane;
    const f32x4 g00 = g[0], g01 = g[1], g10 = g[128], g11 = g[129];
    for (int m0 = gw * 4; m0 < M; m0 += NGW * 4) {
        u32x4 xv[4][2]; float ss[4];
#pragma unroll
        for (int r = 0; r < 4; ++r) { const u32x4* xr = (const u32x4*)(xb + (size_t)(m0 + r) * DM) + lane; xv[r][0] = xr[0]; xv[r][1] = xr[64];
            const float* sp = ssqx + (size_t)(m0 + r) * 16; ss[r] = (lane < 16) ? sp[lane] : 0.f; }
#pragma unroll
        for (int r = 0; r < 4; ++r) {
            const float rs = __builtin_amdgcn_rsqf(wave_sum_f(ss[r]) * (1.0f / DM) + EPS);
            f32x4* orow = (f32x4*)(P.out + (size_t)(m0 + r) * DM) + 2 * lane;
            float a[8], b[8]; unpack8(xv[r][0], a); unpack8(xv[r][1], b);
            orow[0] = (f32x4){a[0] * rs * g00.x, a[1] * rs * g00.y, a[2] * rs * g00.z, a[3] * rs * g00.w}; orow[1] = (f32x4){a[4] * rs * g01.x, a[5] * rs * g01.y, a[6] * rs * g01.z, a[7] * rs * g01.w};
            orow[128] = (f32x4){b[0] * rs * g10.x, b[1] * rs * g10.y, b[2] * rs * g10.z, b[3] * rs * g10.w}; orow[129] = (f32x4){b[4] * rs * g11.x, b[5] * rs * g11.y, b[6] * rs * g11.z, b[7] * rs * g11.w};
        }
    }
}

constexpr int PH_PER_LAYER = 6, N_PHASES = 2 + DEPTH * PH_PER_LAYER;

__global__ void __launch_bounds__(NTHREADS, 2) fwd(Args args) {
    extern __shared__ __attribute__((aligned(16))) unsigned char lds_raw[];
    LAS unsigned char* lds = (LAS unsigned char*)lds_raw;
    const Ptrs& P = args.p;
    const int wave_id = __builtin_amdgcn_readfirstlane((int)threadIdx.x >> 6);
    const int tid = tid_here();
    for (int u = tid; u < (LDS_BYTES - RING_BYTES) / 4; u += NTHREADS) ((LAS unsigned*)(lds + RING_BYTES))[u] = 0u;
    __syncthreads();
    unsigned char* const ws0 = P.ws;
    XcdBarrier bar; bar.bar = (unsigned*)(ws0 + WS_CTL) + CW_BAR; bar.x = 0; bar.st = nullptr;
#if MK_N_LAUNCHES == 1
    bar = xcd_barrier_post((unsigned*)(ws0 + WS_CTL) + CW_BAR, (volatile LAS unsigned*)(lds + MISC_OFF) + 8);
#define GRID_BAR() xcd_barrier(bar)
#else
#define GRID_BAR() do { } while (0)
#endif
    const int lo = args.ph_lo, hi = args.ph_hi;
#define IN(k) (lo <= (k) && (k) < hi)
#define LAUNDER_WS() size_t zo_ = 0; asm volatile("" : "+s"(zo_)); unsigned char* const ws = ws0 + zo_
#define SEAM(k) do { if (IN(k) && IN((k) + 1)) { REP(10) GRID_BAR(); } } while (0)
    const int G = gridDim.x, c = blockIdx.x;

#define XB ((bf16*)(ws + WS_XB))
#define SSQX ((float*)(ws + WS_SSQX))
#define SSQL ((float*)(ws + WS_SSQL))
#define SSQ2 ((float*)(ws + WS_SSQ2))
#define WI ((float*)(ws + WS_WI))
#define CQ ((bf16*)(ws + WS_CQ))
#define CKV ((bf16*)(ws + WS_CKV))
#define AQ ((bf16*)(ws + WS_AQ))
#define RQ ((bf16*)(ws + WS_RQ))
#define RK ((bf16*)(ws + WS_RK))
#define QI ((bf16*)(ws + WS_QI))
#define MS ((bf16*)(ws + WS_MS))
#define RV ((bf16*)(ws + WS_RV))
#define RG ((bf16*)(ws + WS_RG))
#define Q ((bf16*)(ws + WS_Q))
#define KN ((bf16*)(ws + WS_KN))
#define V ((bf16*)(ws + WS_V))
#define O ((bf16*)(ws + WS_O))
#define H ((bf16*)(ws + WS_H))
#define BM ((u64*)(ws + WS_BM))
    if (IN(0)) { REP(9) prologue(P, lds, wave_id); } SEAM(0);

    for (int l = 0; l < DEPTH; ++l) {
        const int pb = 1 + l * PH_PER_LAYER;
        if (IN(pb + 0)) {
            LAUNDER_WS(); unsigned char* wl = ws + WS_W + (size_t)l * WL_BYTES; (void)wl;
            pg8::Gemm g{XB, (const bf16*)(wl + WL_IN), M, NIN, DM}; pg8::StaticOrder S; S.init(M, NIN, G, c);
            KL_RUN(0, FIn, ws);
        } SEAM(pb + 0);
        if (IN(pb + 1)) {
            { LAUNDER_WS(); unsigned char* wl = ws + WS_W + (size_t)l * WL_BYTES; pg8::Gemm g{CQ, (const bf16*)(wl + WL_UQ), M, 768, 768}; pg8::StaticOrder S; S.init(M, 768, G, c); KL_RUN(1, FUq, SSQL, Q); }
            { LAUNDER_WS(); unsigned char* wl = ws + WS_W + (size_t)l * WL_BYTES; pg8::Gemm g{CKV, (const bf16*)(wl + WL_UKV), M, 1024, 256}; pg8::StaticOrder S; S.init(M, 1024, G, c); KL_RUN(2, FUkv, SSQL, KN); }
            { LAUNDER_WS(); REP(2) select_phase(lds, QI, MS, WI, BM, wave_id); }
            __syncthreads();
            { LAUNDER_WS(); const float* gr = P.g_ret + l * 256 + zo_; REP(3) ret_phase(lds, RQ, RK, RV, RG, gr, O, wave_id); }
        } SEAM(pb + 1);
        if (IN(pb + 2)) {
            LAUNDER_WS(); unsigned char* wl = ws + WS_W + (size_t)l * WL_BYTES; (void)wl;
            REP(4) attn_phase<true>(lds, Q, KN, MS, V, nullptr, O, wave_id);
            REP(5) attn_phase<false>(lds, AQ, nullptr, MS, nullptr, BM, O, wave_id);
        } SEAM(pb + 2);
        if (IN(pb + 3)) {
            LAUNDER_WS(); unsigned char* wl = ws + WS_W + (size_t)l * WL_BYTES; (void)wl;
            pg8::Gemm g{O, (const bf16*)(wl + WL_OUT), M, DM, DM}; pg8::StaticOrder S; S.init(M, DM, G, c);
            KL_RUN(3, FRes<false>, XB, nullptr, SSQ2);
        } SEAM(pb + 3);
        if (IN(pb + 4)) {
            LAUNDER_WS(); unsigned char* wl = ws + WS_W + (size_t)l * WL_BYTES; (void)wl;
            pg8::Gemm g{XB, (const bf16*)(wl + WL_F1), M, FF, DM}; pg8::StaticOrder S; S.init(M, FF, G, c);
            KL_RUN(4, FFf1, H);
        } SEAM(pb + 4);
        if (IN(pb + 5)) {
            LAUNDER_WS(); unsigned char* wl = ws + WS_W + (size_t)l * WL_BYTES; (void)wl;
            pg8::Gemm g{H, (const bf16*)(wl + WL_F2), M, DM, FF}; pg8::StaticOrder S; S.init(M, DM, G, c);
            KL_RUN(5, FRes<true>, XB, SSQ2, SSQX);
        } SEAM(pb + 5);
    }
    if (IN(N_PHASES - 1)) final_norm(P, wave_id);
#undef IN
#undef SEAM
}
}

extern "C" void kernel_launch(void* const* d_in, const int* in_sizes, int n_in, void* d_out, int out_size, void* d_ws, size_t ws_size, hipStream_t stream) {
    using namespace mk;
    static int grid = 0;
    if (grid == 0) {
        if (n_in != 13 || in_sizes[0] != M * DM || out_size != M * DM || ws_size < WS_END || ws_size < WS_H + 512 * MiB) {
            fprintf(stderr, "kernel_launch: unexpected shapes (n_in %d, in0 %d, out %d, ws %zu); nothing launched\n", n_in, n_in > 0 ? in_sizes[0] : -1, out_size, ws_size); grid = -1; return; }
        int dev = 0, cus = 0, per_cu = 0;
        if (hipGetDevice(&dev) != hipSuccess || hipDeviceGetAttribute(&cus, hipDeviceAttributeMultiprocessorCount, dev) != hipSuccess) { grid = -1; return; }
        if (hipFuncSetAttribute((const void*)fwd, hipFuncAttributeMaxDynamicSharedMemorySize, LDS_BYTES) != hipSuccess) { fprintf(stderr, "kernel_launch: hipFuncSetAttribute failed\n"); grid = -1; return; }
        if (hipOccupancyMaxActiveBlocksPerMultiprocessor(&per_cu, (const void*)fwd, NTHREADS, LDS_BYTES) != hipSuccess || per_cu < 1) { fprintf(stderr, "kernel_launch: occupancy query says %d\n", per_cu); }
        (void)hipGetLastError();
        grid = cus;
    }
    if (grid < 0) return;
    if (hipMemsetAsync((char*)d_ws + WS_CTL, 0, CTL_ZERO_BYTES, stream) != hipSuccess) return;
    Args a{};
    a.p.x = (const float*)d_in[0]; a.p.g_mix = (const float*)d_in[1]; a.p.w_in = (const float*)d_in[2]; a.p.g_q = (const float*)d_in[3]; a.p.w_uq = (const float*)d_in[4];
    a.p.g_kv = (const float*)d_in[5]; a.p.w_ukv = (const float*)d_in[6]; a.p.g_ret = (const float*)d_in[7]; a.p.w_out = (const float*)d_in[8]; a.p.g_mlp = (const float*)d_in[9];
    a.p.w_ff1 = (const float*)d_in[10]; a.p.w_ff2 = (const float*)d_in[11]; a.p.g_final = (const float*)d_in[12];
    a.p.out = (float*)d_out; a.p.ws = (unsigned char*)d_ws;
#if MK_N_LAUNCHES == 1
    a.ph_lo = 0; a.ph_hi = N_PHASES;
    hipLaunchKernelGGL(fwd, dim3(grid), dim3(NTHREADS), LDS_BYTES, stream, a);
#else
    for (int ph = 0; ph < N_PHASES; ++ph) { a.ph_lo = ph; a.ph_hi = ph + 1; hipLaunchKernelGGL(fwd, dim3(grid), dim3(NTHREADS), LDS_BYTES, stream, a); }
#endif
}
```

```cpp
#include <hip/hip_runtime.h>
#include <cstdio>
#include <cstdint>
namespace pg8 {
#define PG8_LAS __attribute__((address_space(3)))
typedef unsigned short bf16_t;
typedef short bf16x8 __attribute__((ext_vector_type(8)));
typedef float f32x4 __attribute__((ext_vector_type(4)));
typedef unsigned u32x4 __attribute__((ext_vector_type(4)));
constexpr int BM = 256, BK = 64, HALF = 128, HTB = HALF * BK * 2  , STAGE_BYTES = 8 * HTB, NXCD = 8, WGM = 8;

__host__ __device__ __forceinline__ int lds_byte(int r, int c) { const int st = (r >> 4) * 2 + (c >> 5), rr = r & 15, cc = c & 31, ob = rr * 64 + cc * 2; return st * 1024 + (ob ^ (((ob >> 9) & 1) << 5)); }
__host__ __device__ __forceinline__ void stage_rc(int b, int& R, int& C) { const int st = b / 1024, sb = b % 1024, swz = sb ^ (((sb >> 9) & 1) << 5); R = (st >> 1) * 16 + swz / 64; C = (st & 1) * 32 + (swz % 64) / 2; }
__host__ __device__ __forceinline__ int perm32(int rho) { const int n = rho >> 4, i = rho & 15; return 8 * (i >> 2) + 4 * n + (i & 3); }

struct Unit { int pm, pn; };
struct Gemm { const bf16_t* A; const bf16_t* Bt; int M, N, K; };

struct StaticOrder {
    int nM, nN, nwg, G, c;
    __host__ __device__ void init(int M, int N, int G_, int c_) { nM = M / BM; nN = N / BM; nwg = nM * nN; G = G_; c = c_; }
    __host__ __device__ bool next(int i, Unit& u) const {
        const long L = (long)i * G + c; if (L >= nwg) return false;
        int wgid = (int)L; { const int q = nwg / NXCD, r = nwg % NXCD, xcd = wgid % NXCD, off = wgid / NXCD; wgid = (xcd < r ? xcd * (q + 1) : r * (q + 1) + (xcd - r) * q) + off; }
        const int nig = WGM * nN, gid = wgid / nig, fm = gid * WGM, gsz = (nM - fm) < WGM ? (nM - fm) : WGM;
        u.pm = fm + ((wgid % nig) % gsz); u.pn = (wgid % nig) / gsz; return true;
    }
    __device__ __forceinline__ void a_ready(const Unit&) const {}
    __device__ __forceinline__ void done(const Unit&) const {}
};

__device__ __forceinline__ unsigned cvt_pk_bf16(float lo, float hi) { unsigned r; asm volatile("v_cvt_pk_bf16_f32 %0, %1, %2" : "=v"(r) : "v"(lo), "v"(hi)); return r; }
typedef float f32x2 __attribute__((ext_vector_type(2)));

template <class Epi, class Sched, bool ALIGN_EPI = false, bool SP2 = false>
__device__ __forceinline__ void gemm_phase(PG8_LAS unsigned char* lds, const Gemm g, const Sched& S, const Epi& E, const int wid_in) {
    int lane_l; asm volatile("v_mbcnt_lo_u32_b32 %0, -1, 0\n\tv_mbcnt_hi_u32_b32 %0, -1, %0" : "=v"(lane_l));
    int wid_l = wid_in; asm volatile("" : "+s"(wid_l));
    const int wid = wid_l, lane = lane_l, tid = wid * 64 + lane, wr = wid >> 2, wc = wid & 3, fr = lane & 15, fq = lane >> 4;
    const int K = g.K, nt = K / BK;
    unsigned voffA[2], voffB[2];
#pragma unroll
    for (int i = 0; i < 2; ++i) { int R, C; stage_rc(tid * 16 + i * 8192, R, C); const int Rb = Epi::PERM ? ((R & ~31) + perm32(R & 31)) : R;
        voffA[i] = (unsigned)(R * K + C) * 2u; voffB[i] = (unsigned)(Rb * K + C) * 2u; }
    const size_t kstep = (size_t)(BK * 2);
    const size_t hstep = (size_t)HALF * K * 2;
    const size_t tstep = 2 * hstep;
    const unsigned ldsw = (unsigned)wid * 1024u;
    const int aoff = lds_byte(wr * 64 + fr, fq * 8), boff = lds_byte(wc * 32 + fr, fq * 8);
#define PG8_SA(b, h) (((b) * 2 + (h)) * HTB)
#define PG8_SB(b, h) ((4 + (b) * 2 + (h)) * HTB)
#define PG8_STAGE(bufoff, gbase, voff) do { _Pragma("unroll") for (int _i = 0; _i < 2; ++_i) \
        __builtin_amdgcn_global_load_lds((const unsigned*)((const char*)(gbase) + (voff)[_i]), (PG8_LAS unsigned*)(lds + (bufoff) + ldsw + _i * 8192), 16, 0, 0); } while (0)
#define PG8_LDA(dst, b, h) do { _Pragma("unroll") for (int m = 0; m < 4; ++m) _Pragma("unroll") for (int k = 0; k < 2; ++k) dst[m][k] = *(const PG8_LAS bf16x8*)(lds + PG8_SA(b, h) + aoff + m * 2048 + k * 1024); } while (0)
#define PG8_LDB(dst, b, h) do { _Pragma("unroll") for (int n = 0; n < 2; ++n) _Pragma("unroll") for (int k = 0; k < 2; ++k) dst[n][k] = *(const PG8_LAS bf16x8*)(lds + PG8_SB(b, h) + boff + n * 2048 + k * 1024); } while (0)
#define PG8_MMA(ai, bj, At, Bt) do { __builtin_amdgcn_s_setprio(1); _Pragma("unroll") for (int m = 0; m < 4; ++m) _Pragma("unroll") for (int n = 0; n < 2; ++n) _Pragma("unroll") for (int k = 0; k < 2; ++k) \
        acc[ai][bj][m][n] = __builtin_amdgcn_mfma_f32_16x16x32_bf16(Bt[n][k], At[m][k], acc[ai][bj][m][n], 0, 0, 0); __builtin_amdgcn_s_setprio(0); } while (0)
#define PG8_WAIT_V(n) asm volatile("s_waitcnt vmcnt(" #n ")" ::: "memory")
#define PG8_WAIT_L(n) asm volatile("s_waitcnt lgkmcnt(" #n ")" ::: "memory")
#define PG8_BAR __builtin_amdgcn_s_barrier()
#define PG8_SCHED __builtin_amdgcn_sched_barrier(0)
    Unit cur, nxt; int ui = 0;
    if (!S.next(0, cur)) return;
    f32x4 acc[2][2][4][2];
#pragma unroll
    for (int a = 0; a < 2; ++a)
#pragma unroll
        for (int b = 0; b < 2; ++b)
#pragma unroll
            for (int m = 0; m < 4; ++m)
#pragma unroll
                for (int n = 0; n < 2; ++n) acc[a][b][m][n] = (f32x4){0.f, 0.f, 0.f, 0.f};
    bf16x8 At[4][2], B0[2][2], B1[2][2];
    const char* cA = (const char*)g.A + (size_t)cur.pm * tstep; const char* cB = (const char*)g.Bt + (size_t)cur.pn * tstep;
    S.a_ready(cur);
    if constexpr (SP2) {
        PG8_STAGE(PG8_SB(0, 0), cB, voffB); PG8_STAGE(PG8_SB(0, 1), cB + hstep, voffB); PG8_STAGE(PG8_SA(0, 0), cA, voffA); PG8_STAGE(PG8_SA(0, 1), cA + hstep, voffA);
        if (wr == 1) PG8_BAR;
        PG8_WAIT_V(2); PG8_BAR;
        PG8_STAGE(PG8_SB(1, 0), cB + kstep, voffB); PG8_STAGE(PG8_SA(1, 0), cA + kstep, voffA); PG8_STAGE(PG8_SB(1, 1), cB + hstep + kstep, voffB);
        PG8_WAIT_V(6); PG8_BAR;
    } else {
        PG8_STAGE(PG8_SB(0, 0), cB, voffB); PG8_STAGE(PG8_SA(0, 0), cA, voffA); PG8_STAGE(PG8_SB(0, 1), cB + hstep, voffB); PG8_STAGE(PG8_SA(0, 1), cA + hstep, voffA);
        if (wr == 1) PG8_BAR;
        PG8_WAIT_V(4); PG8_BAR;
        PG8_STAGE(PG8_SB(1, 0), cB + kstep, voffB); PG8_STAGE(PG8_SA(1, 0), cA + kstep, voffA); PG8_STAGE(PG8_SB(1, 1), cB + hstep + kstep, voffB);
        PG8_WAIT_V(6); PG8_BAR;
    }
    for (;;) {
        const bool has_next = S.next(ui + 1, nxt);
        const char* nA = has_next ? (const char*)g.A + (size_t)nxt.pm * tstep : cA; const char* nB = has_next ? (const char*)g.Bt + (size_t)nxt.pn * tstep : cB;
        for (int t = 0; t < nt; t += 2) {
            const bool last = (t == nt - 2);
            const char* a1 = cA + (size_t)(t + 1) * kstep;
            const char* a2 = last ? nA : cA + (size_t)(t + 2) * kstep; const char* b2 = last ? nB : cB + (size_t)(t + 2) * kstep;
            const char* a3 = a2 + kstep; const char* b3 = b2 + kstep;
            if (last && has_next) S.a_ready(nxt);
            if (last) E.stage_aux(cur, lds, wid, lane);
            if constexpr (SP2) {
            PG8_LDB(B0, 0, 0); PG8_LDB(B1, 0, 1); PG8_SCHED; PG8_LDA(At, 0, 0); PG8_STAGE(PG8_SA(1, 1), a1 + hstep, voffA);
            PG8_WAIT_V(8); PG8_WAIT_L(0); PG8_BAR; PG8_MMA(0, 0, At, B0); PG8_MMA(0, 1, At, B1); PG8_BAR; PG8_SCHED;
            PG8_LDA(At, 0, 1); PG8_STAGE(PG8_SB(0, 0), b2, voffB); PG8_STAGE(PG8_SB(0, 1), b2 + hstep, voffB); PG8_STAGE(PG8_SA(0, 0), a2, voffA);
            PG8_WAIT_V(8); PG8_WAIT_L(0); PG8_BAR; PG8_MMA(1, 0, At, B0); PG8_MMA(1, 1, At, B1); PG8_BAR; PG8_SCHED;
            PG8_LDB(B0, 1, 0); PG8_LDB(B1, 1, 1); PG8_SCHED; PG8_LDA(At, 1, 0); PG8_STAGE(PG8_SA(0, 1), a2 + hstep, voffA);
            PG8_WAIT_V(8); PG8_WAIT_L(0); PG8_BAR; PG8_MMA(0, 0, At, B0); PG8_MMA(0, 1, At, B1); PG8_BAR; PG8_SCHED;
            PG8_LDA(At, 1, 1); PG8_STAGE(PG8_SB(1, 0), b3, voffB); PG8_STAGE(PG8_SB(1, 1), b3 + hstep, voffB); PG8_STAGE(PG8_SA(1, 0), a3, voffA);
            PG8_WAIT_V(8); PG8_WAIT_L(0); PG8_BAR; PG8_MMA(1, 0, At, B0); PG8_MMA(1, 1, At, B1); PG8_BAR; PG8_SCHED;
            } else {
            PG8_LDB(B0, 0, 0); PG8_SCHED; PG8_LDA(At, 0, 0); PG8_STAGE(PG8_SA(1, 1), a1 + hstep, voffA);
            PG8_WAIT_L(8); PG8_BAR; PG8_WAIT_L(0); PG8_MMA(0, 0, At, B0); PG8_BAR; PG8_SCHED;
            PG8_LDB(B1, 0, 1); PG8_STAGE(PG8_SB(0, 0), b2, voffB);
            PG8_BAR; PG8_WAIT_L(0); PG8_MMA(0, 1, At, B1); PG8_BAR;
            PG8_LDA(At, 0, 1); PG8_STAGE(PG8_SA(0, 0), a2, voffA);
            PG8_BAR; PG8_WAIT_L(0); PG8_MMA(1, 0, At, B0); PG8_BAR; PG8_SCHED;
            PG8_STAGE(PG8_SB(0, 1), b2 + hstep, voffB);
            PG8_WAIT_V(6); PG8_BAR; PG8_MMA(1, 1, At, B1); PG8_BAR;
            PG8_LDB(B0, 1, 0); PG8_SCHED; PG8_LDA(At, 1, 0); PG8_STAGE(PG8_SA(0, 1), a2 + hstep, voffA);
            PG8_WAIT_L(8); PG8_BAR; PG8_WAIT_L(0); PG8_MMA(0, 0, At, B0); PG8_BAR; PG8_SCHED;
            PG8_LDB(B1, 1, 1); PG8_STAGE(PG8_SB(1, 0), b3, voffB);
            PG8_BAR; PG8_WAIT_L(0); PG8_MMA(0, 1, At, B1); PG8_BAR;
            PG8_LDA(At, 1, 1); PG8_STAGE(PG8_SA(1, 0), a3, voffA);
            PG8_BAR; PG8_WAIT_L(0); PG8_MMA(1, 0, At, B0); PG8_BAR; PG8_SCHED;
            PG8_STAGE(PG8_SB(1, 1), b3 + hstep, voffB);
            PG8_WAIT_V(6); PG8_BAR; PG8_MMA(1, 1, At, B1); PG8_BAR;
            }
        }
        if constexpr (ALIGN_EPI) { if (wr == 0) PG8_BAR; }
        if constexpr (!Epi::AFTER_DRAIN) { E(acc, cur, wr, wc, fr, fq); S.done(cur); }
        if (!has_next) break;
#pragma unroll
        for (int a = 0; a < 2; ++a)
#pragma unroll
            for (int b = 0; b < 2; ++b)
#pragma unroll
                for (int m = 0; m < 4; ++m)
#pragma unroll
                    for (int n = 0; n < 2; ++n) acc[a][b][m][n] = (f32x4){0.f, 0.f, 0.f, 0.f};
        cur = nxt; cA = nA; cB = nB; ++ui;
        if constexpr (ALIGN_EPI) { if (wr == 1) PG8_BAR; }
    }
    PG8_WAIT_V(0);
    if constexpr (!ALIGN_EPI) { if (wr == 0) PG8_BAR; }
    PG8_BAR;
    if constexpr (Epi::AFTER_DRAIN) { E.fused(acc, cur, wr, wc, fr, fq, lds, wid, lane); S.done(cur); }
#undef PG8_SA
#undef PG8_SB
#undef PG8_STAGE
#undef PG8_LDA
#undef PG8_LDB
#undef PG8_MMA
#undef PG8_WAIT_V
#undef PG8_WAIT_L
#undef PG8_BAR
#undef PG8_SCHED
}
}

#ifndef MK_N_LAUNCHES
#define MK_N_LAUNCHES 1
#endif
#ifndef PROBE_REP
#define PROBE_REP 0
#endif
#define REP(bit) for (int rep_ = 0; rep_ < ((PROBE_REP >> (bit)) & 1) + 1; ++rep_)
#ifndef PROBE_KL
#define PROBE_KL 0
#endif
#ifndef SEL_NB
#define SEL_NB 13
#endif
#ifndef ATT_FUSE_SM
#define ATT_FUSE_SM 2
#endif
#ifndef ATT_SPLIT
#define ATT_SPLIT 1
#endif
#ifndef ATT_NQR
#define ATT_NQR 2
#endif
#ifndef EPI_LDS_AUX
#define EPI_LDS_AUX 1
#endif
#ifndef RES_BATCH
#define RES_BATCH 4
#endif
#ifndef MK_NAIVE_GEMM
#define MK_NAIVE_GEMM 0
#endif

namespace mk {
#define GAS __attribute__((address_space(1)))
#define LAS __attribute__((address_space(3)))
typedef unsigned short bf16;
typedef float f32x4 __attribute__((ext_vector_type(4)));
typedef float f32x2 __attribute__((ext_vector_type(2)));
typedef unsigned u32x4 __attribute__((ext_vector_type(4)));
typedef unsigned u32x2 __attribute__((ext_vector_type(2)));
typedef __bf16 bf16x2_t __attribute__((ext_vector_type(2)));
typedef unsigned long long u64;

constexpr int BATCH = 32, SEQ = 2048, DM = 1024, DEPTH = 2, M = BATCH * SEQ, FF = 4096;
constexpr int NIN = 2816;
constexpr int IN_W = 2760;
constexpr float EPS = 1e-6f;
constexpr float LOG2E = 1.4426950408889634f;
constexpr int NWAVES = 8, NTHREADS = 512;

constexpr size_t MiB = 1u << 20;
constexpr size_t WS_CTL = 0, CTL_ZERO_BYTES = 1 * MiB;
constexpr size_t W_IN_B = (size_t)NIN * DM * 2, W_UQ_B = 768 * 768 * 2, W_UKV_B = 1024 * 256 * 2, W_OUT_B = 1024 * 1024 * 2, W_F1_B = (size_t)FF * DM * 2, W_F2_B = (size_t)DM * FF * 2;
constexpr size_t WL_IN = 0, WL_UQ = WL_IN + W_IN_B, WL_UKV = WL_UQ + W_UQ_B, WL_OUT = WL_UKV + W_UKV_B, WL_F1 = WL_OUT + W_OUT_B, WL_F2 = WL_F1 + W_F1_B, WL_BYTES = WL_F2 + W_F2_B;
constexpr size_t WS_W = 1 * MiB;
constexpr size_t WS_SSQX = 55 * MiB, WS_SSQL = 59 * MiB;
constexpr size_t WS_WI = 63 * MiB;
constexpr size_t WS_SSQ2 = 66 * MiB;
constexpr size_t WS_XB = 70 * MiB;
constexpr size_t WS_BIG = 198 * MiB;
constexpr size_t WS_CQ = WS_BIG, WS_CKV = WS_CQ + 96 * MiB, WS_AQ = WS_CKV + 32 * MiB, WS_RQ = WS_AQ + 32 * MiB, WS_RK = WS_RQ + 32 * MiB, WS_QI = WS_RK + 32 * MiB,
                 WS_MS = WS_QI + 32 * MiB, WS_RV = WS_MS + 32 * MiB, WS_RG = WS_RV + 32 * MiB, WS_Q = WS_RG + 32 * MiB, WS_KN = WS_Q + 96 * MiB, WS_V = WS_KN + 64 * MiB,
                 WS_BM = WS_V + 64 * MiB, WS_O = WS_BM + 16 * MiB, WS_END = WS_O + 128 * MiB;
constexpr size_t WS_H = WS_BIG;
static_assert(WS_W + 2 * WL_BYTES <= WS_SSQX && WS_END <= 1024 * MiB && WS_H + 512 * MiB <= 1024 * MiB, "d_ws map");
constexpr int CW_BAR = 4096;

constexpr int RING_BYTES = 131072, MISC_OFF = RING_BYTES + 320, LDS_BYTES = 147456;

__device__ __forceinline__ unsigned cvtpk(float lo, float hi) { f32x2 v = {lo, hi}; bf16x2_t b = __builtin_convertvector(v, bf16x2_t); return __builtin_bit_cast(unsigned, b); }
__device__ __forceinline__ float relu_i(float x) { const int b = __float_as_int(x); return __int_as_float(b > 0 ? b : 0); }
__device__ __forceinline__ float bf_lo(unsigned u) { return __uint_as_float(u << 16); }
__device__ __forceinline__ float bf_hi(unsigned u) { return __uint_as_float(u & 0xffff0000u); }
__device__ __forceinline__ void unpack8(const u32x4 r, float* f) { f[0] = bf_lo(r.x); f[1] = bf_hi(r.x); f[2] = bf_lo(r.y); f[3] = bf_hi(r.y); f[4] = bf_lo(r.z); f[5] = bf_hi(r.z); f[6] = bf_lo(r.w); f[7] = bf_hi(r.w); }
__device__ __forceinline__ void st8(bf16* dst, const float* v) { u32x4 w; w.x = cvtpk(v[0], v[1]); w.y = cvtpk(v[2], v[3]); w.z = cvtpk(v[4], v[5]); w.w = cvtpk(v[6], v[7]); *(u32x4*)dst = w; }
__device__ __forceinline__ void st8nt(bf16* dst, const float* v) { u32x4 w; w.x = cvtpk(v[0], v[1]); w.y = cvtpk(v[2], v[3]); w.z = cvtpk(v[4], v[5]); w.w = cvtpk(v[6], v[7]); __builtin_nontemporal_store(w, (u32x4*)dst); }
__device__ __forceinline__ void st8f(float* dst, const float* v) { *(f32x4*)dst = (f32x4){v[0], v[1], v[2], v[3]}; *(f32x4*)(dst + 4) = (f32x4){v[4], v[5], v[6], v[7]}; }
__device__ __forceinline__ float sum16(const float* p) { const f32x4 a = *(const f32x4*)p, b = *(const f32x4*)(p + 4), c = *(const f32x4*)(p + 8), d = *(const f32x4*)(p + 12);
    return (((a.x + a.y) + (a.z + a.w)) + ((b.x + b.y) + (b.z + b.w))) + (((c.x + c.y) + (c.z + c.w)) + ((d.x + d.y) + (d.z + d.w))); }
__device__ __forceinline__ float wave_sum(float v) {
#pragma unroll
    for (int o = 1; o < 64; o <<= 1) v += __shfl_xor(v, o);
    return v; }
__device__ __forceinline__ float wave_max(float v) {
#pragma unroll
    for (int o = 1; o < 64; o <<= 1) v = fmaxf(v, __shfl_xor(v, o));
    return v; }
__device__ __forceinline__ float wave_min(float v) {
#pragma unroll
    for (int o = 1; o < 64; o <<= 1) v = fminf(v, __shfl_xor(v, o));
    return v; }

__device__ __forceinline__ float xhalf_sum(float a) { const auto rr = __builtin_amdgcn_permlane32_swap(__float_as_uint(a), __float_as_uint(a), false, false); return __uint_as_float(rr[0]) + __uint_as_float(rr[1]); }
__device__ __forceinline__ float xrow16_sum(float x) { const auto s_ = __builtin_amdgcn_permlane16_swap(__float_as_uint(x), __float_as_uint(x), false, false); x = __uint_as_float(s_[0]) + __uint_as_float(s_[1]);
    const auto t_ = __builtin_amdgcn_permlane32_swap(__float_as_uint(x), __float_as_uint(x), false, false); return __uint_as_float(t_[0]) + __uint_as_float(t_[1]); }
__device__ __forceinline__ float xhalf_max(float a) { const auto rr = __builtin_amdgcn_permlane32_swap(__float_as_uint(a), __float_as_uint(a), false, false); return fmaxf(__uint_as_float(rr[0]), __uint_as_float(rr[1])); }
#define DPP_I(x, ctrl) __builtin_amdgcn_update_dpp(0, (x), (ctrl), 0xf, 0xf, false)
__device__ __forceinline__ int wave_sum_i(int x) {
    x += DPP_I(x, 0xB1); x += DPP_I(x, 0x4E); x += DPP_I(x, 0x141); x += DPP_I(x, 0x140);
    return __builtin_amdgcn_readlane(x, 0) + __builtin_amdgcn_readlane(x, 16) + __builtin_amdgcn_readlane(x, 32) + __builtin_amdgcn_readlane(x, 48); }
__device__ __forceinline__ float wave_max_f(float x) {
    x = fmaxf(x, __int_as_float(DPP_I(__float_as_int(x), 0xB1))); x = fmaxf(x, __int_as_float(DPP_I(__float_as_int(x), 0x4E))); x = fmaxf(x, __int_as_float(DPP_I(__float_as_int(x), 0x141))); x = fmaxf(x, __int_as_float(DPP_I(__float_as_int(x), 0x140)));
    const int xi = __float_as_int(x);
    return fmaxf(fmaxf(__int_as_float(__builtin_amdgcn_readlane(xi, 0)), __int_as_float(__builtin_amdgcn_readlane(xi, 16))), fmaxf(__int_as_float(__builtin_amdgcn_readlane(xi, 32)), __int_as_float(__builtin_amdgcn_readlane(xi, 48)))); }
__device__ __forceinline__ float wave_min_f(float x) { return -wave_max_f(-x); }
#define LDS_WAIT() asm volatile("s_waitcnt lgkmcnt(0)" ::: "memory")
__device__ __forceinline__ int lane_here() { int t; asm volatile("v_mbcnt_lo_u32_b32 %0, -1, 0\n\tv_mbcnt_hi_u32_b32 %0, -1, %0" : "=v"(t)); return t; }
#define tid_here() (wave_id * 64 + lane_here())

#define XB_TMO      128
#define XB_XCNT(j)  (256  + 64 * (j))
#define XB_XSUB(j)  (1280 + 64 * (j))
#define XB_XGEN(j)  (2304 + 64 * (j))
#define XB_TOP      3328
#define XB_TOPGEN   3392
#define XCD_BAR_WORDS 3456
#define XB_SPIN_CAP (1u << 24)
__device__ __forceinline__ unsigned xb_ld(unsigned* p)              { return __hip_atomic_load(p, __ATOMIC_RELAXED, __HIP_MEMORY_SCOPE_AGENT); }
__device__ __forceinline__ unsigned xb_add(unsigned* p, unsigned v) { return __hip_atomic_fetch_add(p, v, __ATOMIC_RELAXED, __HIP_MEMORY_SCOPE_AGENT); }
__device__ __forceinline__ unsigned xb_xcc_id() { return (unsigned)__builtin_amdgcn_s_getreg((3 << 11) | 20) & 0xFu; }
#define XB_SPIN(cond, bar) do { unsigned _sp = 0; while (cond) { __builtin_amdgcn_s_sleep(1); \
    if ((++_sp & 255u) == 0u) { if (xb_ld(&(bar)[XB_TMO])) break; if (_sp > XB_SPIN_CAP) { atomicAdd(&(bar)[XB_TMO], 1u); break; } } } } while (0)
struct XcdBarrier { unsigned* bar; unsigned x; volatile LAS unsigned* st; };
__device__ __forceinline__ XcdBarrier xcd_barrier_post(unsigned* bar, volatile LAS unsigned* st) {
    XcdBarrier b; b.bar = bar; b.x = xb_xcc_id(); b.st = st;
    if (threadIdx.x == 0) (void)xb_add(&bar[XB_XCNT(b.x)], 1u);
    return b;
}
__device__ __forceinline__ void xcd_barrier_complete(unsigned* bar, unsigned x, unsigned& nloc, unsigned& nx) {
    const unsigned G = gridDim.x * gridDim.y * gridDim.z;
    unsigned sum, cnt, mine, sp = 0u;
    for (;;) {
        sum = 0u; cnt = 0u; mine = 0u;
#pragma unroll
        for (unsigned j = 0; j < 16; ++j) { const unsigned c = xb_ld(&bar[XB_XCNT(j)]); sum += c; cnt += (c > 0u) ? 1u : 0u; mine = (j == x) ? c : mine; }
        if (sum == G) break;
        __builtin_amdgcn_s_sleep(1);
        if ((++sp & 255u) == 0u) { if (xb_ld(&bar[XB_TMO])) break; if (sp > XB_SPIN_CAP) { atomicAdd(&bar[XB_TMO], 1u); break; } }
    }
    nloc = mine > 0u ? mine : 1u; nx = cnt > 0u ? cnt : 1u;
}
__device__ __forceinline__ void xcd_barrier(const XcdBarrier& b) {
    asm volatile("s_waitcnt vmcnt(0)" ::: "memory");
    __syncthreads();
    if (threadIdx.x == 0) {
        size_t zo_ = 0; asm volatile("" : "+s"(zo_)); unsigned* bar = b.bar + zo_;
        __builtin_amdgcn_s_waitcnt(0);
        unsigned nloc = b.st[0], nx = b.st[1];
        if (nloc == 0u) { xcd_barrier_complete(bar, b.x, nloc, nx); b.st[0] = nloc; b.st[1] = nx; }
        const unsigned old = xb_add(&bar[XB_XSUB(b.x)], 1u);
        const unsigned gen = old / nloc;
        if (old + 1u == (gen + 1u) * nloc) {
            __builtin_amdgcn_fence(__ATOMIC_RELEASE, "agent");
            asm volatile("s_waitcnt vmcnt(0)" ::: "memory");
            const unsigned og = xb_add(&bar[XB_TOP], 1u);
            const unsigned tg = og / nx;
            if (og + 1u == (tg + 1u) * nx) xb_add(&bar[XB_TOPGEN], 1u);
            else XB_SPIN(xb_ld(&bar[XB_TOPGEN]) == tg, bar);
            __builtin_amdgcn_fence(__ATOMIC_ACQUIRE, "agent");
            xb_add(&bar[XB_XGEN(b.x)], 1u);
            asm volatile("s_waitcnt vmcnt(0)" ::: "memory");
        } else {
            XB_SPIN(xb_ld(&bar[XB_XGEN(b.x)]) == gen, bar);
            __builtin_amdgcn_fence(__ATOMIC_ACQUIRE, "agent");
            asm volatile("s_waitcnt vmcnt(0)" ::: "memory");
        }
    }
    __syncthreads();
}

struct SrcIn { __device__ __forceinline__ int operator()(int n) const {
    if (n < 1024) return n;
    const int t = (n - 1024) >> 8, c = (n - 1024) & 255, half = c >> 7, p = c & 127;
    if (t == 0) return 1056 + (p >> 5) * 64 + half * 32 + (p & 31);
    if (t == 1) return 1736 + (p >> 5) * 64 + half * 32 + (p & 31);
    if (t == 2) return 1992 + (p >> 5) * 64 + half * 32 + (p & 31);
    if (t == 3) return 1440 + (p >> 4) * 32 + half * 16 + (p & 15);
    if (t == 4) {
        if (p < 32) return 1312 + half * 32 + p;
        if (p < 48) return 1024 + half * 16 + (p - 32);
        if (p < 64) return 1696 + half * 16 + (p - 48);
        if (half == 0) return 1376 + (p - 64);
        return (p - 64 < 8) ? 1728 + (p - 64) : -1;
    }
    if (t == 5) return 2248 + c;
    return 2504 + c; } };
struct SrcUq { __device__ __forceinline__ int operator()(int n) const {
    if (n < 512) return (n >> 6) * 96 + (n & 63);
    const int c = n - 512, half = c >> 7, p = c & 127; return (p >> 4) * 96 + 64 + half * 16 + (p & 15); } };
struct SrcUkv { __device__ __forceinline__ int operator()(int n) const {
    if (n < 512) return (n >> 6) * 128 + (n & 63);
    const int c = n - 512; return (c >> 6) * 128 + 64 + (c & 63); } };
struct SrcId { __device__ __forceinline__ int operator()(int n) const { return n; } };

template <class SrcF>
__device__ __forceinline__ void transpose_item(const float* W, int K, int Nsrc, int Ndst, const float* gain, bf16* WT, LAS float* scr, int item, int lane, SrcF srcf) {
    const int nblk = Ndst / 32, kb = item / nblk, nb = item % nblk, k0 = 64 * kb, n0 = 32 * nb;
    const int sc = srcf(n0 + (lane & 31));
#pragma unroll 8
    for (int i = 0; i < 32; ++i) { const int kk = 2 * i + (lane >> 5); float v = 0.f; if (sc >= 0) v = W[(size_t)(k0 + kk) * Nsrc + sc]; if (gain) v *= gain[k0 + kk]; scr[kk * 33 + (lane & 31)] = v; }
    LDS_WAIT(); asm volatile("" ::: "memory");
    const int c = lane & 7;
#pragma unroll
    for (int j = 0; j < 4; ++j) { const int n = (lane >> 3) + 8 * j; const LAS float* s = scr + (8 * c) * 33 + n;
        u32x4 o; o.x = cvtpk(s[0 * 33], s[1 * 33]); o.y = cvtpk(s[2 * 33], s[3 * 33]); o.z = cvtpk(s[4 * 33], s[5 * 33]); o.w = cvtpk(s[6 * 33], s[7 * 33]);
        *(u32x4*)(WT + (size_t)(n0 + n) * K + k0 + 8 * c) = o; }
    LDS_WAIT(); asm volatile("" ::: "memory");
}

struct Ptrs {
    const float *x, *g_mix, *w_in, *g_q, *w_uq, *g_kv, *w_ukv, *g_ret, *w_out, *g_mlp, *w_ff1, *w_ff2, *g_final;
    float* out; unsigned char* ws;
};
struct Args { Ptrs p; int ph_lo, ph_hi; };
static_assert(sizeof(Args) == 15 * 8 + 8, "Args has no padding");

constexpr int AUX_LDS_OFF = RING_BYTES + 6144;
template <class F> struct EpiT {
    static constexpr bool PERM = true, AFTER_DRAIN = false;
    F f; LAS const unsigned char* ldsb;
    __device__ __forceinline__ void stage_aux(const pg8::Unit& u, PG8_LAS unsigned char* lds, int wid, int lane) const {
        if constexpr (F::LDS_AUX) { unsigned lo = (unsigned)(wid * 1024 + lane * 16); asm volatile("" : "+v"(lo));
            const char* src = (const char*)f.aux_base() + (size_t)u.pm * (256 * 64) + lo;
            __builtin_amdgcn_global_load_lds((const unsigned*)src, (PG8_LAS unsigned*)(lds + AUX_LDS_OFF + wid * 1024), 16, 0, 0); }
    }
    template <int R0, int NRW>
    __device__ __forceinline__ void apply_rows(const pg8::f32x4 (&acc)[2][2][4][2], const pg8::Unit& u, int row0, int wc, int fq, const typename F::Ctx& ctx, const typename F::AuxT* ax) const {
#pragma unroll
        for (int i = 0; i < NRW; ++i) {
            const int it = R0 + i, ai = it >> 2, m = it & 3, row = row0 + ai * 128 + m * 16;
            float x1[8], x2[8];
#pragma unroll
            for (int j = 0; j < 4; ++j) { x1[j] = acc[ai][0][m][0][j]; x1[4 + j] = acc[ai][0][m][1][j]; x2[j] = acc[ai][1][m][0][j]; x2[4 + j] = acc[ai][1][m][1][j]; }
            f.apply(ctx, ax[i], row, u.pn, wc, fq, x1, x2);
            asm volatile("" ::: "memory");
        }
    }
    template <int R0, int NRW>
    __device__ __forceinline__ void rows(const pg8::f32x4 (&acc)[2][2][4][2], const pg8::Unit& u, int row0, int wc, int fq, const typename F::Ctx& ctx) const {
        typename F::AuxT ax[NRW];
#pragma unroll
        for (int i = 0; i < NRW; ++i) ax[i] = f.load(row0 + ((R0 + i) >> 2) * 128 + ((R0 + i) & 3) * 16, u.pn, wc, fq);
        asm volatile("" ::: "memory");
        apply_rows<R0, NRW>(acc, u, row0, wc, fq, ctx, ax);
    }
    __device__ __forceinline__ void operator()(const pg8::f32x4 (&acc)[2][2][4][2], const pg8::Unit& u, int wr, int wc, int fr, int fq) const {
        { const int ln = lane_here(); fr = ln & 15; fq = ln >> 4; }
        const int row0 = u.pm * 256 + wr * 64 + fr;
        const typename F::Ctx ctx = f.begin(u.pn, wc, fq);
        if constexpr (F::LDS_AUX) {
            typename F::AuxT hi4[4], lo4[4];
#pragma unroll
            for (int i = 0; i < 4; ++i) hi4[i] = f.load(row0 + 128 + i * 16, u.pn, wc, fq);
            asm volatile("" ::: "memory");
#pragma unroll
            for (int i = 0; i < 4; ++i) lo4[i] = f.from_lds(ldsb + AUX_LDS_OFF + (wr * 64 + i * 16 + fr) * 64, fq);
            apply_rows<0, 4>(acc, u, row0, wc, fq, ctx, lo4);
            apply_rows<4, 4>(acc, u, row0, wc, fq, ctx, hi4);
        } else {
            if constexpr (F::BATCH == 8) rows<0, 8>(acc, u, row0, wc, fq, ctx);
            else { rows<0, 4>(acc, u, row0, wc, fq, ctx); rows<4, 4>(acc, u, row0, wc, fq, ctx); }
        }
    }
};
__device__ __forceinline__ f32x4 part4(const float* p, int fq, int n4) { f32x4 a = {0.f, 0.f, 0.f, 0.f}; if (fq < n4) a = *(const f32x4*)(p + 4 * fq); return a; }
__device__ __forceinline__ float red4(const f32x4 a) { return xrow16_sum((a.x + a.y) + (a.z + a.w)); }
__device__ __forceinline__ float ssq16(const float* x1, const float* x2) { float s = 0.f;
#pragma unroll
    for (int j = 0; j < 8; ++j) s += x1[j] * x1[j] + x2[j] * x2[j];
    return xrow16_sum(s); }
struct RopeCtx { float inv[8]; };
__device__ __forceinline__ RopeCtx rope_ctx(int f0, bool dim64) { RopeCtx c; const float step = dim64 ? 0.41524101186092029f : 0.83048202372184058f;
#pragma unroll
    for (int j = 0; j < 8; ++j) c.inv[j] = __builtin_amdgcn_exp2f(-(float)(f0 + j) * step) * 0.15915494309189535f;
    return c; }
__device__ __forceinline__ void rope8(float* x1, float* x2, const RopeCtx& c, int pos) {
    const float pf = (float)pos;
#pragma unroll
    for (int j = 0; j < 8; ++j) { const float rev = __builtin_amdgcn_fractf(pf * c.inv[j]); const float cs = __builtin_amdgcn_cosf(rev), sn = __builtin_amdgcn_sinf(rev);
        const float a = x1[j], b = x2[j]; x1[j] = a * cs - b * sn; x2[j] = a * sn + b * cs; }
}

struct FIn {
    typedef f32x4 AuxT; typedef RopeCtx Ctx; static constexpr int BATCH = 8; static constexpr bool LDS_AUX = (EPI_LDS_AUX != 0);
    unsigned char* ws;
    __device__ __forceinline__ const float* aux_base() const { return (const float*)(ws + WS_SSQX); }
    __device__ __forceinline__ AuxT from_lds(LAS const unsigned char* rowp, int fq) const { return *(LAS const f32x4*)(rowp + fq * 16); }
    __device__ __forceinline__ Ctx begin(int pn, int wc, int fq) const { const int p = wc * 32 + fq * 8; const bool d64 = (pn >= 4 && pn <= 6) || (pn == 8 && wc == 0); return rope_ctx(d64 ? (p & 31) : (p & 15), d64); }
    __device__ __forceinline__ AuxT load(int row, int, int, int fq) const { return part4((const float*)(ws + WS_SSQX) + (size_t)row * 16, fq, 4); }
    __device__ __forceinline__ void apply(const Ctx& ctx, const AuxT& ax, int row, int pn, int wc, int fq, float* x1, float* x2) const {
        float* ssql = (float*)(ws + WS_SSQL);
        const float sc_ = (pn == 4) ? 0.125f * LOG2E : (pn == 6) ? 0.125f : 1.0f;
        const float rs = __builtin_amdgcn_rsqf(red4(ax) * (1.0f / DM) + EPS) * sc_;
#pragma unroll
        for (int j = 0; j < 8; ++j) { x1[j] *= rs; x2[j] *= rs; }
        const int p = wc * 32 + fq * 8, pos = row & (SEQ - 1);
        if (pn < 3) { bf16* d = (bf16*)(ws + WS_CQ) + (size_t)row * 768 + pn * 256 + p; st8(d, x1); st8(d + 128, x2); const float s = ssq16(x1, x2); if (fq == 0) ssql[(size_t)row * 16 + pn * 4 + wc] = s; }
        else if (pn == 3) { bf16* d = (bf16*)(ws + WS_CKV) + (size_t)row * 256 + p; st8(d, x1); st8(d + 128, x2); const float s = ssq16(x1, x2); if (fq == 0) ssql[(size_t)row * 16 + 12 + wc] = s; }
        else if (pn <= 6) { rope8(x1, x2, ctx, pos);
            bf16* d = (bf16*)(ws + WS_AQ + (size_t)(pn - 4) * (32 * MiB)) + (size_t)row * 256 + (p >> 5) * 64 + (p & 31); st8(d, x1); st8(d + 32, x2); }
        else if (pn == 7) { rope8(x1, x2, ctx, pos); bf16* d = (bf16*)(ws + WS_QI) + (size_t)row * 256 + (p >> 4) * 32 + (p & 15); st8(d, x1); st8(d + 16, x2); }
        else if (pn == 8) { bf16* d = (bf16*)(ws + WS_MS) + (size_t)row * 256;
            if (wc == 0) { rope8(x1, x2, ctx, pos); st8(d + p, x1); st8(d + 32 + p, x2); }
            else if (wc == 1) { const int i = (p - 32) & 15, o = (p < 48) ? 64 : 96; rope8(x1, x2, ctx, pos); st8(d + o + i, x1); st8(d + o + 16 + i, x2); }
            else { st8(d + 128 + (p - 64), x1); if (p == 64) { float w[8];
#pragma unroll
                    for (int j = 0; j < 8; ++j) w[j] = x2[j] * 0.0625f;
                    st8f((float*)(ws + WS_WI) + (size_t)row * 8, w); } } }
        else { bf16* d = (bf16*)(ws + WS_RV + (size_t)(pn - 9) * (32 * MiB)) + (size_t)row * 256 + p; st8(d, x1); st8(d + 128, x2); }
    }
};
static_assert(WS_V == WS_KN + 64 * MiB && WS_RQ == WS_AQ + 32 * MiB && WS_RK == WS_AQ + 64 * MiB && WS_RG == WS_RV + 32 * MiB, "FIn / FUkv compute these destinations by arithmetic");
struct FUq {
    typedef f32x4 AuxT; typedef RopeCtx Ctx; static constexpr int BATCH = 8; static constexpr bool LDS_AUX = (EPI_LDS_AUX != 0);
    const float* ssql; bf16* q;
    __device__ __forceinline__ const float* aux_base() const { return ssql; }
    __device__ __forceinline__ AuxT from_lds(LAS const unsigned char* rowp, int fq) const { f32x4 a = {0.f, 0.f, 0.f, 0.f}; if (fq < 3) a = *(LAS const f32x4*)(rowp + fq * 16); return a; }
    __device__ __forceinline__ Ctx begin(int, int wc, int fq) const { return rope_ctx((wc * 32 + fq * 8) & 15, false); }
    __device__ __forceinline__ AuxT load(int row, int, int, int fq) const { return part4(ssql + (size_t)row * 16, fq, 3); }
    __device__ __forceinline__ void apply(const Ctx& ctx, const AuxT& ax, int row, int pn, int wc, int fq, float* x1, float* x2) const {
        const float rs = __builtin_amdgcn_rsqf(red4(ax) * (1.0f / 768.0f) + EPS) * (0.10206207261596577f * LOG2E);
#pragma unroll
        for (int j = 0; j < 8; ++j) { x1[j] *= rs; x2[j] *= rs; }
        const int p = wc * 32 + fq * 8;
        if (pn < 2) { const int c1 = pn * 256 + p, c2 = c1 + 128; st8(q + (size_t)row * 768 + (c1 >> 6) * 96 + (c1 & 63), x1); st8(q + (size_t)row * 768 + (c2 >> 6) * 96 + (c2 & 63), x2); }
        else { rope8(x1, x2, ctx, row & (SEQ - 1)); bf16* d = q + (size_t)row * 768 + (p >> 4) * 96 + 64 + (p & 15); st8(d, x1); st8(d + 16, x2); }
    }
};
struct NoCtx { };
struct FUkv {
    typedef f32x4 AuxT; typedef NoCtx Ctx; static constexpr int BATCH = 8; static constexpr bool LDS_AUX = ((EPI_LDS_AUX & 2) != 0);
    const float* ssql; bf16* kn;
    __device__ __forceinline__ const float* aux_base() const { return ssql; }
    __device__ __forceinline__ AuxT from_lds(LAS const unsigned char* rowp, int) const { return *(LAS const f32x4*)(rowp + 48); }
    __device__ __forceinline__ Ctx begin(int, int, int) const { return Ctx{}; }
    __device__ __forceinline__ AuxT load(int row, int, int, int) const { return *(const f32x4*)(ssql + (size_t)row * 16 + 12); }
    __device__ __forceinline__ void apply(const Ctx&, const AuxT& ax, int row, int pn, int wc, int fq, float* x1, float* x2) const {
        const float rs = __builtin_amdgcn_rsqf(((ax.x + ax.y) + (ax.z + ax.w)) * (1.0f / 256.0f) + EPS);
#pragma unroll
        for (int j = 0; j < 8; ++j) { x1[j] *= rs; x2[j] *= rs; }
        const int p = wc * 32 + fq * 8; bf16* d = kn + (size_t)(pn >> 1) * (size_t)(32 * MiB) + (size_t)row * 512 + (pn & 1) * 256 + p; st8(d, x1); st8(d + 128, x2);
    }
};
struct ResAux { u32x4 a, b; f32x4 s; };
template <bool SCALE> struct FRes {
    typedef ResAux AuxT; typedef NoCtx Ctx; static constexpr int BATCH = RES_BATCH; static constexpr bool LDS_AUX = false;
    bf16* xb; const float* ssq_in; float* ssq_out;
    __device__ __forceinline__ Ctx begin(int, int, int) const { return Ctx{}; }
    __device__ __forceinline__ AuxT load(int row, int pn, int wc, int fq) const {
        const size_t o = (size_t)row * DM + pn * 256 + wc * 32 + fq * 8; AuxT ax;
        ax.a = *(const u32x4*)(xb + o); ax.b = *(const u32x4*)(xb + o + 128); ax.s = (f32x4){0.f, 0.f, 0.f, 0.f};
        if (SCALE) ax.s = part4(ssq_in + (size_t)row * 16, fq, 4);
        return ax;
    }
    __device__ __forceinline__ void apply(const Ctx&, const AuxT& ax, int row, int pn, int wc, int fq, float* x1, float* x2) const {
        const int p = wc * 32 + fq * 8; const size_t o = (size_t)row * DM + pn * 256 + p;
        if (SCALE) { const float r2 = __builtin_amdgcn_rcpf(red4(ax.s) * (1.0f / DM) + EPS);
#pragma unroll
            for (int j = 0; j < 8; ++j) { x1[j] *= r2; x2[j] *= r2; } }
        float a[8], b[8]; unpack8(ax.a, a); unpack8(ax.b, b);
#pragma unroll
        for (int j = 0; j < 8; ++j) { x1[j] += a[j]; x2[j] += b[j]; }
        st8(xb + o, x1); st8(xb + o + 128, x2);
        const float s = ssq16(x1, x2); if (fq == 0) ssq_out[(size_t)row * 16 + pn * 4 + wc] = s;
    }
};
struct FFf1 {
    typedef int AuxT; typedef NoCtx Ctx; static constexpr int BATCH = 8; static constexpr bool LDS_AUX = false;
    bf16* h;
    __device__ __forceinline__ Ctx begin(int, int, int) const { return Ctx{}; }
    __device__ __forceinline__ AuxT load(int, int, int, int) const { return 0; }
    __device__ __forceinline__ void apply(const Ctx&, const AuxT&, int row, int pn, int wc, int fq, float* x1, float* x2) const {
#pragma unroll
        for (int j = 0; j < 8; ++j) { const float a = relu_i(x1[j]), b = relu_i(x2[j]); x1[j] = a * a; x2[j] = b * b; }
        const int p = wc * 32 + fq * 8; bf16* d = h + (size_t)row * FF + pn * 256 + p; st8nt(d, x1); st8nt(d + 128, x2);
    }
};

struct FNull {
    typedef int AuxT; typedef NoCtx Ctx; static constexpr int BATCH = 8; static constexpr bool LDS_AUX = false;
    __device__ __forceinline__ Ctx begin(int, int, int) const { return Ctx{}; }
    __device__ __forceinline__ AuxT load(int, int, int, int) const { return 0; }
    __device__ __forceinline__ void apply(const Ctx&, const AuxT&, int, int, int, int, float* x1, float* x2) const {
#pragma unroll
        for (int j = 0; j < 8; ++j) asm volatile("" :: "v"(x1[j]), "v"(x2[j])); }
};
#if MK_NAIVE_GEMM
template <class Epi, class Sched>
__device__ __forceinline__ void gemm_phase_x(LAS unsigned char*, const pg8::Gemm g, const Sched& S, const Epi& E, const int wave_id) {
    const int tid = tid_here(), wid = wave_id, lane = tid & 63, wr = wid >> 2, wc = wid & 3, fr = lane & 15, fq = lane >> 4;
    pg8::Unit u;
    for (int it = 0; S.next(it, u); ++it) {
        pg8::f32x4 acc[2][2][4][2];
#pragma unroll
        for (int a = 0; a < 2; ++a)
#pragma unroll
            for (int b = 0; b < 2; ++b)
#pragma unroll
                for (int m = 0; m < 4; ++m)
#pragma unroll
                    for (int n = 0; n < 2; ++n) acc[a][b][m][n] = (pg8::f32x4){0.f, 0.f, 0.f, 0.f};
        for (int k = 0; k < g.K; k += 8) {
            float bv[2][8][8];
#pragma unroll
            for (int bj = 0; bj < 2; ++bj)
#pragma unroll
                for (int c = 0; c < 8; ++c) { const int col = u.pn * 256 + bj * 128 + wc * 32 + fq * 8 + c; unpack8(*(const u32x4*)(g.Bt + (size_t)col * g.K + k), bv[bj][c]); }
#pragma unroll
            for (int ai = 0; ai < 2; ++ai)
#pragma unroll
                for (int m = 0; m < 4; ++m) { const int row = u.pm * 256 + ai * 128 + wr * 64 + m * 16 + fr; float av[8]; unpack8(*(const u32x4*)(g.A + (size_t)row * g.K + k), av);
#pragma unroll
                    for (int bj = 0; bj < 2; ++bj)
#pragma unroll
                        for (int c = 0; c < 8; ++c) { float s = 0.f;
#pragma unroll
                            for (int j = 0; j < 8; ++j) s += av[j] * bv[bj][c][j];
                            acc[ai][bj][m][c >> 2][c & 3] += s; } }
        }
        E(acc, u, wr, wc, fr, fq);
    }
    __syncthreads();
}
#define GEMM_PHASE(EpiType, lds, g, S, E) gemm_phase_x<EpiType, pg8::StaticOrder>(lds, g, S, E, wave_id)
#else
#define GEMM_PHASE(EpiType, lds, g, S, E) pg8::gemm_phase<EpiType, pg8::StaticOrder, true, true>(lds, g, S, E, wave_id)
#endif
#if PROBE_KL
#define KL_RUN(bit, FT, ...) do { EpiT<FT> E{FT{__VA_ARGS__}, lds}; for (int rep_ = 0; rep_ < ((PROBE_KL >> (bit)) & 1) + 1; ++rep_) { __syncthreads(); if (tid_here() == 0) *(volatile LAS unsigned*)(lds + MISC_OFF + 128) = (rep_ + 1 < ((PROBE_KL >> (bit)) & 1) + 1) ? 1u : 0u; __syncthreads(); GEMM_PHASE(EpiT<FT>, lds, g, S, E); } } while (0)
#else
#define KL_RUN(bit, FT, ...) do { EpiT<FT> E{FT{__VA_ARGS__}, lds}; GEMM_PHASE(EpiT<FT>, lds, g, S, E); } while (0)
#endif

__device__ __forceinline__ void mla_naive(const bf16* Q, const bf16* KN, const bf16* MS, const bf16* V, bf16* O, const int wave_id) {
    const int tid = tid_here();
    for (int u = blockIdx.x; u < BATCH * 8 * 4; u += gridDim.x) {
        const int b = u >> 5, h = (u >> 2) & 7, tb = u & 3, t = tb * 512 + tid; const size_t row = (size_t)b * SEQ + t;
        float q[96], o[64];
#pragma unroll
        for (int c = 0; c < 12; ++c) unpack8(*(const u32x4*)(Q + row * 768 + h * 96 + c * 8), q + c * 8);
#pragma unroll
        for (int d = 0; d < 64; ++d) o[d] = 0.f;
        float mx = -1e30f, l = 0.f;
        const int smax = tb * 512 + (tid | 63);
        for (int s = 0; s <= smax; ++s) {
            const size_t rs = (size_t)b * SEQ + s; float sc = 0.f;
#pragma unroll
            for (int c = 0; c < 8; ++c) { float k[8]; unpack8(*(const u32x4*)(KN + rs * 512 + h * 64 + c * 8), k);
#pragma unroll
                for (int j = 0; j < 8; ++j) sc += q[c * 8 + j] * k[j]; }
#pragma unroll
            for (int c = 0; c < 4; ++c) { float k[8]; unpack8(*(const u32x4*)(MS + rs * 256 + 64 + c * 8), k);
#pragma unroll
                for (int j = 0; j < 8; ++j) sc += q[64 + c * 8 + j] * k[j]; }
            if (s <= t) {
                const float mn = fmaxf(mx, sc), a = __builtin_amdgcn_exp2f(mx - mn), pp = __builtin_amdgcn_exp2f(sc - mn);
                l = l * a + pp; mx = mn;
#pragma unroll
                for (int c = 0; c < 8; ++c) { float v[8]; unpack8(*(const u32x4*)(V + rs * 512 + h * 64 + c * 8), v);
#pragma unroll
                    for (int j = 0; j < 8; ++j) o[c * 8 + j] = o[c * 8 + j] * a + pp * v[j]; }
            }
        }
        const float inv = 1.0f / l;
#pragma unroll
        for (int c = 0; c < 8; ++c) { float w[8];
#pragma unroll
            for (int j = 0; j < 8; ++j) w[j] = o[c * 8 + j] * inv;
            st8(O + row * DM + h * 64 + c * 8, w); }
    }
}
__device__ __forceinline__ void dsa_naive(const bf16* AQ, const bf16* MS, const unsigned* BM, bf16* O, const int wave_id) {
    const int tid = tid_here();
    for (int u = blockIdx.x; u < BATCH * 4 * 4; u += gridDim.x) {
        const int b = u >> 4, h = (u >> 2) & 3, tb = u & 3, t = tb * 512 + tid; const size_t row = (size_t)b * SEQ + t;
        float q[64], o[64];
#pragma unroll
        for (int c = 0; c < 8; ++c) { unpack8(*(const u32x4*)(AQ + row * 256 + h * 64 + c * 8), q + c * 8);
#pragma unroll
            for (int j = 0; j < 8; ++j) q[c * 8 + j] *= 1.0f; }
#pragma unroll
        for (int d = 0; d < 64; ++d) o[d] = 0.f;
        float mx = -1e30f, l = 0.f; unsigned word = 0;
        const int smax = tb * 512 + (tid | 63);
        for (int s = 0; s <= smax; ++s) {
            if ((s & 31) == 0) word = BM[row * 64 + (s >> 5)];
            const bool sel = (s <= t) && ((word >> (s & 31)) & 1u);
            if (sel) {
                const size_t rs = (size_t)b * SEQ + s; float sc = 0.f;
#pragma unroll
                for (int c = 0; c < 8; ++c) { float k[8]; unpack8(*(const u32x4*)(MS + rs * 256 + c * 8), k);
#pragma unroll
                    for (int j = 0; j < 8; ++j) sc += q[c * 8 + j] * k[j]; }
                const float mn = fmaxf(mx, sc), a = __builtin_amdgcn_exp2f(mx - mn), pp = __builtin_amdgcn_exp2f(sc - mn);
                l = l * a + pp; mx = mn;
#pragma unroll
                for (int c = 0; c < 8; ++c) { float v[8]; unpack8(*(const u32x4*)(MS + rs * 256 + 128 + c * 8), v);
#pragma unroll
                    for (int j = 0; j < 8; ++j) o[c * 8 + j] = o[c * 8 + j] * a + pp * v[j]; }
            }
        }
        const float inv = 1.0f / l;
#pragma unroll
        for (int c = 0; c < 8; ++c) { float w[8];
#pragma unroll
            for (int j = 0; j < 8; ++j) w[j] = o[c * 8 + j] * inv;
            st8(O + row * DM + 512 + h * 64 + c * 8, w); }
    }
}
typedef float f32x2s __attribute__((ext_vector_type(2)));
__device__ __forceinline__ f32x2s pk_gt(f32x2s v, f32x2s big, f32x2s nm) { f32x2s e; asm("v_pk_fma_f32 %0, %1, %2, %3 clamp" : "=v"(e) : "v"(v), "v"(big), "v"(nm)); return e; }
__device__ __forceinline__ float max3_raw(float a, float b, float c) { float r; asm("v_max3_f32 %0, %1, %2, %3" : "=v"(r) : "v"(a), "v"(b), "v"(c)); return r; }
__device__ __forceinline__ float min3_raw(float a, float b, float c) { float r; asm("v_min3_f32 %0, %1, %2, %3" : "=v"(r) : "v"(a), "v"(b), "v"(c)); return r; }
__device__ __forceinline__ float wave_sum_f(float x) {
    x += __int_as_float(DPP_I(__float_as_int(x), 0xB1)); x += __int_as_float(DPP_I(__float_as_int(x), 0x4E)); x += __int_as_float(DPP_I(__float_as_int(x), 0x141)); x += __int_as_float(DPP_I(__float_as_int(x), 0x140));
    const int xi = __float_as_int(x);
    return (__int_as_float(__builtin_amdgcn_readlane(xi, 0)) + __int_as_float(__builtin_amdgcn_readlane(xi, 16))) + (__int_as_float(__builtin_amdgcn_readlane(xi, 32)) + __int_as_float(__builtin_amdgcn_readlane(xi, 48))); }
__device__ __forceinline__ int fkey(int u) { return u ^ ((u >> 31) & 0x7fffffff); }
template <int NR>
__device__ __forceinline__ void select_row(const f32x2s (&vp)[NR / 2], int nk, u64* bm, int lane) {
    static_assert(NR % 2 == 0, "pairs");
    float mx = vp[0].x, mn = vp[0].x;
#pragma unroll
    for (int j = 0; j < NR / 2; ++j) { mx = max3_raw(mx, vp[j].x, vp[j].y); mn = min3_raw(mn, vp[j].x, vp[j].y); }
    float hi = wave_max_f(mx); const float mnw = wave_min_f(mn);
    float lo = mnw - fabsf(mnw) * 1e-3f - 1e-3f;
    int clo = nk, chi = 0;
    bool exact = false; float thr = hi;
    float bigs = 1.152921504606847e18f, zf = 0.f; asm volatile("" : "+v"(bigs), "+v"(zf));
    const f32x2s big = {bigs, bigs};
    constexpr int NS = (NR == 8) ? 4 : NR - 8;
#define OPQ(c) ({ float c_ = (c); asm volatile("" : "+v"(c_)); c_; })
    f32x2s s1 = {zf, zf}, s2 = {zf, zf};
#pragma unroll
    for (int j = 0; j < NS / 2; ++j) { s1 += vp[j]; s2 += vp[j] * vp[j]; }
    const float S1 = wave_sum_f(s1.x + s1.y), S2 = wave_sum_f(s2.x + s2.y);
    const float invn = OPQ(1.0f / (64.0f * NS));
    float mu = S1 * invn; asm volatile("" : "+v"(mu));
    float var = fmaxf(__builtin_fmaf(S2, invn, -mu * mu), OPQ(1e-20f)); asm volatile("" : "+v"(var));
    float sd = var * __builtin_amdgcn_rsqf(var); asm volatile("" : "+v"(sd));
    float pq = 1.0f - OPQ(256.5f) * __builtin_amdgcn_rcpf((float)nk); pq = fminf(fmaxf(pq, OPQ(0.025f)), OPQ(0.975f));
    const float z = __builtin_amdgcn_logf(pq * __builtin_amdgcn_rcpf(1.0f - pq)) * OPQ(0.40725434f);
    float zz2 = z * z; asm volatile("" : "+v"(zz2));
    float rdens = sd * __builtin_amdgcn_rcpf((float)nk * OPQ(0.3989422804f) * __builtin_amdgcn_exp2f(OPQ(-0.72134752f) * zz2));
    asm volatile("" : "+v"(rdens));
    float nxt = __builtin_fmaf(z, sd, mu); asm volatile("" : "+v"(nxt));
#define RFL(x) __builtin_amdgcn_readfirstlane(x)
    int ulo = RFL(__float_as_int(lo)), uhi = RFL(__float_as_int(hi)); clo = RFL(clo);
    int unxt = RFL(__float_as_int(nxt)); bool have_nxt = true; int nsteps = 0, uthr = uhi;
    const float rdens_u = __int_as_float(RFL(__float_as_int(rdens)));
    for (int it = 0, it3 = 0; it < 200; ++it, it3 = (it3 == 2) ? 0 : it3 + 1) {
        const int kl = fkey(ulo), kh = fkey(uhi); const unsigned span = (unsigned)kh - (unsigned)kl;
        if (span <= 1u) break;
        int kc = kl + (int)(span >> 1);
        if (have_nxt) { const int kn = fkey(unxt); if (kn > kl && kn < kh) kc = kn; have_nxt = false; }
        else if (it3 != 2) { const float lo_f = __int_as_float(ulo), hi_f = __int_as_float(uhi);
            const float gq = lo_f + (hi_f - lo_f) * (((float)(clo - 256) + 0.5f) * __builtin_amdgcn_rcpf((float)(clo - chi)));
            const int kg = fkey(RFL(__float_as_int(gq))); if (kg > kl && kg < kh) kc = kg; }
        const int umid = fkey(kc); const float mid = __int_as_float(umid);
        const float nmv = -mid * 1.152921504606847e18f; const f32x2s nm = {nmv, nmv};
        f32x2s acc0 = {zf, zf}, acc1 = {zf, zf}, acc2 = {zf, zf}, acc3 = {zf, zf};
#pragma unroll
        for (int j = 0; j < NR / 2; j += 4) { acc0 += pk_gt(vp[j], big, nm); acc1 += pk_gt(vp[j + 1], big, nm); acc2 += pk_gt(vp[j + 2], big, nm); acc3 += pk_gt(vp[j + 3], big, nm); }
        const f32x2s acc = (acc0 + acc1) + (acc2 + acc3);
        const int c = RFL((int)wave_sum_f(acc.x + acc.y));
        if (c == 256) { exact = true; uthr = umid; break; }
        if (c > 256) { ulo = umid; clo = c; } else { uhi = umid; chi = c; }
        if (nsteps < 2) { ++nsteps; const float nx = mid + ((float)(c - 256) + 0.5f) * rdens_u; unxt = RFL(__float_as_int(nx)); have_nxt = true; }
    }
#undef RFL
    thr = __int_as_float(uthr); hi = __int_as_float(uhi);
    if (exact) {
#pragma unroll
        for (int j = 0; j < NR / 2; ++j) { const u64 w0 = __ballot(vp[j].x > thr), w1 = __ballot(vp[j].y > thr); bm[2 * j] = w0; bm[2 * j + 1] = w1; }
    } else {
        const int need = 256 - chi; int tr = 0; const u64 lt = (1ull << lane) - 1ull;
#pragma unroll
        for (int i = 0; i < NR; ++i) { const float x = (i & 1) ? vp[i >> 1].y : vp[i >> 1].x; const bool gt = x > hi, tie = (x == hi); const u64 tb = __ballot(tie); const int rank = tr + __popcll(tb & lt); tr += __popcll(tb);
            const u64 w = __ballot(gt || (tie && rank < need)); bm[i] = w; }
    }
}
__device__ __forceinline__ void select_naive(LAS unsigned char* lds, const bf16* QI, const bf16* MS, const float* WI, u64* BM, const int wave_id) {
    const int tid = tid_here(), wave = wave_id, lane = tid & 63;
    LAS float* sc_lds = (LAS float*)(lds + wave * 8192);
    LAS float* qi_lds = (LAS float*)(lds + 65536 + wave * 1024);
    for (int qb = blockIdx.x; qb < M / 8; qb += gridDim.x) {
        const int row = qb * 8 + wave, b = row >> 11, t = row & (SEQ - 1);
        u64* bm = BM + (size_t)row * 32;
        if (t < 256) { if (lane < 32) { const int k0 = 64 * lane; bm[lane] = (t >= k0 + 63) ? ~0ull : (t < k0 ? 0ull : ((1ull << (t - k0 + 1)) - 1ull)); } continue; }
        { const u32x2 r = *(const u32x2*)(QI + (size_t)row * 256 + lane * 4); qi_lds[lane * 4] = bf_lo(r.x); qi_lds[lane * 4 + 1] = bf_hi(r.x); qi_lds[lane * 4 + 2] = bf_lo(r.y); qi_lds[lane * 4 + 3] = bf_hi(r.y); }
        float w8[8];
#pragma unroll
        for (int hh = 0; hh < 8; ++hh) w8[hh] = WI[(size_t)row * 8 + hh];
        LDS_WAIT();
        const int nk = t + 1;
        for (int s0 = 0; s0 < nk; s0 += 64) {
            const int s = s0 + lane; float scv = -INFINITY;
            if (s < nk) { float k[32];
#pragma unroll
                for (int c = 0; c < 4; ++c) unpack8(*(const u32x4*)(MS + ((size_t)b * SEQ + s) * 256 + 96 + c * 8), k + c * 8);
                scv = 0.f;
#pragma unroll
                for (int hh = 0; hh < 8; ++hh) { float d = 0.f;
#pragma unroll
                    for (int j = 0; j < 32; ++j) d += qi_lds[hh * 32 + j] * k[j];
                    scv += w8[hh] * fmaxf(d, 0.f); } }
            sc_lds[s] = scv; }
        LDS_WAIT();
        float v[32];
#pragma unroll
        for (int i = 0; i < 32; ++i) v[i] = (i * 64 + lane < nk) ? sc_lds[i * 64 + lane] : __builtin_nanf("");
        { f32x2s vp[16];
#pragma unroll
          for (int i = 0; i < 32; ++i) { if (i & 1) vp[i >> 1].y = v[i]; else vp[i >> 1].x = v[i]; }
          select_row<32>(vp, nk, bm, lane); }
        LDS_WAIT();
    }
}
__device__ __forceinline__ void ret_naive(const bf16* RQ, const bf16* RK, const bf16* RV, const bf16* RG, const float* g_ret, bf16* O, const int wave_id) {
    const int tid = tid_here();
    for (int u = blockIdx.x; u < BATCH * 4 * 4; u += gridDim.x) {
        const int b = u >> 4, h = (u >> 2) & 3, tb = u & 3, t = tb * 512 + tid; const size_t row = (size_t)b * SEQ + t;
        const float lg2 = (h == 0) ? -0.045803689613124935f : (h == 1) ? -0.022720076500083562f : (h == 2) ? -0.011315313227834123f : -0.0056465631411395075f;
        float q[64], o[64];
#pragma unroll
        for (int c = 0; c < 8; ++c) unpack8(*(const u32x4*)(RQ + row * 256 + h * 64 + c * 8), q + c * 8);
#pragma unroll
        for (int d = 0; d < 64; ++d) o[d] = 0.f;
        const int smax = tb * 512 + (tid | 63);
        for (int s = 0; s <= smax; ++s) {
            const size_t rs = (size_t)b * SEQ + s; float sc = 0.f;
#pragma unroll
            for (int c = 0; c < 8; ++c) { float k[8]; unpack8(*(const u32x4*)(RK + rs * 256 + h * 64 + c * 8), k);
#pragma unroll
                for (int j = 0; j < 8; ++j) sc += q[c * 8 + j] * k[j]; }
            if (s <= t) {
                const float w = sc * __builtin_amdgcn_exp2f((float)(t - s) * lg2);
#pragma unroll
                for (int c = 0; c < 8; ++c) { float v[8]; unpack8(*(const u32x4*)(RV + rs * 256 + h * 64 + c * 8), v);
#pragma unroll
                    for (int j = 0; j < 8; ++j) o[c * 8 + j] += w * v[j]; }
            }
        }
        float mu = 0.f;
#pragma unroll
        for (int d = 0; d < 64; ++d) mu += o[d];
        mu *= (1.0f / 64.0f); float var = 0.f;
#pragma unroll
        for (int d = 0; d < 64; ++d) { const float e = o[d] - mu; var += e * e; }
        const float rstd = 1.0f / sqrtf(var * (1.0f / 64.0f) + EPS);
#pragma unroll
        for (int c = 0; c < 8; ++c) { float g[8], w[8]; unpack8(*(const u32x4*)(RG + row * 256 + h * 64 + c * 8), g);
#pragma unroll
            for (int j = 0; j < 8; ++j) { const float y = (o[c * 8 + j] - mu) * rstd * g_ret[h * 64 + c * 8 + j]; w[j] = y * g[j] / (1.0f + __expf(-g[j])); }
            st8(O + row * DM + 768 + h * 64 + c * 8, w); }
    }
}

typedef short bf16x8 __attribute__((ext_vector_type(8)));
typedef float f32x16 __attribute__((ext_vector_type(16)));
typedef short s16x4 __attribute__((ext_vector_type(4)));
__device__ __forceinline__ s16x4 ds_tr16(LAS const unsigned char* p) { return __builtin_bit_cast(s16x4, __builtin_amdgcn_ds_read_tr16_b64_v4i16((LAS s16x4*)p)); }
struct TagF { static constexpr bool value = true; }; struct TagG { static constexpr bool value = false; };
template <bool MLA>
__device__ __forceinline__ void attn_phase(LAS unsigned char* lds, const bf16* Qp, const bf16* KNp, const bf16* MSp, const bf16* Vp, const u64* BMp, bf16* Op, const int wave_id) {
    constexpr int DQK = MLA ? 96 : 64, KS = DQK / 16, KP = DQK * 2 + 16, VP = 192, KBUF = 64 * KP, VBUF = 64 * VP, BUF = KBUF + VBUF, QG = 2, NQR = MLA ? ATT_NQR : 4, QSLOT = QG * (KS - NQR) * 1024;
    static_assert(2 * BUF + 8 * QSLOT <= RING_BYTES, "attention LDS");
    const int tid = tid_here(), wave = wave_id, lane = tid & 63, l31 = lane & 31, hi = lane >> 5;
    const int G = gridDim.x, NU = MLA ? 1024 : 512;
    const int keyA = tid >> 3, chA = tid & 7;
    const int vb = (4 * hi + ((lane & 15) >> 2)) * VP + (16 * ((lane >> 4) & 1) + 4 * (lane & 3)) * 2;
    for (int u = blockIdx.x; u < NU; u += G) {
        int b, h, qw0, nt;
        if (MLA) { const int bh = u & 255, r = u >> 8, qb = (r + bh) & 3; b = bh >> 3; h = bh & 7; qw0 = qb * 512 + 64 * wave; nt = 8 * (qb + 1); }
        else { const int bj = u & 255, r = u >> 8, j = bj & 7, qb = (r == 0) ? j : 15 - j; b = bj >> 3; h = wave >> 1; qw0 = qb * 128 + 64 * (wave & 1); nt = 2 * (qb + 1); }
        const int qg0[2] = {MLA ? qw0 - 32 * wave : qw0, MLA ? qw0 - 64 * wave + 32 * (15 - wave) : qw0 + 32};
        const size_t rowb = (size_t)b * SEQ;
        bf16x8 qf[QG][NQR];
        LAS unsigned char* qrl = lds + 2 * BUF + wave * QSLOT + lane * 16;
#pragma unroll
        for (int g = 0; g < QG; ++g)
#pragma unroll
            for (int s = 0; s < KS; ++s) { const bf16* qb_ = Qp + (rowb + qg0[g]) * (MLA ? 768 : 256) + h * DQK + 16 * s;
                const bf16x8 f = *(const bf16x8*)((const char*)qb_ + (unsigned)(l31 * (MLA ? 1536 : 512) + 16 * hi));
                if (s < NQR) qf[g][s < NQR ? s : 0] = f; else *(LAS bf16x8*)(qrl + (g * (KS - NQR) + (s - NQR)) * 1024) = f; }
        f32x16 ot[QG][2];
#pragma unroll
        for (int g = 0; g < QG; ++g)
#pragma unroll
            for (int r = 0; r < 16; ++r) { ot[g][0][r] = 0.f; ot[g][1][r] = 0.f; }
        float mrun[QG], lrun[QG];
#pragma unroll
        for (int g = 0; g < QG; ++g) { mrun[g] = -1e30f; lrun[g] = 0.f; }
        u32x4 sa, sb, sc;
        const unsigned offA_ = 2u * (unsigned)(MLA ? keyA * 512 + chA * 8 : keyA * 256 + chA * 8);
        const unsigned offB_ = 2u * (unsigned)(MLA ? (tid < 256 ? (tid >> 2) * 256 + 64 + (tid & 3) * 8 : ((tid - 256) >> 3) * 512 + chA * 8) : keyA * 256 + 128 + chA * 8);
        const unsigned offC_ = 2u * (unsigned)((32 + keyA) * 512 + chA * 8);
#define ATT_LOAD(j) do { const size_t rk = rowb + 64 * (j); unsigned offA = offA_, offB = offB_, offC = offC_; asm volatile("" : "+v"(offA), "+v"(offB), "+v"(offC));     \
            if (MLA) { const bf16* kb_ = KNp + rk * 512 + h * 64; const bf16* vb2_ = Vp + rk * 512 + h * 64; const bf16* mb_ = MSp + rk * 256; \
                       sa = *(const u32x4*)((const char*)kb_ + offA); \
                       if (tid < 256) { sb = *(const u32x4*)((const char*)mb_ + offB); sc = *(const u32x4*)((const char*)vb2_ + offC); } \
                       else sb = *(const u32x4*)((const char*)vb2_ + offB); } \
            else { const bf16* mb_ = MSp + rk * 256; sa = *(const u32x4*)((const char*)mb_ + offA); sb = *(const u32x4*)((const char*)mb_ + offB); } } while (0)
#define ATT_WRITE(buf) do { LAS unsigned char* kb_ = lds + (buf) * BUF; LAS unsigned char* vb_ = kb_ + KBUF; \
            *(LAS u32x4*)(kb_ + keyA * KP + chA * 16) = sa; \
            if (MLA) { if (tid < 256) { *(LAS u32x4*)(kb_ + (tid >> 2) * KP + 128 + (tid & 3) * 16) = sb; *(LAS u32x4*)(vb_ + (32 + keyA) * VP + chA * 16) = sc; } \
                       else *(LAS u32x4*)(vb_ + ((tid - 256) >> 3) * VP + chA * 16) = sb; } \
            else *(LAS u32x4*)(vb_ + keyA * VP + chA * 16) = sb; } while (0)
        auto tile = [&](auto tag_, const int j) __attribute__((always_inline)) {
            constexpr bool FULL = decltype(tag_)::value;
            const bool active = (MLA && !FULL) ? (64 * j <= qg0[1] + 31) : true, act0 = (MLA && !FULL) ? (64 * j <= qg0[0] + 31) : true;
            if (active) {
                LAS const unsigned char* kbuf = lds + (j & 1) * BUF; LAS const unsigned char* vbuf = kbuf + KBUF;
                f32x16 st[QG][2];
#pragma unroll
                for (int g = 0; g < QG; ++g)
#pragma unroll
                    for (int r = 0; r < 16; ++r) { st[g][0][r] = 0.f; st[g][1][r] = 0.f; }
#pragma unroll
                for (int s = 0; s < KS; ++s) {
                    const bf16x8 k0 = *(LAS const bf16x8*)(kbuf + l31 * KP + (16 * s + 8 * hi) * 2), k1 = *(LAS const bf16x8*)(kbuf + (32 + l31) * KP + (16 * s + 8 * hi) * 2);
#pragma unroll
                    for (int g = 0; g < QG; ++g) { if (g == 0 && !act0) continue; bf16x8 qq; if (s < NQR) qq = qf[g][s < NQR ? s : 0]; else qq = *(LAS const bf16x8*)(qrl + (g * (KS - NQR) + (s - NQR)) * 1024);
                        st[g][0] = __builtin_amdgcn_mfma_f32_32x32x16_bf16(k0, qq, st[g][0], 0, 0, 0); st[g][1] = __builtin_amdgcn_mfma_f32_32x32x16_bf16(k1, qq, st[g][1], 0, 0, 0); } }
                bf16x8 pf[QG][4];
#define ATT_MASK(g) do { const int qpos = qg0[g] + l31; \
                    if (MLA) { if (64 * j + 63 > qg0[g]) { const int lim = qpos - 64 * j - 4 * hi; \
                            _Pragma("unroll") for (int r = 0; r < 16; ++r) { const int ko = (r & 3) + 8 * (r >> 2); if (ko > lim) st[g][0][r] = -INFINITY; if (ko + 32 > lim) st[g][1][r] = -INFINITY; } } } \
                    else { const u64* bmb_ = BMp + (rowb + qg0[g]) * 32 + j; unsigned lo_ = (unsigned)(l31 * 256); asm volatile("" : "+v"(lo_)); \
                        const u64 w = *(const u64*)((const char*)bmb_ + lo_); const unsigned wlo = (unsigned)(w >> (4 * hi)), whi = (unsigned)(w >> (32 + 4 * hi)); \
                        _Pragma("unroll") for (int r = 0; r < 16; ++r) { const int ko = (r & 3) + 8 * (r >> 2); \
                            { const unsigned m_ = (unsigned)__builtin_amdgcn_sbfe((int)wlo, ko, 1); st[g][0][r] = __uint_as_float((m_ & __float_as_uint(st[g][0][r])) | (~m_ & 0xff800000u)); } \
                            { const unsigned m_ = (unsigned)__builtin_amdgcn_sbfe((int)whi, ko, 1); st[g][1][r] = __uint_as_float((m_ & __float_as_uint(st[g][1][r])) | (~m_ & 0xff800000u)); } } } } while (0)
#define ATT_MX3(a, b, c) __builtin_fmaxf(__builtin_fmaxf((a), (b)), (c))
#define ATT_MAXR(g, mt) do { float ma_ = st[g][0][0], mb_ = st[g][1][0]; \
                    _Pragma("unroll") for (int r = 1; r < 16; r += 2) { ma_ = ATT_MX3(ma_, st[g][0][r], st[g][0][r + 1 < 16 ? r + 1 : r]); mb_ = ATT_MX3(mb_, st[g][1][r], st[g][1][r + 1 < 16 ? r + 1 : r]); } \
                    mt = xhalf_max(__builtin_fmaxf(ma_, mb_)); } while (0)
#define ATT_RESC(g, mt) do { const float mn0 = fmaxf(mrun[g], mt), alpha = __builtin_amdgcn_exp2f(mrun[g] - mn0); mrun[g] = mn0; lrun[g] *= alpha; \
                    _Pragma("unroll") for (int r = 0; r < 16; ++r) { ot[g][0][r] *= alpha; ot[g][1][r] *= alpha; } } while (0)
#define ATT_EXPS(g) do { const float mn = mrun[g]; float ps = 0.f; \
                    _Pragma("unroll") for (int r = 0; r < 16; ++r) { st[g][0][r] = __builtin_amdgcn_exp2f(st[g][0][r] - mn); st[g][1][r] = __builtin_amdgcn_exp2f(st[g][1][r] - mn); ps += st[g][0][r] + st[g][1][r]; } \
                    lrun[g] += ps; \
                    _Pragma("unroll") for (int t = 0; t < 2; ++t) _Pragma("unroll") for (int s = 0; s < 2; ++s) { u32x4 a; a.x = cvtpk(st[g][t][8 * s], st[g][t][8 * s + 1]); a.y = cvtpk(st[g][t][8 * s + 2], st[g][t][8 * s + 3]); \
                            a.z = cvtpk(st[g][t][8 * s + 4], st[g][t][8 * s + 5]); a.w = cvtpk(st[g][t][8 * s + 6], st[g][t][8 * s + 7]); pf[g][2 * t + s] = __builtin_bit_cast(bf16x8, a); } } while (0)
                if (FULL || !MLA) {
                    float mt0, mt1;
                    if (!FULL) { ATT_MASK(0); ATT_MASK(1); } ATT_MAXR(0, mt0); ATT_MAXR(1, mt1);
                    if (__builtin_amdgcn_ballot_w64((mt0 > mrun[0] + 6.0f) || (mt1 > mrun[1] + 6.0f)) != 0ull) { ATT_RESC(0, mt0); ATT_RESC(1, mt1); }
                    __builtin_amdgcn_sched_barrier(0); ATT_EXPS(0); __builtin_amdgcn_sched_barrier(0); ATT_EXPS(1);
                } else {
                    if (act0) { float mt0; ATT_MASK(0); ATT_MAXR(0, mt0); if (__builtin_amdgcn_ballot_w64(mt0 > mrun[0] + 6.0f) != 0ull) { ATT_RESC(0, mt0); } ATT_EXPS(0); }
                    float mt1;
                    ATT_MASK(1); ATT_MAXR(1, mt1);
                    if (__builtin_amdgcn_ballot_w64(mt1 > mrun[1] + 6.0f) != 0ull) { ATT_RESC(1, mt1); }
                    ATT_EXPS(1);
                }
#undef ATT_MASK
#undef ATT_MAXR
#undef ATT_RESC
#undef ATT_EXPS
#pragma unroll
                for (int ks = 0; ks < 4; ++ks) {
                    const s16x4 a0 = ds_tr16(vbuf + vb + (16 * ks) * VP), a1 = ds_tr16(vbuf + vb + (16 * ks + 8) * VP), c0 = ds_tr16(vbuf + vb + (16 * ks) * VP + 64), c1 = ds_tr16(vbuf + vb + (16 * ks + 8) * VP + 64);
                    const bf16x8 v0 = {a0[0], a0[1], a0[2], a0[3], a1[0], a1[1], a1[2], a1[3]}, v1 = {c0[0], c0[1], c0[2], c0[3], c1[0], c1[1], c1[2], c1[3]};
#pragma unroll
                    for (int g = 0; g < QG; ++g) { if (g == 0 && !act0) continue; ot[g][0] = __builtin_amdgcn_mfma_f32_32x32x16_bf16(v0, pf[g][ks], ot[g][0], 0, 0, 0); ot[g][1] = __builtin_amdgcn_mfma_f32_32x32x16_bf16(v1, pf[g][ks], ot[g][1], 0, 0, 0); } }
            }
        };
        const int jf = (MLA && ATT_SPLIT) ? (((qg0[0] + 1) >> 6) < nt ? ((qg0[0] + 1) >> 6) : nt) : 0;
        ATT_LOAD(0); ATT_WRITE(0); __syncthreads();
        int j = 0;
        if (MLA && ATT_SPLIT) {
            for (; j < jf; ++j) {
                const bool more = (j + 1 < nt);
                if (more) ATT_LOAD(j + 1);
                tile(TagF{}, j);
                if (more) ATT_WRITE((j + 1) & 1);
                __syncthreads();
            }
        }
        for (; j < nt; ++j) {
            const bool more = (j + 1 < nt);
            if (more) ATT_LOAD(j + 1);
            tile(TagG{}, j);
            if (more) ATT_WRITE((j + 1) & 1);
            __syncthreads();
        }
#undef ATT_LOAD
#undef ATT_WRITE
        const int le = lane_here(), l31e = le & 31, hie = le >> 5;
#pragma unroll
        for (int g = 0; g < QG; ++g) {
            const float inv = 1.0f / xhalf_sum(lrun[g]);
            bf16* orow = Op + (rowb + qg0[g] + l31e) * DM + (MLA ? h * 64 : 512 + h * 64) + 8 * hie;
#pragma unroll
            for (int t = 0; t < 2; ++t)
#pragma unroll
                for (int k = 0; k < 4; k += 2) {
                    u32x2 a, b2; a.x = cvtpk(ot[g][t][4 * k] * inv, ot[g][t][4 * k + 1] * inv); a.y = cvtpk(ot[g][t][4 * k + 2] * inv, ot[g][t][4 * k + 3] * inv);
                    b2.x = cvtpk(ot[g][t][4 * k + 4] * inv, ot[g][t][4 * k + 5] * inv); b2.y = cvtpk(ot[g][t][4 * k + 6] * inv, ot[g][t][4 * k + 7] * inv);
                    const auto rx = __builtin_amdgcn_permlane32_swap(a.x, b2.x, false, false); const auto ry = __builtin_amdgcn_permlane32_swap(a.y, b2.y, false, false);
                    u32x4 w; w.x = rx[0]; w.y = ry[0]; w.z = rx[1]; w.w = ry[1];
                    *(u32x4*)(orow + 32 * t + 8 * k) = w; }
        }
    }
}

__device__ __forceinline__ void ret_phase(LAS unsigned char* lds, const bf16* RQ, const bf16* RK, const bf16* RV, const bf16* RG, const float* g_ret, bf16* Op, const int wave_id) {
    constexpr int KP = 144, VP = 192, OFF_K = 0, OFF_V = 128 * KP, OFF_Z = OFF_V + 128 * VP, OFF_R = OFF_Z + 128 * VP;
    const int tid = tid_here(), wave = wave_id, lane = tid & 63, l31 = lane & 31, hi = lane >> 5;
    const int trq = (lane & 15) >> 2, trc = (16 * ((lane >> 4) & 1) + 4 * (lane & 3)) * 2;
    const int trn = (8 * hi + trq) * VP + trc, trp = (4 * hi + trq) * VP + trc;
    LAS unsigned char* KT = lds + OFF_K; LAS unsigned char* VT = lds + OFF_V; LAS unsigned char* KZ = lds + OFF_Z; LAS unsigned char* RT = lds + OFF_R;
    for (int u = blockIdx.x; u < BATCH * 4; u += gridDim.x) {
        const int b = u >> 2, h = u & 3; const size_t rowb = (size_t)b * SEQ;
        const float lg = (h == 0) ? -0.04580368961312479f : (h == 1) ? -0.02272007650008353f : (h == 2) ? -0.011315313227834146f : -0.005646563141142063f;
        { unsigned zz = 0u; asm volatile("" : "+v"(zz)); *(LAS u32x4*)(RT + (tid >> 3) * VP + (tid & 7) * 16) = (u32x4){zz, zz, zz, zz}; }
        f32x16 sacc;
#pragma unroll
        for (int r = 0; r < 16; ++r) sacc[r] = 0.f;
        float kr[16];
#pragma unroll
        for (int r = 0; r < 16; ++r) kr[r] = __builtin_amdgcn_exp2f(-(float)((r & 3) + 8 * (r >> 2)) * lg);
        u32x4 k0, k1, v0, v1;
#define RET_LOAD(n) do { const size_t r0 = rowb + 128 * (n) + (tid >> 3), r1 = r0 + 64; const int co = h * 64 + (tid & 7) * 8; \
            k0 = *(const u32x4*)(RK + r0 * 256 + co); k1 = *(const u32x4*)(RK + r1 * 256 + co); v0 = *(const u32x4*)(RV + r0 * 256 + co); v1 = *(const u32x4*)(RV + r1 * 256 + co); } while (0)
        RET_LOAD(0);
        for (int n = 0; n < 16; ++n) {
            {
                const int r0 = tid >> 3, cb = (tid & 7) * 16;
                *(LAS u32x4*)(KT + r0 * KP + cb) = k0; *(LAS u32x4*)(KT + (r0 + 64) * KP + cb) = k1; *(LAS u32x4*)(VT + r0 * VP + cb) = v0; *(LAS u32x4*)(VT + (r0 + 64) * VP + cb) = v1;
                float f[8]; const float z0 = __builtin_amdgcn_exp2f((float)(127 - r0) * lg), z1 = __builtin_amdgcn_exp2f((float)(63 - r0) * lg);
                unpack8(k0, f);
#pragma unroll
                for (int j = 0; j < 8; ++j) f[j] *= z0;
                { u32x4 w; w.x = cvtpk(f[0], f[1]); w.y = cvtpk(f[2], f[3]); w.z = cvtpk(f[4], f[5]); w.w = cvtpk(f[6], f[7]); *(LAS u32x4*)(KZ + r0 * VP + cb) = w; }
                unpack8(k1, f);
#pragma unroll
                for (int j = 0; j < 8; ++j) f[j] *= z1;
                { u32x4 w; w.x = cvtpk(f[0], f[1]); w.y = cvtpk(f[2], f[3]); w.z = cvtpk(f[4], f[5]); w.w = cvtpk(f[6], f[7]); *(LAS u32x4*)(KZ + (r0 + 64) * VP + cb) = w; }
            }
            const int posq = 32 * wave + l31; const size_t rowq = rowb + 128 * n + (wave < 4 ? posq : 0);
            bf16x8 qf[4];
            if (wave < 4) {
#pragma unroll
                for (int s = 0; s < 4; ++s) qf[s] = *(const bf16x8*)(RQ + rowq * 256 + h * 64 + 16 * s + 8 * hi); }
            __syncthreads();
            if (n + 1 < 16) RET_LOAD(n + 1);
            f32x16 a0, a1;
            if (wave < 4) {
#pragma unroll
                for (int r = 0; r < 16; ++r) { a0[r] = 0.f; a1[r] = 0.f; }
#pragma unroll
                for (int s = 0; s < 4; ++s) {
                    const s16x4 x0 = ds_tr16(RT + trn + (16 * s) * VP), x1 = ds_tr16(RT + trn + (16 * s + 4) * VP), y0 = ds_tr16(RT + trn + (16 * s) * VP + 64), y1 = ds_tr16(RT + trn + (16 * s + 4) * VP + 64);
                    const bf16x8 f0 = {x0[0], x0[1], x0[2], x0[3], x1[0], x1[1], x1[2], x1[3]}, f1 = {y0[0], y0[1], y0[2], y0[3], y1[0], y1[1], y1[2], y1[3]};
                    a0 = __builtin_amdgcn_mfma_f32_32x32x16_bf16(f0, qf[s], a0, 0, 0, 0); a1 = __builtin_amdgcn_mfma_f32_32x32x16_bf16(f1, qf[s], a1, 0, 0, 0); }
                const float xi = __builtin_amdgcn_exp2f((float)(posq + 1) * lg);
#pragma unroll
                for (int r = 0; r < 16; ++r) { a0[r] *= xi; a1[r] *= xi; }
#pragma unroll 1
                for (int kt = 0; kt <= wave; ++kt) {
                    {
                        f32x16 st;
#pragma unroll
                        for (int r = 0; r < 16; ++r) st[r] = 0.f;
#pragma unroll
                        for (int s = 0; s < 4; ++s) { const bf16x8 kf = *(LAS const bf16x8*)(KT + (32 * kt + l31) * KP + (16 * s + 8 * hi) * 2); st = __builtin_amdgcn_mfma_f32_32x32x16_bf16(kf, qf[s], st, 0, 0, 0); }
                        {
                            const int rb = posq - 32 * kt - 4 * hi; const float wb = __builtin_amdgcn_exp2f((float)rb * lg);
                            if (kt < wave) {
#pragma unroll
                                for (int r = 0; r < 16; ++r) st[r] *= wb * kr[r];
                            } else {
#pragma unroll
                                for (int r = 0; r < 16; ++r) { const int rel = rb - ((r & 3) + 8 * (r >> 2)); st[r] = (rel >= 0) ? st[r] * (wb * kr[r]) : 0.f; }
                            }
                        }
#pragma unroll
                        for (int s = 0; s < 2; ++s) {
                            u32x4 pw; pw.x = cvtpk(st[8 * s], st[8 * s + 1]); pw.y = cvtpk(st[8 * s + 2], st[8 * s + 3]); pw.z = cvtpk(st[8 * s + 4], st[8 * s + 5]); pw.w = cvtpk(st[8 * s + 6], st[8 * s + 7]);
                            const bf16x8 pf = __builtin_bit_cast(bf16x8, pw);
                            const int ro = (32 * kt + 16 * s) * VP;
                            const s16x4 x0 = ds_tr16(VT + trp + ro), x1 = ds_tr16(VT + trp + ro + 8 * VP), y0 = ds_tr16(VT + trp + ro + 64), y1 = ds_tr16(VT + trp + ro + 8 * VP + 64);
                            const bf16x8 f0 = {x0[0], x0[1], x0[2], x0[3], x1[0], x1[1], x1[2], x1[3]}, f1 = {y0[0], y0[1], y0[2], y0[3], y1[0], y1[1], y1[2], y1[3]};
                            a0 = __builtin_amdgcn_mfma_f32_32x32x16_bf16(f0, pf, a0, 0, 0, 0); a1 = __builtin_amdgcn_mfma_f32_32x32x16_bf16(f1, pf, a1, 0, 0, 0); }
                    }
                }
            } else {
                const int et = wave & 1, dt = (wave >> 1) & 1; const float cd = __builtin_amdgcn_exp2f(128.0f * lg);
#pragma unroll
                for (int r = 0; r < 16; ++r) sacc[r] *= cd;
#pragma unroll
                for (int s = 0; s < 8; ++s) {
                    const s16x4 x0 = ds_tr16(VT + trn + (16 * s) * VP + et * 64), x1 = ds_tr16(VT + trn + (16 * s + 4) * VP + et * 64), y0 = ds_tr16(KZ + trn + (16 * s) * VP + dt * 64), y1 = ds_tr16(KZ + trn + (16 * s + 4) * VP + dt * 64);
                    const bf16x8 fa = {x0[0], x0[1], x0[2], x0[3], x1[0], x1[1], x1[2], x1[3]}, fb = {y0[0], y0[1], y0[2], y0[3], y1[0], y1[1], y1[2], y1[3]};
                    sacc = __builtin_amdgcn_mfma_f32_32x32x16_bf16(fa, fb, sacc, 0, 0, 0); }
            }
            __syncthreads();
            if (wave < 4) {
                float s1 = 0.f;
#pragma unroll
                for (int r = 0; r < 16; ++r) s1 += a0[r] + a1[r];
                s1 = xhalf_sum(s1); const float mu = s1 * (1.0f / 64.0f); float s2 = 0.f;
#pragma unroll
                for (int r = 0; r < 16; ++r) { const float d0 = a0[r] - mu, d1 = a1[r] - mu; s2 += d0 * d0 + d1 * d1; }
                s2 = xhalf_sum(s2); const float rstd = __builtin_amdgcn_rsqf(s2 * (1.0f / 64.0f) + EPS);
#pragma unroll
                for (int t = 0; t < 2; ++t)
#pragma unroll
                    for (int g = 0; g < 4; ++g) { const int e0 = h * 64 + 32 * t + 8 * g + 4 * hi;
                        const u32x2 gr = *(const u32x2*)(RG + rowq * 256 + e0); const f32x4 gg = *(const f32x4*)(g_ret + e0);
                        const float gt[4] = {bf_lo(gr.x), bf_hi(gr.x), bf_lo(gr.y), bf_hi(gr.y)}; const float gn[4] = {gg.x, gg.y, gg.z, gg.w}; float y[4];
#pragma unroll
                        for (int i = 0; i < 4; ++i) { const float x = (t == 0 ? a0[4 * g + i] : a1[4 * g + i]); y[i] = (x - mu) * rstd * gn[i] * gt[i] * __builtin_amdgcn_rcpf(1.0f + __expf(-gt[i]));     }
                        u32x2 w; w.x = cvtpk(y[0], y[1]); w.y = cvtpk(y[2], y[3]); *(u32x2*)(Op + rowq * DM + 768 + e0) = w; }
            } else {
                const int et = wave & 1, dt = (wave >> 1) & 1;
#pragma unroll
                for (int g = 0; g < 4; ++g) { u32x2 w; w.x = cvtpk(sacc[4 * g], sacc[4 * g + 1]); w.y = cvtpk(sacc[4 * g + 2], sacc[4 * g + 3]);
                    *(LAS u32x2*)(RT + (32 * dt + l31) * VP + (32 * et + 8 * g + 4 * hi) * 2) = w; }
            }
        }
#undef RET_LOAD
        __syncthreads();
    }
}


template <int NR>
__device__ __forceinline__ void select_two(LAS const float* sc, LAS float* cand, LAS unsigned* ticket, int lane, int t0, int nkt, u64* bmrow0) {
    for (;;) {
        unsigned qv = 0u; if (lane == 0) qv = __hip_atomic_fetch_add(ticket, 1u, __ATOMIC_RELAXED, __HIP_MEMORY_SCOPE_WORKGROUP);
        const int q = __builtin_amdgcn_readfirstlane((int)qv);
        if (q >= 16) break;
        const int nk = t0 + q + 1; u64* bm = bmrow0 + (size_t)q * 32;
        f32x2s vp[NR / 2];
#pragma unroll
        for (int i = 0; i < NR; ++i) { float x = __builtin_nanf(""); if (2 * i < nkt) { x = sc[q * 2048 + i * 64 + lane]; if (2 * i + 1 >= nkt && lane >= 32) x = __builtin_nanf(""); }
            if (i & 1) vp[i >> 1].y = x; else vp[i >> 1].x = x; }
        select_row<NR>(vp, nk, bm, lane);
        if (NR < 32 && lane >= NR && lane < 32) { unsigned zz = 0u; asm volatile("" : "+v"(zz)); *(u32x2*)(bm + lane) = (u32x2){zz, zz}; }
    }
}
__device__ __forceinline__ void select_phase(LAS unsigned char* lds, const bf16* QI, const bf16* MS, const float* WI, u64* BM, const int wave_id) {
    const int tid = tid_here(), wave = wave_id, lane = tid & 63, l31 = lane & 31, hi = lane >> 5;
    LAS float* sc = (LAS float*)lds;
    const bool deal256 = (gridDim.x == 256); const int cblk = blockIdx.x;
    constexpr int NB = SEL_NB;
    const int nmine = deal256 ? (cblk < 128 ? NB : NB + 2 * (16 - NB)) : (M / 16 - cblk + (int)gridDim.x - 1) / (int)gridDim.x;
    for (int iu = 0; iu < nmine; ++iu) {
        int r, x;
        if (deal256) { if (iu < NB) { r = iu; x = cblk; } else { r = NB + ((iu - NB) >> 1); x = (cblk - 128) + 128 * ((iu - NB) & 1); } }
        else { const int v = cblk + iu * (int)gridDim.x; r = v >> 8; x = v & 255; }
        const int pr = (r < 7) ? r : (r < 14 ? r + 2 : r - 7);
        const int b = x >> 3, tb = pr * 8 + (x & 7), t0 = tb * 16; const size_t rowb = (size_t)b * SEQ;
        if (t0 < 256) {
            const int t = t0 + 2 * wave + (lane >> 5); u64* bm = BM + (rowb + t) * 32; const int k0 = 64 * l31;
            bm[l31] = (t >= k0 + 63) ? ~0ull : (t < k0 ? 0ull : ((1ull << (t - k0 + 1)) - 1ull));
            continue;
        }
        const int nkt = (t0 + 16 + 31) >> 5;
        if (tid == 0) *(LAS unsigned*)(lds + RING_BYTES + 512) = 0u;
        const int qloc = 2 * ((l31 >> 2) & 1) + (l31 >> 4), hd = 4 * ((l31 >> 3) & 1) + (l31 & 3);
        bf16x8 qa[4][2]; float wv[4][2][8];
#pragma unroll
        for (int qg = 0; qg < 4; ++qg) {
            const size_t rq = rowb + t0 + 4 * qg + qloc;
            qa[qg][0] = *(const bf16x8*)(QI + rq * 256 + hd * 32 + 8 * hi); qa[qg][1] = *(const bf16x8*)(QI + rq * 256 + hd * 32 + 16 + 8 * hi);
#pragma unroll
            for (int jq = 0; jq < 2; ++jq) { const float* wp = WI + (rowb + t0 + 4 * qg + 2 * hi + jq) * 8; const f32x4 wa = *(const f32x4*)wp, wb = *(const f32x4*)(wp + 4);
                wv[qg][jq][0] = wa.x; wv[qg][jq][1] = wa.y; wv[qg][jq][2] = wa.z; wv[qg][jq][3] = wa.w; wv[qg][jq][4] = wb.x; wv[qg][jq][5] = wb.y; wv[qg][jq][6] = wb.z; wv[qg][jq][7] = wb.w; }
        }
        const bf16* kp0 = MS + (rowb + l31) * 256 + 96 + 8 * hi;
        REP(7) {
        if (wave < nkt) {
        bf16x8 kb0 = *(const bf16x8*)(kp0 + (size_t)(32 * wave) * 256), kb1 = *(const bf16x8*)(kp0 + (size_t)(32 * wave) * 256 + 16);
        for (int kt = wave; kt < nkt; kt += 8) {
            const int ktn = (kt + 8 < nkt) ? kt + 8 : kt;
            const bf16x8 nb0 = *(const bf16x8*)(kp0 + (size_t)(32 * ktn) * 256), nb1 = *(const bf16x8*)(kp0 + (size_t)(32 * ktn) * 256 + 16);
#pragma unroll
            for (int qg = 0; qg < 4; ++qg) {
                f32x16 d;
#pragma unroll
                for (int r = 0; r < 16; ++r) d[r] = 0.f;
                d = __builtin_amdgcn_mfma_f32_32x32x16_bf16(qa[qg][0], kb0, d, 0, 0, 0); d = __builtin_amdgcn_mfma_f32_32x32x16_bf16(qa[qg][1], kb1, d, 0, 0, 0);
                float w0 = 0.f, w1 = 0.f;
#pragma unroll
                for (int i = 0; i < 8; ++i) { w0 += wv[qg][0][i] * relu_i(d[i]); w1 += wv[qg][1][i] * relu_i(d[8 + i]); }
                LAS float* o = sc + (4 * qg + 2 * hi) * 2048 + 32 * kt + l31;
                if (kt == nkt - 1) { const int tq0 = t0 + 4 * qg + 2 * hi, key = 32 * kt + l31; if (key > tq0) w0 = __builtin_nanf(""); if (key > tq0 + 1) w1 = __builtin_nanf(""); }
                o[0] = w0; o[2048] = w1;
            }
            kb0 = nb0; kb1 = nb1;
        }
        }
        }
        __syncthreads();
        u64* bmrow0 = BM + (rowb + t0) * 32;
        REP(8) {
        LAS float* cand = (LAS float*)(lds + RING_BYTES + 1024) + wave * 128; LAS unsigned* ticket = (LAS unsigned*)(lds + RING_BYTES + 512);
        if (t0 + 16 <= 512) select_two<8>(sc, cand, ticket, lane, t0, nkt, bmrow0);
        else if (t0 + 16 <= 1024) select_two<16>(sc, cand, ticket, lane, t0, nkt, bmrow0);
        else if (t0 + 16 <= 1536) select_two<24>(sc, cand, ticket, lane, t0, nkt, bmrow0);
        else select_two<32>(sc, cand, ticket, lane, t0, nkt, bmrow0);
        }
        __syncthreads();
    }
}

__device__ __forceinline__ void prologue(const Ptrs& P, LAS unsigned char* lds, const int wave_id) {
    const int tid = tid_here(), wave = wave_id, lane = tid & 63;
    LAS float* scr = (LAS float*)(lds + wave * 16384);
    const int gw = blockIdx.x * NWAVES + wave, NGW = gridDim.x * NWAVES;
    constexpr int I_IN = (DM / 64) * (NIN / 32), I_UQ = (768 / 64) * (768 / 32), I_UKV = (256 / 64) * (1024 / 32), I_OUT = (DM / 64) * (DM / 32), I_F1 = (DM / 64) * (FF / 32), I_F2 = (FF / 64) * (DM / 32);
    constexpr int I_L = I_IN + I_UQ + I_UKV + I_OUT + I_F1 + I_F2;
    for (int it = gw; it < DEPTH * I_L; it += NGW) {
        const int l = it / I_L; int r = it % I_L; unsigned char* wl = P.ws + WS_W + (size_t)l * WL_BYTES;
        if (r < I_IN) { transpose_item(P.w_in + (size_t)l * DM * IN_W, DM, IN_W, NIN, P.g_mix + l * DM, (bf16*)(wl + WL_IN), scr, r, lane, SrcIn()); continue; } r -= I_IN;
        if (r < I_UQ) { transpose_item(P.w_uq + (size_t)l * 768 * 768, 768, 768, 768, P.g_q + l * 768, (bf16*)(wl + WL_UQ), scr, r, lane, SrcUq()); continue; } r -= I_UQ;
        if (r < I_UKV) { transpose_item(P.w_ukv + (size_t)l * 256 * 1024, 256, 1024, 1024, P.g_kv + l * 256, (bf16*)(wl + WL_UKV), scr, r, lane, SrcUkv()); continue; } r -= I_UKV;
        if (r < I_OUT) { transpose_item(P.w_out + (size_t)l * DM * DM, DM, DM, DM, nullptr, (bf16*)(wl + WL_OUT), scr, r, lane, SrcId()); continue; } r -= I_OUT;
        if (r < I_F1) { transpose_item(P.w_ff1 + (size_t)l * DM * FF, DM, FF, FF, P.g_mlp + l * DM, (bf16*)(wl + WL_F1), scr, r, lane, SrcId()); continue; } r -= I_F1;
        transpose_item(P.w_ff2 + (size_t)l * FF * DM, FF, DM, DM, nullptr, (bf16*)(wl + WL_F2), scr, r, lane, SrcId());
    }
    bf16* xb = (bf16*)(P.ws + WS_XB); float* ssqx = (float*)(P.ws + WS_SSQX);
    for (int m0 = gw * 4; m0 < M; m0 += NGW * 4) {
        f32x4 v[4][4];
#pragma unroll
        for (int r = 0; r < 4; ++r) { const f32x4* xr = (const f32x4*)(P.x + (size_t)(m0 + r) * DM) + lane;
#pragma unroll
            for (int j = 0; j < 4; ++j) v[r][j] = xr[64 * j]; }
#pragma unroll
        for (int r = 0; r < 4; ++r) {
            float s = 0.f;
#pragma unroll
            for (int j = 0; j < 4; ++j) s += (v[r][j].x * v[r][j].x + v[r][j].y * v[r][j].y) + (v[r][j].z * v[r][j].z + v[r][j].w * v[r][j].w);
            s = wave_sum_f(s);
            u32x2* o8 = (u32x2*)(xb + (size_t)(m0 + r) * DM) + lane;
#pragma unroll
            for (int j = 0; j < 4; ++j) { u32x2 w; w.x = cvtpk(v[r][j].x, v[r][j].y); w.y = cvtpk(v[r][j].z, v[r][j].w); o8[64 * j] = w; }
            if (lane < 16) ssqx[(size_t)(m0 + r) * 16 + lane] = (lane == 0) ? s : 0.f;
        }
    }
}
__device__ __forceinline__ void final_norm(const Ptrs& P, const int wave_id) {
    const int tid = tid_here(), wave = wave_id, lane = tid & 63;
    const int gw = blockIdx.x * NWAVES + wave, NGW = gridDim.x * NWAVES;
    const float* ssqx = (const float*)(P.ws + WS_SSQX); const bf16* xb = (const bf16*)(P.ws + WS_XB);
    const f32x4* g = (const f32x4*)P.g_final + 2 * lane;
    const f32x4 g00 = g[0], g01 = g[1], g10 = g[128], g11 = g[129];
    for (int m0 = gw * 4; m0 < M; m0 += NGW * 4) {
        u32x4 xv[4][2]; float ss[4];
#pragma unroll
        for (int r = 0; r < 4; ++r) { const u32x4* xr = (const u32x4*)(xb + (size_t)(m0 + r) * DM) + lane; xv[r][0] = xr[0]; xv[r][1] = xr[64];
            const float* sp = ssqx + (size_t)(m0 + r) * 16; ss[r] = (lane < 16) ? sp[lane] : 0.f; }
#pragma unroll
        for (int r = 0; r < 4; ++r) {
            const float rs = __builtin_amdgcn_rsqf(wave_sum_f(ss[r]) * (1.0f / DM) + EPS);
            f32x4* orow = (f32x4*)(P.out + (size_t)(m0 + r) * DM) + 2 * lane;
            float a[8], b[8]; unpack8(xv[r][0], a); unpack8(xv[r][1], b);
            orow[0] = (f32x4){a[0] * rs * g00.x, a[1] * rs * g00.y, a[2] * rs * g00.z, a[3] * rs * g00.w}; orow[1] = (f32x4){a[4] * rs * g01.x, a[5] * rs * g01.y, a[6] * rs * g01.z, a[7] * rs * g01.w};
            orow[128] = (f32x4){b[0] * rs * g10.x, b[1] * rs * g10.y, b[2] * rs * g10.z, b[3] * rs * g10.w}; orow[129] = (f32x4){b[4] * rs * g11.x, b[5] * rs * g11.y, b[6] * rs * g11.z, b[7] * rs * g11.w};
        }
    }
}

constexpr int PH_PER_LAYER = 6, N_PHASES = 2 + DEPTH * PH_PER_LAYER;

__global__ void __launch_bounds__(NTHREADS, 2) fwd(Args args) {
    extern __shared__ __attribute__((aligned(16))) unsigned char lds_raw[];
    LAS unsigned char* lds = (LAS unsigned char*)lds_raw;
    const Ptrs& P = args.p;
    const int wave_id = __builtin_amdgcn_readfirstlane((int)threadIdx.x >> 6);
    const int tid = tid_here();
    for (int u = tid; u < (LDS_BYTES - RING_BYTES) / 4; u += NTHREADS) ((LAS unsigned*)(lds + RING_BYTES))[u] = 0u;
    __syncthreads();
    unsigned char* const ws0 = P.ws;
    XcdBarrier bar; bar.bar = (unsigned*)(ws0 + WS_CTL) + CW_BAR; bar.x = 0; bar.st = nullptr;
#if MK_N_LAUNCHES == 1
    bar = xcd_barrier_post((unsigned*)(ws0 + WS_CTL) + CW_BAR, (volatile LAS unsigned*)(lds + MISC_OFF) + 8);
#define GRID_BAR() xcd_barrier(bar)
#else
#define GRID_BAR() do { } while (0)
#endif
    const int lo = args.ph_lo, hi = args.ph_hi;
#define IN(k) (lo <= (k) && (k) < hi)
#define LAUNDER_WS() size_t zo_ = 0; asm volatile("" : "+s"(zo_)); unsigned char* const ws = ws0 + zo_
#define SEAM(k) do { if (IN(k) && IN((k) + 1)) { REP(10) GRID_BAR(); } } while (0)
    const int G = gridDim.x, c = blockIdx.x;

#define XB ((bf16*)(ws + WS_XB))
#define SSQX ((float*)(ws + WS_SSQX))
#define SSQL ((float*)(ws + WS_SSQL))
#define SSQ2 ((float*)(ws + WS_SSQ2))
#define WI ((float*)(ws + WS_WI))
#define CQ ((bf16*)(ws + WS_CQ))
#define CKV ((bf16*)(ws + WS_CKV))
#define AQ ((bf16*)(ws + WS_AQ))
#define RQ ((bf16*)(ws + WS_RQ))
#define RK ((bf16*)(ws + WS_RK))
#define QI ((bf16*)(ws + WS_QI))
#define MS ((bf16*)(ws + WS_MS))
#define RV ((bf16*)(ws + WS_RV))
#define RG ((bf16*)(ws + WS_RG))
#define Q ((bf16*)(ws + WS_Q))
#define KN ((bf16*)(ws + WS_KN))
#define V ((bf16*)(ws + WS_V))
#define O ((bf16*)(ws + WS_O))
#define H ((bf16*)(ws + WS_H))
#define BM ((u64*)(ws + WS_BM))
    if (IN(0)) { REP(9) prologue(P, lds, wave_id); } SEAM(0);

    for (int l = 0; l < DEPTH; ++l) {
        const int pb = 1 + l * PH_PER_LAYER;
        if (IN(pb + 0)) {
            LAUNDER_WS(); unsigned char* wl = ws + WS_W + (size_t)l * WL_BYTES; (void)wl;
            pg8::Gemm g{XB, (const bf16*)(wl + WL_IN), M, NIN, DM}; pg8::StaticOrder S; S.init(M, NIN, G, c);
            KL_RUN(0, FIn, ws);
        } SEAM(pb + 0);
        if (IN(pb + 1)) {
            { LAUNDER_WS(); unsigned char* wl = ws + WS_W + (size_t)l * WL_BYTES; pg8::Gemm g{CQ, (const bf16*)(wl + WL_UQ), M, 768, 768}; pg8::StaticOrder S; S.init(M, 768, G, c); KL_RUN(1, FUq, SSQL, Q); }
            { LAUNDER_WS(); unsigned char* wl = ws + WS_W + (size_t)l * WL_BYTES; pg8::Gemm g{CKV, (const bf16*)(wl + WL_UKV), M, 1024, 256}; pg8::StaticOrder S; S.init(M, 1024, G, c); KL_RUN(2, FUkv, SSQL, KN); }
            { LAUNDER_WS(); REP(2) select_phase(lds, QI, MS, WI, BM, wave_id); }
            __syncthreads();
            { LAUNDER_WS(); const float* gr = P.g_ret + l * 256 + zo_; REP(3) ret_phase(lds, RQ, RK, RV, RG, gr, O, wave_id); }
        } SEAM(pb + 1);
        if (IN(pb + 2)) {
            LAUNDER_WS(); unsigned char* wl = ws + WS_W + (size_t)l * WL_BYTES; (void)wl;
            REP(4) attn_phase<true>(lds, Q, KN, MS, V, nullptr, O, wave_id);
            REP(5) attn_phase<false>(lds, AQ, nullptr, MS, nullptr, BM, O, wave_id);
        } SEAM(pb + 2);
        if (IN(pb + 3)) {
            LAUNDER_WS(); unsigned char* wl = ws + WS_W + (size_t)l * WL_BYTES; (void)wl;
            pg8::Gemm g{O, (const bf16*)(wl + WL_OUT), M, DM, DM}; pg8::StaticOrder S; S.init(M, DM, G, c);
            KL_RUN(3, FRes<false>, XB, nullptr, SSQ2);
        } SEAM(pb + 3);
        if (IN(pb + 4)) {
            LAUNDER_WS(); unsigned char* wl = ws + WS_W + (size_t)l * WL_BYTES; (void)wl;
            pg8::Gemm g{XB, (const bf16*)(wl + WL_F1), M, FF, DM}; pg8::StaticOrder S; S.init(M, FF, G, c);
            KL_RUN(4, FFf1, H);
        } SEAM(pb + 4);
        if (IN(pb + 5)) {
            LAUNDER_WS(); unsigned char* wl = ws + WS_W + (size_t)l * WL_BYTES; (void)wl;
            pg8::Gemm g{H, (const bf16*)(wl + WL_F2), M, DM, FF}; pg8::StaticOrder S; S.init(M, DM, G, c);
            KL_RUN(5, FRes<true>, XB, SSQ2, SSQX);
        } SEAM(pb + 5);
    }
    if (IN(N_PHASES - 1)) final_norm(P, wave_id);
#undef IN
#undef SEAM
}
}

extern "C" void kernel_launch(void* const* d_in, const int* in_sizes, int n_in, void* d_out, int out_size, void* d_ws, size_t ws_size, hipStream_t stream) {
    using namespace mk;
    static int grid = 0;
    if (grid == 0) {
        if (n_in != 13 || in_sizes[0] != M * DM || out_size != M * DM || ws_size < WS_END || ws_size < WS_H + 512 * MiB) {
            fprintf(stderr, "kernel_launch: unexpected shapes (n_in %d, in0 %d, out %d, ws %zu); nothing launched\n", n_in, n_in > 0 ? in_sizes[0] : -1, out_size, ws_size); grid = -1; return; }
        int dev = 0, cus = 0, per_cu = 0;
        if (hipGetDevice(&dev) != hipSuccess || hipDeviceGetAttribute(&cus, hipDeviceAttributeMultiprocessorCount, dev) != hipSuccess) { grid = -1; return; }
        if (hipFuncSetAttribute((const void*)fwd, hipFuncAttributeMaxDynamicSharedMemorySize, LDS_BYTES) != hipSuccess) { fprintf(stderr, "kernel_launch: hipFuncSetAttribute failed\n"); grid = -1; return; }
        if (hipOccupancyMaxActiveBlocksPerMultiprocessor(&per_cu, (const void*)fwd, NTHREADS, LDS_BYTES) != hipSuccess || per_cu < 1) { fprintf(stderr, "kernel_launch: occupancy query says %d\n", per_cu); }
        (void)hipGetLastError();
        grid = cus;
    }
    if (grid < 0) return;
    if (hipMemsetAsync((char*)d_ws + WS_CTL, 0, CTL_ZERO_BYTES, stream) != hipSuccess) return;
    Args a{};
    a.p.x = (const float*)d_in[0]; a.p.g_mix = (const float*)d_in[1]; a.p.w_in = (const float*)d_in[2]; a.p.g_q = (const float*)d_in[3]; a.p.w_uq = (const float*)d_in[4];
    a.p.g_kv = (const float*)d_in[5]; a.p.w_ukv = (const float*)d_in[6]; a.p.g_ret = (const float*)d_in[7]; a.p.w_out = (const float*)d_in[8]; a.p.g_mlp = (const float*)d_in[9];
    a.p.w_ff1 = (const float*)d_in[10]; a.p.w_ff2 = (const float*)d_in[11]; a.p.g_final = (const float*)d_in[12];
    a.p.out = (float*)d_out; a.p.ws = (unsigned char*)d_ws;
#if MK_N_LAUNCHES == 1
    a.ph_lo = 0; a.ph_hi = N_PHASES;
    hipLaunchKernelGGL(fwd, dim3(grid), dim3(NTHREADS), LDS_BYTES, stream, a);
#else
    for (int ph = 0; ph < N_PHASES; ++ph) { a.ph_lo = ph; a.ph_hi = ph + 1; hipLaunchKernelGGL(fwd, dim3(grid), dim3(NTHREADS), LDS_BYTES, stream, a); }
#endif
}
```
